# Optimizing an MI355X kernel written in HIP

```python
import jax
import jax.numpy as jnp
from jax import lax
import numpy as np

D_MODEL = 1024
BATCH = 32
SEQ = 2048
DEPTH = 2

CHUNK = 64
Q_BLOCK = 128
EPS = 1e-6
ROPE_THETA = 10000.0

RET_HEADS = 4
RET_HEAD_DIM = 64
RET_WIDTH = RET_HEADS * RET_HEAD_DIM

MLA_HEADS = 8
MLA_NOPE = 64
MLA_ROPE = 32
MLA_V = 64
MLA_WIDTH = MLA_HEADS * MLA_V
MLA_Q_RANK = 256
MLA_KV_RANK = 128

GLA_HEADS = 4
GLA_DK = 32
GLA_DV = 64
GLA_KWIDTH = GLA_HEADS * GLA_DK
GLA_WIDTH = GLA_HEADS * GLA_DV
GLA_GATE_RANK = 16
GLA_TAU = 16.0

MIX_WIDTH = RET_WIDTH + MLA_WIDTH + GLA_WIDTH

RET_SPLIT = (RET_WIDTH, RET_WIDTH, RET_WIDTH, RET_WIDTH)
MLA_SPLIT = (MLA_Q_RANK, MLA_KV_RANK, MLA_ROPE, MLA_WIDTH)
GLA_SPLIT = (GLA_KWIDTH, GLA_KWIDTH, GLA_WIDTH, GLA_GATE_RANK, GLA_WIDTH)
IN_COLS = sum(RET_SPLIT) + sum(MLA_SPLIT) + sum(GLA_SPLIT)

kernel_name = "hybrid_retention_mla_gla_streaming_block"


def rms_norm(x, w=None):
    xf = x.astype(jnp.float32)
    y = xf * lax.rsqrt(jnp.mean(xf * xf, axis=-1, keepdims=True) + EPS)
    if w is not None:
        y = y * w.astype(jnp.float32)
    return y.astype(x.dtype)


def split_cols(t, sizes):
    cuts = [int(s) for s in np.cumsum(sizes)[:-1]]
    return jnp.split(t, cuts, axis=-1)


def to_heads(t, n_heads):
    b, s, _ = t.shape
    return t.reshape(b, s, n_heads, -1)


def rope(x, pos):
    half = x.shape[-1] // 2
    inv = ROPE_THETA ** (-jnp.arange(half, dtype=jnp.float32) / half)
    ang = pos.astype(jnp.float32)[..., None] * inv
    cos = jnp.cos(ang)[:, :, None, :]
    sin = jnp.sin(ang)[:, :, None, :]
    x1 = x[..., :half].astype(jnp.float32)
    x2 = x[..., half:].astype(jnp.float32)
    out = jnp.concatenate([x1 * cos - x2 * sin, x2 * cos + x1 * sin], axis=-1)
    return out.astype(x.dtype)


def chunk_states(u, a):
    u_t = jnp.moveaxis(u, 1, 0)
    a_t = jnp.moveaxis(a, 1, 0)

    def step(s, inp):
        ui, ai = inp
        return ai[..., None] * s + ui, s

    _, s_prev = lax.scan(step, jnp.zeros_like(u_t[0]), (u_t, a_t))
    return jnp.moveaxis(s_prev, 0, 1)


def retention(q, k, v):
    b, s, h, d = q.shape
    dv = v.shape[-1]
    nc = s // CHUNK
    f32 = jnp.float32
    log_gamma = jnp.log1p(-jnp.exp2(-5.0 - jnp.arange(h, dtype=f32)))
    q = q.astype(f32).reshape(b, nc, CHUNK, h, d)
    k = k.astype(f32).reshape(b, nc, CHUNK, h, d) * (d ** -0.5)
    v = v.astype(f32).reshape(b, nc, CHUNK, h, dv)
    idx = jnp.arange(CHUNK, dtype=f32)
    decay = jnp.exp(log_gamma[:, None, None] * jnp.abs(idx[:, None] - idx[None, :]))
    scores = jnp.einsum('bnihd,bnjhd->bnhij', q, k) * decay
    intra = jnp.einsum('bnhij,bnjhe->bnihe', scores, v)
    k_w = jnp.exp((CHUNK - 1.0 - idx)[:, None] * log_gamma[None, :])
    u = jnp.einsum('bnjhd,jh,bnjhe->bnhde', k, k_w, v)
    a = jnp.broadcast_to(jnp.exp(CHUNK * log_gamma)[:, None], (b, nc, h, d))
    s_prev = chunk_states(u, a)
    q_w = jnp.exp((idx + 1.0)[:, None] * log_gamma[None, :])
    inter = jnp.einsum('bnihd,ih,bnhde->bnihe', q, q_w, s_prev)
    return (intra + inter).reshape(b, s, h, dv)


def mla(q_lat, kv_lat, k_rope, q_norm_w, w_uq, kv_norm_w, w_ukv, pos):
    b, s, _ = q_lat.shape
    q = (rms_norm(q_lat, q_norm_w) @ w_uq).reshape(b, s, MLA_HEADS, MLA_NOPE + MLA_ROPE)
    q_nope = q[..., :MLA_NOPE]
    q_pe = rope(q[..., MLA_NOPE:], pos)
    kv = (rms_norm(kv_lat, kv_norm_w) @ w_ukv).reshape(b, s, MLA_HEADS, MLA_NOPE + MLA_V)
    k_nope = kv[..., :MLA_NOPE]
    v = kv[..., MLA_NOPE:]
    k_pe = rope(k_rope[:, :, None, :], pos)[:, :, 0, :]
    scale = (MLA_NOPE + MLA_ROPE) ** -0.5
    key_chunk = jnp.arange(s) // CHUNK
    nb = s // Q_BLOCK
    qn_b = jnp.moveaxis(q_nope.reshape(b, nb, Q_BLOCK, MLA_HEADS, MLA_NOPE), 1, 0)
    qp_b = jnp.moveaxis(q_pe.reshape(b, nb, Q_BLOCK, MLA_HEADS, MLA_ROPE), 1, 0)
    starts = jnp.arange(nb, dtype=jnp.int32) * Q_BLOCK

    def block(args):
        qn, qp, i0 = args
        sc = (jnp.einsum('bqhd,bkhd->bhqk', qn, k_nope)
              + jnp.einsum('bqhd,bkd->bhqk', qp, k_pe)).astype(jnp.float32) * scale
        q_chunk = (i0 + jnp.arange(Q_BLOCK)) // CHUNK
        mask = key_chunk[None, :] <= q_chunk[:, None]
        sc = jnp.where(mask, sc, -jnp.inf)
        p = jax.nn.softmax(sc, axis=-1).astype(v.dtype)
        return jnp.einsum('bhqk,bkhe->bqhe', p, v)

    out = lax.map(block, (qn_b, qp_b, starts))
    return jnp.moveaxis(out, 0, 1).reshape(b, s, MLA_WIDTH)


def gla(q, k, v, g_low, w_g2, b_g2):
    b, s, h, dk = q.shape
    dv = v.shape[-1]
    nc = s // CHUNK
    f32 = jnp.float32
    log_a = jax.nn.log_sigmoid((g_low @ w_g2 + b_g2).astype(f32)) / GLA_TAU
    cum = jnp.cumsum(log_a.reshape(b, nc, CHUNK, h, dk), axis=2)
    q = q.astype(f32).reshape(b, nc, CHUNK, h, dk)
    k = k.astype(f32).reshape(b, nc, CHUNK, h, dk) * (dk ** -0.5)
    v = v.astype(f32).reshape(b, nc, CHUNK, h, dv)
    e_pos = jnp.exp(cum)
    e_neg = jnp.exp(-cum)
    q_pos = q * e_pos
    past = jnp.einsum('bnihd,bnjhd->bnhij', q_pos, k * e_neg)
    fut = jnp.einsum('bnihd,bnjhd->bnhij', q * e_neg, k * e_pos)
    idx = jnp.arange(CHUNK)
    attn = jnp.where(idx[:, None] >= idx[None, :], past, fut)
    intra = jnp.einsum('bnhij,bnjhe->bnihe', attn, v)
    last = cum[:, :, -1]
    u = jnp.einsum('bnjhd,bnjhe->bnhde', k * jnp.exp(last[:, :, None] - cum), v)
    s_prev = chunk_states(u, jnp.exp(last))
    inter = jnp.einsum('bnihd,bnhde->bnihe', q_pos, s_prev)
    return (intra + inter).reshape(b, s, h, dv)


def setup_inputs(seed: int = 0) -> dict:
    key = jax.random.key(seed)
    ks = jax.random.split(key, 16)
    f32 = jnp.float32

    def normal(k, shape, scale):
        return jax.random.normal(k, shape, f32) * scale

    def gain(k, shape):
        return 1.0 + 0.02 * jax.random.normal(k, shape, f32)

    x = normal(ks[0], (BATCH, SEQ, D_MODEL), 1.0)
    c = normal(ks[1], (BATCH, D_MODEL), 1.0)
    offset = jax.random.randint(ks[2], (BATCH, 1), 0, 4096, dtype=jnp.int32)
    positions = offset + jnp.arange(SEQ, dtype=jnp.int32)[None, :]
    norm_w = gain(ks[3], (DEPTH, D_MODEL))
    ada_w = normal(ks[4], (DEPTH, D_MODEL, 3 * D_MODEL), 0.5 * D_MODEL ** -0.5)
    ada_b = normal(ks[5], (DEPTH, 3 * D_MODEL), 0.02)
    w_in = normal(ks[6], (DEPTH, D_MODEL, IN_COLS), D_MODEL ** -0.5)
    mla_q_norm = gain(ks[7], (DEPTH, MLA_Q_RANK))
    w_uq = normal(ks[8], (DEPTH, MLA_Q_RANK, MLA_HEADS * (MLA_NOPE + MLA_ROPE)), MLA_Q_RANK ** -0.5)
    mla_kv_norm = gain(ks[9], (DEPTH, MLA_KV_RANK))
    w_ukv = normal(ks[10], (DEPTH, MLA_KV_RANK, MLA_HEADS * (MLA_NOPE + MLA_V)), MLA_KV_RANK ** -0.5)
    gla_w_g2 = normal(ks[11], (DEPTH, GLA_GATE_RANK, GLA_KWIDTH), GLA_GATE_RANK ** -0.5)
    gla_b_g2 = normal(ks[12], (DEPTH, GLA_KWIDTH), 0.02)
    gla_norm = gain(ks[13], (DEPTH, GLA_DV))
    w_out = normal(ks[14], (DEPTH, MIX_WIDTH, D_MODEL), MIX_WIDTH ** -0.5)
    final_norm = gain(ks[15], (D_MODEL,))
    return {"x": x, "c": c, "positions": positions, "norm_w": norm_w, "ada_w": ada_w,
            "ada_b": ada_b, "w_in": w_in, "mla_q_norm": mla_q_norm, "w_uq": w_uq,
            "mla_kv_norm": mla_kv_norm, "w_ukv": w_ukv, "gla_w_g2": gla_w_g2,
            "gla_b_g2": gla_b_g2, "gla_norm": gla_norm, "w_out": w_out,
            "final_norm": final_norm}


def reference(x, c, positions, norm_w, ada_w, ada_b, w_in, mla_q_norm, w_uq, mla_kv_norm,
              w_ukv, gla_w_g2, gla_b_g2, gla_norm, w_out, final_norm):
    b, s, _ = x.shape
    c_act = jax.nn.silu(c)
    for l in range(DEPTH):
        shift, scale, gate = jnp.split(c_act @ ada_w[l] + ada_b[l], 3, axis=-1)
        h = rms_norm(x, norm_w[l]) * (1.0 + scale[:, None, :]) + shift[:, None, :]
        proj = h @ w_in[l]
        ret_p, mla_p, gla_p = split_cols(proj, (sum(RET_SPLIT), sum(MLA_SPLIT), sum(GLA_SPLIT)))

        rq, rk, rv, rz = split_cols(ret_p, RET_SPLIT)
        r_o = retention(rope(to_heads(rq, RET_HEADS), positions),
                        rope(to_heads(rk, RET_HEADS), positions),
                        to_heads(rv, RET_HEADS))
        r_o = rms_norm(r_o).astype(x.dtype).reshape(b, s, RET_WIDTH)

        mq, mkv, mkr, mz = split_cols(mla_p, MLA_SPLIT)
        m_o = mla(mq, mkv, mkr, mla_q_norm[l], w_uq[l], mla_kv_norm[l], w_ukv[l], positions)

        gq, gk, gv, gg, gz = split_cols(gla_p, GLA_SPLIT)
        g_o = gla(to_heads(gq, GLA_HEADS), to_heads(gk, GLA_HEADS), to_heads(gv, GLA_HEADS),
                  gg, gla_w_g2[l], gla_b_g2[l])
        g_o = rms_norm(g_o, gla_norm[l]).astype(x.dtype).reshape(b, s, GLA_WIDTH)

        mixed = jnp.concatenate([r_o * jax.nn.silu(rz), m_o * jax.nn.silu(mz),
                                 g_o * jax.nn.silu(gz)], axis=-1)
        x = x + gate[:, None, :] * (mixed @ w_out[l])
    return rms_norm(x, final_norm)
```

```cpp
#include <hip/hip_runtime.h>
#include <cstdio>
#include <cstdint>
#include <cmath>

typedef unsigned short bf16_t;
typedef short bf16x8 __attribute__((ext_vector_type(8)));
typedef float f32x4 __attribute__((ext_vector_type(4)));
typedef unsigned u32x4 __attribute__((ext_vector_type(4)));
typedef unsigned u32x2 __attribute__((ext_vector_type(2)));

constexpr int D = 1024, NB = 32, S = 2048, T = NB * S, DEPTH = 2, CH = 64;
constexpr int NIN = 2736, NP = 2816;
constexpr float EPS = 1e-6f;
constexpr int P_RQ = 0, P_RK = 256, P_RV = 512, P_RZ = 768, P_MQ = 1024, P_MKV = 1280, P_KPE = 1408, P_GG = 1440, P_PAD = 1456,
              P_MZ = 1536, P_GQ = 2048, P_GK = 2176, P_GV = 2304, P_GZ = 2560;
constexpr float QSCALE = 0.10206207261596577f * 1.4426950408889634f;

constexpr size_t MiB = 1u << 20;
constexpr size_t WS_CTL = 0;
constexpr size_t WS_ADA = 1 * MiB;
constexpr size_t WS_CS32 = 2 * MiB;
constexpr size_t WS_CS16 = 18 * MiB;
constexpr size_t WS_WIN = 26 * MiB;
constexpr size_t WS_WUQ = 38 * MiB;
constexpr size_t WS_WUKV = 39 * MiB;
constexpr size_t WS_WOUT = 40 * MiB;
constexpr size_t WS_RSQ = 44 * MiB;
constexpr size_t WS_RSKV = 45 * MiB;
constexpr size_t WS_GG = 46 * MiB;
constexpr size_t WS_H = 50 * MiB;
constexpr size_t WS_PROJ = 178 * MiB;
constexpr size_t WS_Q = 530 * MiB;
constexpr size_t WS_KV = 626 * MiB;
constexpr size_t WS_MIX = 754 * MiB;
constexpr size_t WS_GCUM = 882 * MiB;
constexpr size_t WS_END = 914 * MiB;

__device__ __forceinline__ unsigned f2bf(float f) { unsigned u = __builtin_bit_cast(unsigned, f); return (u + 0x7fffu + ((u >> 16) & 1u)) >> 16; }
__device__ __forceinline__ unsigned pk2(float lo, float hi) { return f2bf(lo) | (f2bf(hi) << 16); }
__device__ __forceinline__ float bf2f(bf16_t v) { return __builtin_bit_cast(float, (unsigned)v << 16); }
__device__ __forceinline__ float silu_f(float x) { return x / (1.f + __expf(-x)); }

__host__ __device__ inline int in_logical(int p) {
    if (p < 512) { int c = p & 63; return (p & ~63) + (c >> 1) + 32 * (c & 1); }
    if (p < 1408) return p;
    if (p < 1440) { int c = p - 1408; return 1408 + (c >> 1) + 16 * (c & 1); }
    if (p < 1456) return 2464 + (p - 1440);
    if (p < 1536) return -1;
    if (p < 2048) return 1440 + (p - 1536);
    if (p < 2304) return 1952 + (p - 2048);
    if (p < 2560) return 2208 + (p - 2304);
    return 2480 + (p - 2560);
}
__host__ __device__ inline int uq_logical(int p) {
    int h = p / 96, c = p % 96;
    if (c < 64) return p;
    int cc = c - 64; return h * 96 + 64 + (cc >> 1) + 16 * (cc & 1);
}

__global__ __launch_bounds__(256) void k_prep(const float* __restrict__ w_in, const float* __restrict__ qnw, const float* __restrict__ w_uq,
                                              const float* __restrict__ kvnw, const float* __restrict__ w_ukv, const float* __restrict__ w_out,
                                              const int* __restrict__ pos, unsigned char* ws) {
    bf16_t* WinT = (bf16_t*)(ws + WS_WIN); bf16_t* WuqT = (bf16_t*)(ws + WS_WUQ); bf16_t* WukvT = (bf16_t*)(ws + WS_WUKV); bf16_t* WoutT = (bf16_t*)(ws + WS_WOUT);
    float2* CS32 = (float2*)(ws + WS_CS32); float2* CS16 = (float2*)(ws + WS_CS16);
    const long gsz = (long)gridDim.x * 256, g0 = (long)blockIdx.x * 256 + threadIdx.x;
    for (long i = g0; i < (long)DEPTH * NP * 1024; i += gsz) {
        int k = (int)(i & 1023); long r = i >> 10; int p = (int)(r % NP), l = (int)(r / NP);
        int lc = in_logical(p);
        float v = lc >= 0 ? w_in[((size_t)l * 1024 + k) * NIN + lc] : 0.f;
        WinT[i] = (bf16_t)f2bf(v);
    }
    for (long i = g0; i < (long)DEPTH * 768 * 256; i += gsz) {
        int k = (int)(i & 255); long r = i >> 8; int p = (int)(r % 768), l = (int)(r / 768);
        WuqT[i] = (bf16_t)f2bf(qnw[l * 256 + k] * w_uq[((size_t)l * 256 + k) * 768 + uq_logical(p)]);
    }
    for (long i = g0; i < (long)DEPTH * 1024 * 128; i += gsz) {
        int k = (int)(i & 127); long r = i >> 7; int n = (int)(r % 1024), l = (int)(r / 1024);
        WukvT[i] = (bf16_t)f2bf(kvnw[l * 128 + k] * w_ukv[((size_t)l * 128 + k) * 1024 + n]);
    }
    for (long i = g0; i < (long)DEPTH * 1024 * 1024; i += gsz) {
        int k = (int)(i & 1023); long r = i >> 10; int n = (int)(r % 1024), l = (int)(r / 1024);
        WoutT[i] = (bf16_t)f2bf(w_out[((size_t)l * 1024 + k) * 1024 + n]);
    }
    for (long i = g0; i < (long)T * 32; i += gsz) {
        int j = (int)(i & 31); int t = (int)(i >> 5);
        double inv = pow(10000.0, -(double)j / 32.0), a = (double)pos[t] * inv; double s, c; sincos(a, &s, &c);
        CS32[i] = make_float2((float)c, (float)s);
    }
    for (long i = g0; i < (long)T * 16; i += gsz) {
        int j = (int)(i & 15); int t = (int)(i >> 4);
        double inv = pow(10000.0, -(double)j / 16.0), a = (double)pos[t] * inv; double s, c; sincos(a, &s, &c);
        CS16[i] = make_float2((float)c, (float)s);
    }
}

__global__ __launch_bounds__(256) void k_ada(const float* __restrict__ c, const float* __restrict__ ada_w, const float* __restrict__ ada_b, float* __restrict__ ADA) {
    int i = blockIdx.x * 256 + threadIdx.x; if (i >= DEPTH * NB * 3072) return;
    int n = i % 3072, b = (i / 3072) % NB, l = i / (3072 * NB);
    float acc = 0.f;
    for (int k = 0; k < 1024; ++k) acc = fmaf(silu_f(c[b * 1024 + k]), ada_w[((size_t)l * 1024 + k) * 3072 + n], acc);
    ADA[i] = acc + ada_b[l * 3072 + n];
}

__device__ __forceinline__ float wave_sum(float v) {
#pragma unroll
    for (int o = 1; o < 64; o <<= 1) v += __shfl_xor(v, o);
    return v;
}

__global__ __launch_bounds__(256) void k_norm(const float* __restrict__ x, const float* __restrict__ nw, const float* __restrict__ ADA_l, bf16_t* __restrict__ H) {
    const int lane = threadIdx.x & 63; const int row = blockIdx.x * 4 + (threadIdx.x >> 6); const int b = row / S;
    const f32x4* xr = (const f32x4*)(x + (size_t)row * D) + lane;
    f32x4 v[4]; float s = 0.f;
#pragma unroll
    for (int j = 0; j < 4; ++j) { v[j] = xr[64 * j]; s += v[j].x * v[j].x + v[j].y * v[j].y + v[j].z * v[j].z + v[j].w * v[j].w; }
    const float rstd = rsqrtf(wave_sum(s) * (1.f / D) + EPS);
    const float* shift = ADA_l + (size_t)b * 3072; const float* scale = shift + 1024;
    u32x2* o = (u32x2*)(H + (size_t)row * D) + lane;
#pragma unroll
    for (int j = 0; j < 4; ++j) {
        const int c0 = 4 * lane + 256 * j; const f32x4 w = *(const f32x4*)(nw + c0), sc = *(const f32x4*)(scale + c0), sh = *(const f32x4*)(shift + c0);
        f32x4 y;
        y.x = v[j].x * rstd * w.x * (1.f + sc.x) + sh.x; y.y = v[j].y * rstd * w.y * (1.f + sc.y) + sh.y;
        y.z = v[j].z * rstd * w.z * (1.f + sc.z) + sh.z; y.w = v[j].w * rstd * w.w * (1.f + sc.w) + sh.w;
        u32x2 pk; pk.x = pk2(y.x, y.y); pk.y = pk2(y.z, y.w); o[64 * j] = pk;
    }
}

__global__ __launch_bounds__(256) void k_final(const float* x, const float* __restrict__ w, float* out) {
    const int lane = threadIdx.x & 63; const int row = blockIdx.x * 4 + (threadIdx.x >> 6);
    const f32x4* xr = (const f32x4*)(x + (size_t)row * D) + lane;
    f32x4 v[4]; float s = 0.f;
#pragma unroll
    for (int j = 0; j < 4; ++j) { v[j] = xr[64 * j]; s += v[j].x * v[j].x + v[j].y * v[j].y + v[j].z * v[j].z + v[j].w * v[j].w; }
    const float rstd = rsqrtf(wave_sum(s) * (1.f / D) + EPS);
    f32x4* o = (f32x4*)(out + (size_t)row * D) + lane;
#pragma unroll
    for (int j = 0; j < 4; ++j) { const f32x4 ww = *(const f32x4*)(w + 4 * lane + 256 * j); o[64 * j] = v[j] * rstd * ww; }
}

struct EpiIn {
    bf16_t* PROJ; float* GG; const float2* CS32; const float2* CS16;
    __device__ __forceinline__ void operator()(int row, int col, f32x4 v) const {
        if (col < 512) {
            const int j = (col & 63) >> 1; const float2 a = CS32[(size_t)row * 32 + j], b = CS32[(size_t)row * 32 + j + 1];
            f32x4 o; o.x = v.x * a.x - v.y * a.y; o.y = v.y * a.x + v.x * a.y; o.z = v.z * b.x - v.w * b.y; o.w = v.w * b.x + v.z * b.y;
            if (col >= 256) o = o * 0.125f; v = o;
        } else if (col < 768) {
        } else if (col < 1024) { v.x = silu_f(v.x); v.y = silu_f(v.y); v.z = silu_f(v.z); v.w = silu_f(v.w);
        } else if (col < 1408) {
        } else if (col < 1440) {
            const int j = (col - 1408) >> 1; const float2 a = CS16[(size_t)row * 16 + j], b = CS16[(size_t)row * 16 + j + 1];
            f32x4 o; o.x = v.x * a.x - v.y * a.y; o.y = v.y * a.x + v.x * a.y; o.z = v.z * b.x - v.w * b.y; o.w = v.w * b.x + v.z * b.y; v = o;
        } else if (col < 1456) { *(f32x4*)(GG + (size_t)row * 16 + (col - 1440)) = v; return;
        } else if (col < 1536) { return;
        } else if (col < 2048) { v.x = silu_f(v.x); v.y = silu_f(v.y); v.z = silu_f(v.z); v.w = silu_f(v.w);
        } else if (col < 2176) {
        } else if (col < 2304) { v = v * 0.17677669529663687f;
        } else if (col < 2560) {
        } else { v.x = silu_f(v.x); v.y = silu_f(v.y); v.z = silu_f(v.z); v.w = silu_f(v.w); }
        u32x2 pk; pk.x = pk2(v.x, v.y); pk.y = pk2(v.z, v.w); *(u32x2*)(PROJ + (size_t)row * NP + col) = pk;
    }
};
struct EpiQ {
    bf16_t* Q; const float* RSQ; const float2* CS16;
    __device__ __forceinline__ void operator()(int row, int col, f32x4 v) const {
        v = v * RSQ[row]; const int c = col % 96;
        if (c >= 64) { const int j = (c - 64) >> 1; const float2 a = CS16[(size_t)row * 16 + j], b = CS16[(size_t)row * 16 + j + 1];
            f32x4 o; o.x = v.x * a.x - v.y * a.y; o.y = v.y * a.x + v.x * a.y; o.z = v.z * b.x - v.w * b.y; o.w = v.w * b.x + v.z * b.y; v = o; }
        v = v * QSCALE;
        u32x2 pk; pk.x = pk2(v.x, v.y); pk.y = pk2(v.z, v.w); *(u32x2*)(Q + (size_t)row * 768 + col) = pk;
    }
};
struct EpiKV {
    bf16_t* KV; const float* RSKV;
    __device__ __forceinline__ void operator()(int row, int col, f32x4 v) const {
        v = v * RSKV[row];
        u32x2 pk; pk.x = pk2(v.x, v.y); pk.y = pk2(v.z, v.w); *(u32x2*)(KV + (size_t)row * 1024 + col) = pk;
    }
};
struct EpiOut {
    const float* xi; float* xo; const float* ADA_l;
    __device__ __forceinline__ void operator()(int row, int col, f32x4 v) const {
        const int b = row / S; const f32x4 g = *(const f32x4*)(ADA_l + (size_t)b * 3072 + 2048 + col);
        const f32x4 xv = *(const f32x4*)(xi + (size_t)row * D + col);
        *(f32x4*)(xo + (size_t)row * D + col) = xv + g * v;
    }
};

template <class Epi>
__global__ __launch_bounds__(256) void k_gemm(const bf16_t* __restrict__ A, int lda, const bf16_t* __restrict__ Bt, int K, Epi epi) {
    __shared__ __attribute__((aligned(16))) short sA[64][40];
    __shared__ __attribute__((aligned(16))) short sB[64][40];
    const int tid = threadIdx.x, lane = tid & 63, w = tid >> 6, wm = w >> 1, wn = w & 1, fr = lane & 15, fq = lane >> 4;
    const int m0 = blockIdx.y * 64, n0 = blockIdx.x * 64;
    const int lr = tid >> 2, lc = (tid & 3) * 8;
    f32x4 acc[2][2];
#pragma unroll
    for (int i = 0; i < 2; ++i)
#pragma unroll
        for (int j = 0; j < 2; ++j) acc[i][j] = (f32x4){0.f, 0.f, 0.f, 0.f};
    for (int k0 = 0; k0 < K; k0 += 32) {
        const bf16x8 av = *(const bf16x8*)(A + (size_t)(m0 + lr) * lda + k0 + lc);
        const bf16x8 bv = *(const bf16x8*)(Bt + (size_t)(n0 + lr) * K + k0 + lc);
        *(bf16x8*)&sA[lr][lc] = av; *(bf16x8*)&sB[lr][lc] = bv;
        __syncthreads();
        bf16x8 a[2], b[2];
#pragma unroll
        for (int i = 0; i < 2; ++i) { a[i] = *(const bf16x8*)&sA[32 * wm + 16 * i + fr][fq * 8]; b[i] = *(const bf16x8*)&sB[32 * wn + 16 * i + fr][fq * 8]; }
#pragma unroll
        for (int i = 0; i < 2; ++i)
#pragma unroll
            for (int j = 0; j < 2; ++j) acc[i][j] = __builtin_amdgcn_mfma_f32_16x16x32_bf16(b[j], a[i], acc[i][j], 0, 0, 0);
        __syncthreads();
    }
#pragma unroll
    for (int i = 0; i < 2; ++i)
#pragma unroll
        for (int j = 0; j < 2; ++j) epi(m0 + 32 * wm + 16 * i + fr, n0 + 32 * wn + 16 * j + 4 * fq, acc[i][j]);
}

__global__ __launch_bounds__(256) void k_rstd(const bf16_t* __restrict__ PROJ, float* __restrict__ RSQ, float* __restrict__ RSKV) {
    const int lane = threadIdx.x & 63; const int row = blockIdx.x * 4 + (threadIdx.x >> 6);
    const bf16_t* p = PROJ + (size_t)row * NP;
    float s = 0.f;
#pragma unroll
    for (int j = 0; j < 4; ++j) { const float v = bf2f(p[P_MQ + lane + 64 * j]); s += v * v; }
    s = wave_sum(s);
    float s2 = 0.f;
#pragma unroll
    for (int j = 0; j < 2; ++j) { const float v = bf2f(p[P_MKV + lane + 64 * j]); s2 += v * v; }
    s2 = wave_sum(s2);
    if (lane == 0) { RSQ[row] = rsqrtf(s * (1.f / 256.f) + EPS); RSKV[row] = rsqrtf(s2 * (1.f / 128.f) + EPS); }
}

__global__ __launch_bounds__(256) void k_attn_naive(const bf16_t* __restrict__ Q, const bf16_t* __restrict__ KV, const bf16_t* __restrict__ PROJ, bf16_t* __restrict__ MIX) {
    const int lane = threadIdx.x & 63; const int W = __builtin_amdgcn_readfirstlane(blockIdx.x * 4 + (threadIdx.x >> 6));
    const int cg = W >> 3, h = W & 7; const int t = cg * 64 + lane; const int b = (cg * 64) / S; const int nk = ((cg * 64) % S) + 64; const int kb = b * S;
    float q[96];
    const bf16_t* qp = Q + (size_t)t * 768 + h * 96;
#pragma unroll
    for (int d = 0; d < 96; ++d) q[d] = bf2f(qp[d]);
    float o[64];
#pragma unroll
    for (int e = 0; e < 64; ++e) o[e] = 0.f;
    float m = -1e30f, l = 0.f;
    for (int j = 0; j < nk; ++j) {
        const bf16_t* kn = KV + (size_t)(kb + j) * 1024 + h * 128; const bf16_t* kp = PROJ + (size_t)(kb + j) * NP + P_KPE;
        float s = 0.f;
#pragma unroll
        for (int d = 0; d < 64; ++d) s = fmaf(q[d], bf2f(kn[d]), s);
#pragma unroll
        for (int d = 0; d < 32; ++d) s = fmaf(q[64 + d], bf2f(kp[d]), s);
        const float mn = fmaxf(m, s); const float sc = exp2f(m - mn), p = exp2f(s - mn); m = mn; l = l * sc + p;
#pragma unroll
        for (int e = 0; e < 64; ++e) o[e] = o[e] * sc + p * bf2f(kn[64 + e]);
    }
    const float rl = 1.f / l;
    const bf16_t* z = PROJ + (size_t)t * NP + P_MZ + h * 64; bf16_t* mo = MIX + (size_t)t * 1024 + 256 + h * 64;
#pragma unroll
    for (int e = 0; e < 64; ++e) mo[e] = (bf16_t)f2bf(o[e] * rl * bf2f(z[e]));
}

__global__ __launch_bounds__(256) void k_ret_naive(const bf16_t* __restrict__ PROJ, bf16_t* __restrict__ MIX) {
    const int lane = threadIdx.x & 63; const int W = __builtin_amdgcn_readfirstlane(blockIdx.x * 4 + (threadIdx.x >> 6));
    const int cg = W >> 2, h = W & 3; const int t = cg * 64 + lane; const int b = (cg * 64) / S; const int nk = ((cg * 64) % S) + 64; const int kb = b * S;
    const float lg = log1pf(-exp2f(-5.f - (float)h));
    float q[64];
    const bf16_t* qp = PROJ + (size_t)t * NP + P_RQ + h * 64;
#pragma unroll
    for (int d = 0; d < 64; ++d) q[d] = bf2f(qp[d]);
    float o[64];
#pragma unroll
    for (int e = 0; e < 64; ++e) o[e] = 0.f;
    const int ti = t - kb;
    for (int j = 0; j < nk; ++j) {
        const bf16_t* kr = PROJ + (size_t)(kb + j) * NP + P_RK + h * 64; const bf16_t* vr = PROJ + (size_t)(kb + j) * NP + P_RV + h * 64;
        float s = 0.f;
#pragma unroll
        for (int d = 0; d < 64; ++d) s = fmaf(q[d], bf2f(kr[d]), s);
        const int dd = ti - j; s *= __expf(lg * (float)(dd < 0 ? -dd : dd));
#pragma unroll
        for (int e = 0; e < 64; ++e) o[e] = fmaf(s, bf2f(vr[e]), o[e]);
    }
    float ss = 0.f;
#pragma unroll
    for (int e = 0; e < 64; ++e) ss += o[e] * o[e];
    const float rstd = rsqrtf(ss * (1.f / 64.f) + EPS);
    const bf16_t* z = PROJ + (size_t)t * NP + P_RZ + h * 64; bf16_t* mo = MIX + (size_t)t * 1024 + h * 64;
#pragma unroll
    for (int e = 0; e < 64; ++e) mo[e] = (bf16_t)f2bf(o[e] * rstd * bf2f(z[e]));
}

__global__ __launch_bounds__(256) void k_gla_la(const float* __restrict__ GG, const float* __restrict__ w_g2, const float* __restrict__ b_g2, float* __restrict__ G) {
    const long i = (long)blockIdx.x * 256 + threadIdx.x; const int n = (int)(i & 127); const long t = i >> 7;
    float z = b_g2[n];
#pragma unroll
    for (int r = 0; r < 16; ++r) z = fmaf(GG[t * 16 + r], w_g2[r * 128 + n], z);
    const float ls = fminf(z, 0.f) - log1pf(__expf(-fabsf(z)));
    G[i] = ls * (1.f / 16.f);
}
__global__ __launch_bounds__(128) void k_gla_cum(float* __restrict__ G) {
    const int b = blockIdx.x, n = threadIdx.x; float acc = 0.f;
    for (int s = 0; s < S; ++s) { const size_t i = ((size_t)b * S + s) * 128 + n; acc += G[i]; G[i] = acc; }
}
__global__ __launch_bounds__(256) void k_gla_naive(const bf16_t* __restrict__ PROJ, const float* __restrict__ G, const float* __restrict__ gnw, bf16_t* __restrict__ MIX) {
    const int lane = threadIdx.x & 63; const int W = __builtin_amdgcn_readfirstlane(blockIdx.x * 4 + (threadIdx.x >> 6));
    const int cg = W >> 2, h = W & 3; const int t = cg * 64 + lane; const int b = (cg * 64) / S; const int nk = ((cg * 64) % S) + 64; const int kb = b * S;
    float q[32], gi[32];
    const bf16_t* qp = PROJ + (size_t)t * NP + P_GQ + h * 32;
#pragma unroll
    for (int d = 0; d < 32; ++d) { q[d] = bf2f(qp[d]); gi[d] = G[(size_t)t * 128 + h * 32 + d]; }
    float o[64];
#pragma unroll
    for (int e = 0; e < 64; ++e) o[e] = 0.f;
    for (int j = 0; j < nk; ++j) {
        const bf16_t* kr = PROJ + (size_t)(kb + j) * NP + P_GK + h * 32; const bf16_t* vr = PROJ + (size_t)(kb + j) * NP + P_GV + h * 64;
        const float* gj = G + (size_t)(kb + j) * 128 + h * 32;
        float s = 0.f;
#pragma unroll
        for (int d = 0; d < 32; ++d) s = fmaf(q[d] * bf2f(kr[d]), __expf(-fabsf(gi[d] - gj[d])), s);
#pragma unroll
        for (int e = 0; e < 64; ++e) o[e] = fmaf(s, bf2f(vr[e]), o[e]);
    }
    float ss = 0.f;
#pragma unroll
    for (int e = 0; e < 64; ++e) ss += o[e] * o[e];
    const float rstd = rsqrtf(ss * (1.f / 64.f) + EPS);
    const bf16_t* z = PROJ + (size_t)t * NP + P_GZ + h * 64; bf16_t* mo = MIX + (size_t)t * 1024 + 768 + h * 64;
#pragma unroll
    for (int e = 0; e < 64; ++e) mo[e] = (bf16_t)f2bf(o[e] * rstd * gnw[e] * bf2f(z[e]));
}

extern "C" void kernel_launch(void* const* d_in, const int* in_sizes, int n_in, void* d_out, int out_size, void* d_ws, size_t ws_size, hipStream_t stream) {
    if (n_in != 16 || in_sizes[0] != T * D || out_size != T * D || ws_size < WS_END) {
        fprintf(stderr, "kernel_launch: shape/ws mismatch n_in %d in0 %d out %d ws %zu (need %zu)\n", n_in, n_in > 0 ? in_sizes[0] : -1, out_size, ws_size, (size_t)WS_END);
        return;
    }
    const float* x = (const float*)d_in[0]; const float* c = (const float*)d_in[1]; const int* pos = (const int*)d_in[2];
    const float* norm_w = (const float*)d_in[3]; const float* ada_w = (const float*)d_in[4]; const float* ada_b = (const float*)d_in[5];
    const float* w_in = (const float*)d_in[6]; const float* qnw = (const float*)d_in[7]; const float* w_uq = (const float*)d_in[8];
    const float* kvnw = (const float*)d_in[9]; const float* w_ukv = (const float*)d_in[10]; const float* w_g2 = (const float*)d_in[11];
    const float* b_g2 = (const float*)d_in[12]; const float* gnw = (const float*)d_in[13]; const float* w_out = (const float*)d_in[14];
    const float* fnw = (const float*)d_in[15];
    unsigned char* ws = (unsigned char*)d_ws; float* out = (float*)d_out;
    float* ADA = (float*)(ws + WS_ADA); float2* CS32 = (float2*)(ws + WS_CS32); float2* CS16 = (float2*)(ws + WS_CS16);
    bf16_t* WinT = (bf16_t*)(ws + WS_WIN); bf16_t* WuqT = (bf16_t*)(ws + WS_WUQ); bf16_t* WukvT = (bf16_t*)(ws + WS_WUKV); bf16_t* WoutT = (bf16_t*)(ws + WS_WOUT);
    float* RSQ = (float*)(ws + WS_RSQ); float* RSKV = (float*)(ws + WS_RSKV); float* GG = (float*)(ws + WS_GG);
    bf16_t* H = (bf16_t*)(ws + WS_H); bf16_t* PROJ = (bf16_t*)(ws + WS_PROJ); bf16_t* Q = (bf16_t*)(ws + WS_Q); bf16_t* KV = (bf16_t*)(ws + WS_KV); bf16_t* MIX = (bf16_t*)(ws + WS_MIX);
    float* GC = (float*)(ws + WS_GCUM);

    hipLaunchKernelGGL(k_prep, dim3(4096), dim3(256), 0, stream, w_in, qnw, w_uq, kvnw, w_ukv, w_out, pos, ws);
    hipLaunchKernelGGL(k_ada, dim3(DEPTH * NB * 3072 / 256), dim3(256), 0, stream, c, ada_w, ada_b, ADA);
    for (int l = 0; l < DEPTH; ++l) {
        const float* xin = (l == 0) ? x : out;
        const float* ADA_l = ADA + (size_t)l * NB * 3072;
        hipLaunchKernelGGL(k_norm, dim3(T / 4), dim3(256), 0, stream, xin, norm_w + l * D, ADA_l, H);
        hipLaunchKernelGGL(k_gemm<EpiIn>, dim3(NP / 64, T / 64), dim3(256), 0, stream, (const bf16_t*)H, D, (const bf16_t*)(WinT + (size_t)l * NP * 1024), 1024, EpiIn{PROJ, GG, CS32, CS16});
        hipLaunchKernelGGL(k_rstd, dim3(T / 4), dim3(256), 0, stream, (const bf16_t*)PROJ, RSQ, RSKV);
        hipLaunchKernelGGL(k_gemm<EpiQ>, dim3(768 / 64, T / 64), dim3(256), 0, stream, (const bf16_t*)(PROJ + P_MQ), NP, (const bf16_t*)(WuqT + (size_t)l * 768 * 256), 256, EpiQ{Q, RSQ, CS16});
        hipLaunchKernelGGL(k_gemm<EpiKV>, dim3(1024 / 64, T / 64), dim3(256), 0, stream, (const bf16_t*)(PROJ + P_MKV), NP, (const bf16_t*)(WukvT + (size_t)l * 1024 * 128), 128, EpiKV{KV, RSKV});
        hipLaunchKernelGGL(k_attn_naive, dim3(T / 64 * 8 / 4), dim3(256), 0, stream, (const bf16_t*)Q, (const bf16_t*)KV, (const bf16_t*)PROJ, MIX);
        hipLaunchKernelGGL(k_ret_naive, dim3(T / 64 * 4 / 4), dim3(256), 0, stream, (const bf16_t*)PROJ, MIX);
        hipLaunchKernelGGL(k_gla_la, dim3(T * 128 / 256), dim3(256), 0, stream, (const float*)GG, w_g2 + (size_t)l * 16 * 128, b_g2 + l * 128, GC);
        hipLaunchKernelGGL(k_gla_cum, dim3(NB), dim3(128), 0, stream, GC);
        hipLaunchKernelGGL(k_gla_naive, dim3(T / 64 * 4 / 4), dim3(256), 0, stream, (const bf16_t*)PROJ, (const float*)GC, gnw + l * 64, MIX);
        hipLaunchKernelGGL(k_gemm<EpiOut>, dim3(1024 / 64, T / 64), dim3(256), 0, stream, (const bf16_t*)MIX, 1024, (const bf16_t*)(WoutT + (size_t)l * 1024 * 1024), 1024, EpiOut{xin, out, ADA_l});
    }
    hipLaunchKernelGGL(k_final, dim3(T / 4), dim3(256), 0, stream, (const float*)out, fnw, out);
}
```

```cpp
#include <hip/hip_runtime.h>
#include <hip/hip_cooperative_groups.h>
namespace cg = cooperative_groups;
#include <cstdio>
#include <cstdint>
#include <cmath>

typedef unsigned short bf16_t;
typedef short bf16x8 __attribute__((ext_vector_type(8)));
typedef float f32x4 __attribute__((ext_vector_type(4)));
typedef unsigned u32x4 __attribute__((ext_vector_type(4)));
typedef unsigned u32x2 __attribute__((ext_vector_type(2)));

constexpr int D = 1024, NB = 32, S = 2048, T = NB * S, DEPTH = 2, CH = 64;
constexpr int NIN = 2736, NP = 2816;
constexpr float EPS = 1e-6f;
constexpr int P_RQ = 0, P_RK = 256, P_RV = 512, P_RZ = 768, P_MQ = 1024, P_MKV = 1280, P_KPE = 1408, P_GG = 1440, P_PAD = 1456,
              P_MZ = 1536, P_GQ = 2048, P_GK = 2176, P_GV = 2304, P_GZ = 2560;
constexpr float QSCALE = 0.10206207261596577f * 1.4426950408889634f;

constexpr size_t MiB = 1u << 20;
constexpr size_t WS_CTL = 0;
constexpr size_t WS_ADA = 1 * MiB;
constexpr size_t WS_CS32 = 2 * MiB;
constexpr size_t WS_CS16 = 18 * MiB;
constexpr size_t WS_WIN = 26 * MiB;
constexpr size_t WS_WUQ = 38 * MiB;
constexpr size_t WS_WUKV = 39 * MiB;
constexpr size_t WS_WOUT = 40 * MiB;
constexpr size_t WS_RSQ = 44 * MiB;
constexpr size_t WS_RSKV = 45 * MiB;
constexpr size_t WS_GG = 46 * MiB;
constexpr size_t WS_H = 50 * MiB;
constexpr size_t WS_PROJ = 178 * MiB;
constexpr size_t WS_Q = 530 * MiB;
constexpr size_t WS_KV = 626 * MiB;
constexpr size_t WS_MIX = 754 * MiB;
constexpr size_t WS_GCUM = 882 * MiB;
constexpr size_t WS_END = 914 * MiB;

__device__ __forceinline__ unsigned f2bf(float f) { unsigned u = __builtin_bit_cast(unsigned, f); return (u + 0x7fffu + ((u >> 16) & 1u)) >> 16; }
__device__ __forceinline__ unsigned pk2(float lo, float hi) { return f2bf(lo) | (f2bf(hi) << 16); }
__device__ __forceinline__ float bf2f(bf16_t v) { return __builtin_bit_cast(float, (unsigned)v << 16); }
__device__ __forceinline__ float silu_f(float x) { return x / (1.f + __expf(-x)); }

__host__ __device__ inline int in_logical(int p) {
    if (p < 512) { int c = p & 63; return (p & ~63) + (c >> 1) + 32 * (c & 1); }
    if (p < 1408) return p;
    if (p < 1440) { int c = p - 1408; return 1408 + (c >> 1) + 16 * (c & 1); }
    if (p < 1456) return 2464 + (p - 1440);
    if (p < 1536) return -1;
    if (p < 2048) return 1440 + (p - 1536);
    if (p < 2304) return 1952 + (p - 2048);
    if (p < 2560) return 2208 + (p - 2304);
    return 2480 + (p - 2560);
}
__host__ __device__ inline int uq_logical(int p) {
    int h = p / 96, c = p % 96;
    if (c < 64) return p;
    int cc = c - 64; return h * 96 + 64 + (cc >> 1) + 16 * (cc & 1);
}

struct Params {
    const float* x; const float* c; const int* pos; const float* norm_w; const float* ada_w; const float* ada_b; const float* w_in; const float* qnw;
    const float* w_uq; const float* kvnw; const float* w_ukv; const float* w_g2; const float* b_g2; const float* gnw; const float* w_out; const float* fnw;
    float* out; unsigned char* ws;
};
struct Ctx { int tid, lane, wave, gw, NGW; long gt, GT; };
__device__ __forceinline__ Ctx fresh(const Ctx& c) { Ctx r = c; asm volatile("" : "+v"(r.lane), "+v"(r.tid)); asm volatile("" : "+s"(r.gw)); r.gt = (long)blockIdx.x * 512 + r.tid; return r; }

__device__ __forceinline__ float wave_sum(float v) {
#pragma unroll
    for (int o = 1; o < 64; o <<= 1) v += __shfl_xor(v, o);
    return v;
}

__device__ __forceinline__ void ph_prep(const Params& p, const Ctx& c) {
    unsigned char* ws = p.ws;
    bf16_t* WinT = (bf16_t*)(ws + WS_WIN); bf16_t* WuqT = (bf16_t*)(ws + WS_WUQ); bf16_t* WukvT = (bf16_t*)(ws + WS_WUKV); bf16_t* WoutT = (bf16_t*)(ws + WS_WOUT);
    float2* CS32 = (float2*)(ws + WS_CS32); float2* CS16 = (float2*)(ws + WS_CS16); float* ADA = (float*)(ws + WS_ADA);
    const long gsz = c.GT, g0 = c.gt;
    for (long i = g0; i < (long)DEPTH * NP * 1024; i += gsz) {
        int k = (int)(i & 1023); long r = i >> 10; int pp = (int)(r % NP), l = (int)(r / NP);
        int lc = in_logical(pp);
        float v = lc >= 0 ? p.w_in[((size_t)l * 1024 + k) * NIN + lc] : 0.f;
        WinT[i] = (bf16_t)f2bf(v);
    }
    for (long i = g0; i < (long)DEPTH * 768 * 256; i += gsz) {
        int k = (int)(i & 255); long r = i >> 8; int pp = (int)(r % 768), l = (int)(r / 768);
        WuqT[i] = (bf16_t)f2bf(p.qnw[l * 256 + k] * p.w_uq[((size_t)l * 256 + k) * 768 + uq_logical(pp)]);
    }
    for (long i = g0; i < (long)DEPTH * 1024 * 128; i += gsz) {
        int k = (int)(i & 127); long r = i >> 7; int n = (int)(r % 1024), l = (int)(r / 1024);
        WukvT[i] = (bf16_t)f2bf(p.kvnw[l * 128 + k] * p.w_ukv[((size_t)l * 128 + k) * 1024 + n]);
    }
    for (long i = g0; i < (long)DEPTH * 1024 * 1024; i += gsz) {
        int k = (int)(i & 1023); long r = i >> 10; int n = (int)(r % 1024), l = (int)(r / 1024);
        WoutT[i] = (bf16_t)f2bf(p.w_out[((size_t)l * 1024 + k) * 1024 + n]);
    }
    for (long i = g0; i < (long)T * 32; i += gsz) {
        int j = (int)(i & 31); int t = (int)(i >> 5);
        double inv = pow(10000.0, -(double)j / 32.0), a = (double)p.pos[t] * inv; double s, cc; sincos(a, &s, &cc);
        CS32[i] = make_float2((float)cc, (float)s);
    }
    for (long i = g0; i < (long)T * 16; i += gsz) {
        int j = (int)(i & 15); int t = (int)(i >> 4);
        double inv = pow(10000.0, -(double)j / 16.0), a = (double)p.pos[t] * inv; double s, cc; sincos(a, &s, &cc);
        CS16[i] = make_float2((float)cc, (float)s);
    }
    for (long i = g0; i < (long)DEPTH * NB * 3072; i += gsz) {
        int n = (int)(i % 3072), b = (int)((i / 3072) % NB), l = (int)(i / (3072 * NB));
        float acc = 0.f;
        for (int k = 0; k < 1024; ++k) acc = fmaf(silu_f(p.c[b * 1024 + k]), p.ada_w[((size_t)l * 1024 + k) * 3072 + n], acc);
        ADA[i] = acc + p.ada_b[l * 3072 + n];
    }
}

__device__ __forceinline__ void ph_norm(const Ctx& c, const float* x, const float* nw, const float* ADA_l, bf16_t* H) {
    const int lane = c.lane;
    for (int row = c.gw; row < T; row += c.NGW) {
        const int b = row / S;
        const f32x4* xr = (const f32x4*)(x + (size_t)row * D) + lane;
        f32x4 v[4]; float s = 0.f;
#pragma unroll
        for (int j = 0; j < 4; ++j) { v[j] = xr[64 * j]; s += v[j].x * v[j].x + v[j].y * v[j].y + v[j].z * v[j].z + v[j].w * v[j].w; }
        const float rstd = rsqrtf(wave_sum(s) * (1.f / D) + EPS);
        const float* shift = ADA_l + (size_t)b * 3072; const float* scale = shift + 1024;
        u32x2* o = (u32x2*)(H + (size_t)row * D) + lane;
#pragma unroll
        for (int j = 0; j < 4; ++j) {
            const int c0 = 4 * lane + 256 * j; const f32x4 w = *(const f32x4*)(nw + c0), sc = *(const f32x4*)(scale + c0), sh = *(const f32x4*)(shift + c0);
            f32x4 y;
            y.x = v[j].x * rstd * w.x * (1.f + sc.x) + sh.x; y.y = v[j].y * rstd * w.y * (1.f + sc.y) + sh.y;
            y.z = v[j].z * rstd * w.z * (1.f + sc.z) + sh.z; y.w = v[j].w * rstd * w.w * (1.f + sc.w) + sh.w;
            u32x2 pk; pk.x = pk2(y.x, y.y); pk.y = pk2(y.z, y.w); o[64 * j] = pk;
        }
    }
}

__device__ __forceinline__ void ph_final(const Ctx& c, const float* x, const float* w, float* out) {
    const int lane = c.lane;
    for (int row = c.gw; row < T; row += c.NGW) {
        const f32x4* xr = (const f32x4*)(x + (size_t)row * D) + lane;
        f32x4 v[4]; float s = 0.f;
#pragma unroll
        for (int j = 0; j < 4; ++j) { v[j] = xr[64 * j]; s += v[j].x * v[j].x + v[j].y * v[j].y + v[j].z * v[j].z + v[j].w * v[j].w; }
        const float rstd = rsqrtf(wave_sum(s) * (1.f / D) + EPS);
        f32x4* o = (f32x4*)(out + (size_t)row * D) + lane;
#pragma unroll
        for (int j = 0; j < 4; ++j) { const f32x4 ww = *(const f32x4*)(w + 4 * lane + 256 * j); o[64 * j] = v[j] * rstd * ww; }
    }
}

__device__ __forceinline__ f32x4 rope4(f32x4 v, float2 a, float2 b) { f32x4 o; o.x = v.x * a.x - v.y * a.y; o.y = v.y * a.x + v.x * a.y; o.z = v.z * b.x - v.w * b.y; o.w = v.w * b.x + v.z * b.y; return o; }
__device__ __forceinline__ f32x4 silu4(f32x4 v) { v.x = silu_f(v.x); v.y = silu_f(v.y); v.z = silu_f(v.z); v.w = silu_f(v.w); return v; }
struct EpiIn {
    bf16_t* PROJ; float* GG; const float2* CS32; const float2* CS16;
    __device__ __forceinline__ void operator()(int row, int col, f32x4 v) const {
        if (col < 512) {
            const int j = (col & 63) >> 1; v = rope4(v, CS32[(size_t)row * 32 + j], CS32[(size_t)row * 32 + j + 1]);
            if (col >= 256) v = v * 0.125f;
        } else if (col < 768) {
        } else if (col < 1024) { v = silu4(v);
        } else if (col < 1408) {
        } else if (col < 1440) {
            const int j = (col - 1408) >> 1; v = rope4(v, CS16[(size_t)row * 16 + j], CS16[(size_t)row * 16 + j + 1]);
        } else if (col < 1456) { *(f32x4*)(GG + (size_t)row * 16 + (col - 1440)) = v; return;
        } else if (col < 1536) { return;
        } else if (col < 2048) { v = silu4(v);
        } else if (col < 2176) {
        } else if (col < 2304) { v = v * 0.17677669529663687f;
        } else if (col < 2560) {
        } else { v = silu4(v); }
        u32x2 pk; pk.x = pk2(v.x, v.y); pk.y = pk2(v.z, v.w); *(u32x2*)(PROJ + (size_t)row * NP + col) = pk;
    }
};
struct EpiQ {
    bf16_t* Q; const float* RSQ; const float2* CS16;
    __device__ __forceinline__ void operator()(int row, int col, f32x4 v) const {
        v = v * RSQ[row]; const int cc = col % 96;
        if (cc >= 64) { const int j = (cc - 64) >> 1; v = rope4(v, CS16[(size_t)row * 16 + j], CS16[(size_t)row * 16 + j + 1]); }
        v = v * QSCALE;
        u32x2 pk; pk.x = pk2(v.x, v.y); pk.y = pk2(v.z, v.w); *(u32x2*)(Q + (size_t)row * 768 + col) = pk;
    }
};
struct EpiKV {
    bf16_t* KV; const float* RSKV;
    __device__ __forceinline__ void operator()(int row, int col, f32x4 v) const {
        v = v * RSKV[row];
        u32x2 pk; pk.x = pk2(v.x, v.y); pk.y = pk2(v.z, v.w); *(u32x2*)(KV + (size_t)row * 1024 + col) = pk;
    }
};
struct EpiOut {
    const float* xi; float* xo; const float* ADA_l;
    __device__ __forceinline__ void operator()(int row, int col, f32x4 v) const {
        const int b = row / S; const f32x4 g = *(const f32x4*)(ADA_l + (size_t)b * 3072 + 2048 + col);
        const f32x4 xv = *(const f32x4*)(xi + (size_t)row * D + col);
        *(f32x4*)(xo + (size_t)row * D + col) = xv + g * v;
    }
};

template <class Epi>
__device__ __forceinline__ void gemm_wave(const Ctx& c, const bf16_t* A, int lda, const bf16_t* Bt, int M, int N, int K, const Epi& epi) {
    const int fr = c.lane & 15, fq = c.lane >> 4; const int ntn = N / 64, nt = (M / 32) * ntn;
    for (int tile = c.gw; tile < nt; tile += c.NGW) {
        const int m0 = (tile / ntn) * 32, n0 = (tile % ntn) * 64;
        f32x4 acc[2][4];
#pragma unroll
        for (int i = 0; i < 2; ++i)
#pragma unroll
            for (int j = 0; j < 4; ++j) acc[i][j] = (f32x4){0.f, 0.f, 0.f, 0.f};
        const bf16_t* ap = A + (size_t)(m0 + fr) * lda + fq * 8; const bf16_t* bp = Bt + (size_t)(n0 + fr) * K + fq * 8;
        for (int k0 = 0; k0 < K; k0 += 32) {
            bf16x8 a[2], b[4];
#pragma unroll
            for (int i = 0; i < 2; ++i) a[i] = *(const bf16x8*)(ap + (size_t)(16 * i) * lda + k0);
#pragma unroll
            for (int j = 0; j < 4; ++j) b[j] = *(const bf16x8*)(bp + (size_t)(16 * j) * K + k0);
#pragma unroll
            for (int i = 0; i < 2; ++i)
#pragma unroll
                for (int j = 0; j < 4; ++j) acc[i][j] = __builtin_amdgcn_mfma_f32_16x16x32_bf16(b[j], a[i], acc[i][j], 0, 0, 0);
        }
#pragma unroll
        for (int i = 0; i < 2; ++i)
#pragma unroll
            for (int j = 0; j < 4; ++j) epi(m0 + 16 * i + fr, n0 + 16 * j + 4 * fq, acc[i][j]);
    }
}

__device__ __forceinline__ void ph_rstd(const Ctx& c, const bf16_t* PROJ, float* RSQ, float* RSKV) {
    const int lane = c.lane;
    for (int row = c.gw; row < T; row += c.NGW) {
        const bf16_t* p = PROJ + (size_t)row * NP;
        float s = 0.f;
#pragma unroll
        for (int j = 0; j < 4; ++j) { const float v = bf2f(p[P_MQ + lane + 64 * j]); s += v * v; }
        s = wave_sum(s);
        float s2 = 0.f;
#pragma unroll
        for (int j = 0; j < 2; ++j) { const float v = bf2f(p[P_MKV + lane + 64 * j]); s2 += v * v; }
        s2 = wave_sum(s2);
        if (lane == 0) { RSQ[row] = rsqrtf(s * (1.f / 256.f) + EPS); RSKV[row] = rsqrtf(s2 * (1.f / 128.f) + EPS); }
    }
}

__device__ __forceinline__ void ph_attn_naive(const Ctx& c, const bf16_t* Q, const bf16_t* KV, const bf16_t* PROJ, bf16_t* MIX) {
    const int lane = c.lane;
    for (int W = c.gw; W < (T / 64) * 16; W += c.NGW) {
        const int cgk = W >> 4, h = (W >> 1) & 7, vh = W & 1; const int t = cgk * 64 + lane; const int b = (cgk * 64) / S; const int nk = ((cgk * 64) % S) + 64; const int kb = b * S;
        float q[96];
        const bf16_t* qp = Q + (size_t)t * 768 + h * 96;
#pragma unroll
        for (int d = 0; d < 96; ++d) q[d] = bf2f(qp[d]);
        float o[32];
#pragma unroll
        for (int e = 0; e < 32; ++e) o[e] = 0.f;
        float m = -1e30f, l = 0.f;
        for (int j = 0; j < nk; ++j) {
            const bf16_t* kn = KV + (size_t)(kb + j) * 1024 + h * 128; const bf16_t* kp = PROJ + (size_t)(kb + j) * NP + P_KPE;
            float s = 0.f;
#pragma unroll
            for (int d = 0; d < 64; ++d) s = fmaf(q[d], bf2f(kn[d]), s);
#pragma unroll
            for (int d = 0; d < 32; ++d) s = fmaf(q[64 + d], bf2f(kp[d]), s);
            const float mn = fmaxf(m, s); const float sc = exp2f(m - mn), pp = exp2f(s - mn); m = mn; l = l * sc + pp;
#pragma unroll
            for (int e = 0; e < 32; ++e) o[e] = o[e] * sc + pp * bf2f(kn[64 + vh * 32 + e]);
        }
        const float rl = 1.f / l;
        const bf16_t* z = PROJ + (size_t)t * NP + P_MZ + h * 64 + vh * 32; bf16_t* mo = MIX + (size_t)t * 1024 + 256 + h * 64 + vh * 32;
#pragma unroll
        for (int e = 0; e < 32; ++e) mo[e] = (bf16_t)f2bf(o[e] * rl * bf2f(z[e]));
    }
}

__device__ __forceinline__ void ph_ret_naive(const Ctx& c, const bf16_t* PROJ, bf16_t* MIX) {
    const int lane = c.lane;
    for (int W = c.gw; W < (T / 64) * 4; W += c.NGW) {
        const int cgk = W >> 2, h = W & 3; const int t = cgk * 64 + lane; const int b = (cgk * 64) / S; const int nk = ((cgk * 64) % S) + 64; const int kb = b * S;
        const float lg = log1pf(-exp2f(-5.f - (float)h));
        float q[64];
        const bf16_t* qp = PROJ + (size_t)t * NP + P_RQ + h * 64;
#pragma unroll
        for (int d = 0; d < 64; ++d) q[d] = bf2f(qp[d]);
        float o[64];
#pragma unroll
        for (int e = 0; e < 64; ++e) o[e] = 0.f;
        const int ti = t - kb;
        for (int j = 0; j < nk; ++j) {
            const bf16_t* kr = PROJ + (size_t)(kb + j) * NP + P_RK + h * 64; const bf16_t* vr = PROJ + (size_t)(kb + j) * NP + P_RV + h * 64;
            float s = 0.f;
#pragma unroll
            for (int d = 0; d < 64; ++d) s = fmaf(q[d], bf2f(kr[d]), s);
            const int dd = ti - j; s *= __expf(lg * (float)(dd < 0 ? -dd : dd));
#pragma unroll
            for (int e = 0; e < 64; ++e) o[e] = fmaf(s, bf2f(vr[e]), o[e]);
        }
        float ss = 0.f;
#pragma unroll
        for (int e = 0; e < 64; ++e) ss += o[e] * o[e];
        const float rstd = rsqrtf(ss * (1.f / 64.f) + EPS);
        const bf16_t* z = PROJ + (size_t)t * NP + P_RZ + h * 64; bf16_t* mo = MIX + (size_t)t * 1024 + h * 64;
#pragma unroll
        for (int e = 0; e < 64; ++e) mo[e] = (bf16_t)f2bf(o[e] * rstd * bf2f(z[e]));
    }
}

__device__ __forceinline__ void ph_gla_la(const Ctx& c, const float* GG, const float* w_g2, const float* b_g2, float* G) {
    for (long i = c.gt; i < (long)T * 128; i += c.GT) {
        const int n = (int)(i & 127); const long t = i >> 7;
        float z = b_g2[n];
#pragma unroll
        for (int r = 0; r < 16; ++r) z = fmaf(GG[t * 16 + r], w_g2[r * 128 + n], z);
        const float ls = fminf(z, 0.f) - log1pf(__expf(-fabsf(z)));
        G[i] = ls * (1.f / 16.f);
    }
}
__device__ __forceinline__ void ph_gla_cum(const Ctx& c, float* G) {
    if (c.gt < NB * 128) {
        const int b = (int)(c.gt >> 7), n = (int)(c.gt & 127); float acc = 0.f;
        for (int s = 0; s < S; ++s) { const size_t i = ((size_t)b * S + s) * 128 + n; acc += G[i]; G[i] = acc; }
    }
}
__device__ __forceinline__ void ph_gla_naive(const Ctx& c, const bf16_t* PROJ, const float* G, const float* gnw, bf16_t* MIX, float* ldsf) {
    const int lane = c.lane;
    for (int W = c.gw; W < (T / 64) * 4; W += c.NGW) {
        const int cgk = W >> 2, h = W & 3; const int t = cgk * 64 + lane; const int b = (cgk * 64) / S; const int nk = ((cgk * 64) % S) + 64; const int kb = b * S;
        float q[32], gi[32];
        const bf16_t* qp = PROJ + (size_t)t * NP + P_GQ + h * 32;
#pragma unroll
        for (int d = 0; d < 32; ++d) { q[d] = bf2f(qp[d]); gi[d] = G[(size_t)t * 128 + h * 32 + d]; }
        float ss = 0.f; float o[32];
        float* o0 = ldsf + c.wave * 2048 + lane;
#pragma unroll 1
        for (int vh = 0; vh < 2; ++vh) {
#pragma unroll
            for (int e = 0; e < 32; ++e) o[e] = 0.f;
            for (int j = 0; j < nk; ++j) {
                const bf16_t* kr = PROJ + (size_t)(kb + j) * NP + P_GK + h * 32; const bf16_t* vr = PROJ + (size_t)(kb + j) * NP + P_GV + h * 64 + vh * 32;
                const float* gj = G + (size_t)(kb + j) * 128 + h * 32;
                float s = 0.f;
#pragma unroll
                for (int d = 0; d < 32; ++d) s = fmaf(q[d] * bf2f(kr[d]), __expf(-fabsf(gi[d] - gj[d])), s);
#pragma unroll
                for (int e = 0; e < 32; ++e) o[e] = fmaf(s, bf2f(vr[e]), o[e]);
            }
#pragma unroll
            for (int e = 0; e < 32; ++e) ss += o[e] * o[e];
            if (vh == 0) {
#pragma unroll
                for (int e = 0; e < 32; ++e) o0[e * 64] = o[e];
            }
        }
        const float rstd = rsqrtf(ss * (1.f / 64.f) + EPS);
        const bf16_t* z = PROJ + (size_t)t * NP + P_GZ + h * 64; bf16_t* mo = MIX + (size_t)t * 1024 + 768 + h * 64;
#pragma unroll
        for (int e = 0; e < 32; ++e) mo[e] = (bf16_t)f2bf(o0[e * 64] * rstd * gnw[e] * bf2f(z[e]));
#pragma unroll
        for (int e = 0; e < 32; ++e) mo[32 + e] = (bf16_t)f2bf(o[e] * rstd * gnw[32 + e] * bf2f(z[32 + e]));
    }
}

constexpr int NTHREADS = 512;
constexpr int LDS_BYTES = 147456;
__global__ void __launch_bounds__(NTHREADS, 2) mk_fwd(Params p) {
    extern __shared__ __attribute__((aligned(16))) unsigned char lds[];
    cg::grid_group grid = cg::this_grid();
    Ctx c; c.tid = threadIdx.x; c.lane = c.tid & 63; c.wave = __builtin_amdgcn_readfirstlane(c.tid >> 6);
    c.gw = blockIdx.x * (NTHREADS / 64) + c.wave; c.NGW = gridDim.x * (NTHREADS / 64);
    c.gt = (long)blockIdx.x * NTHREADS + c.tid; c.GT = (long)gridDim.x * NTHREADS;
    unsigned char* ws = p.ws;
    float* ADA = (float*)(ws + WS_ADA); const float2* CS32 = (const float2*)(ws + WS_CS32); const float2* CS16 = (const float2*)(ws + WS_CS16);
    bf16_t* WinT = (bf16_t*)(ws + WS_WIN); bf16_t* WuqT = (bf16_t*)(ws + WS_WUQ); bf16_t* WukvT = (bf16_t*)(ws + WS_WUKV); bf16_t* WoutT = (bf16_t*)(ws + WS_WOUT);
    float* RSQ = (float*)(ws + WS_RSQ); float* RSKV = (float*)(ws + WS_RSKV); float* GG = (float*)(ws + WS_GG);
    bf16_t* H = (bf16_t*)(ws + WS_H); bf16_t* PROJ = (bf16_t*)(ws + WS_PROJ); bf16_t* Q = (bf16_t*)(ws + WS_Q); bf16_t* KV = (bf16_t*)(ws + WS_KV); bf16_t* MIX = (bf16_t*)(ws + WS_MIX);
    float* GC = (float*)(ws + WS_GCUM);
    if (c.tid == 0) lds[0] = 0;

    ph_prep(p, fresh(c));
    grid.sync();
#pragma unroll 1
    for (int l = 0; l < DEPTH; ++l) {
        const float* xin = (l == 0) ? p.x : p.out;
        const float* ADA_l = ADA + (size_t)l * NB * 3072;
        ph_norm(fresh(c), xin, p.norm_w + l * D, ADA_l, H);
        grid.sync();
        gemm_wave(fresh(c), H, D, WinT + (size_t)l * NP * 1024, T, NP, 1024, EpiIn{PROJ, GG, CS32, CS16});
        grid.sync();
        ph_rstd(fresh(c), PROJ, RSQ, RSKV);
        ph_gla_la(fresh(c), GG, p.w_g2 + (size_t)l * 16 * 128, p.b_g2 + l * 128, GC);
        grid.sync();
        gemm_wave(fresh(c), PROJ + P_MQ, NP, WuqT + (size_t)l * 768 * 256, T, 768, 256, EpiQ{Q, RSQ, CS16});
        gemm_wave(fresh(c), PROJ + P_MKV, NP, WukvT + (size_t)l * 1024 * 128, T, 1024, 128, EpiKV{KV, RSKV});
        ph_gla_cum(fresh(c), GC);
        grid.sync();
        ph_attn_naive(fresh(c), Q, KV, PROJ, MIX);
        ph_ret_naive(fresh(c), PROJ, MIX);
        ph_gla_naive(fresh(c), PROJ, GC, p.gnw + l * 64, MIX, (float*)lds);
        grid.sync();
        gemm_wave(fresh(c), MIX, 1024, WoutT + (size_t)l * 1024 * 1024, T, 1024, 1024, EpiOut{xin, p.out, ADA_l});
        grid.sync();
    }
    ph_final(fresh(c), p.out, p.fnw, p.out);
}

extern "C" void kernel_launch(void* const* d_in, const int* in_sizes, int n_in, void* d_out, int out_size, void* d_ws, size_t ws_size, hipStream_t stream) {
    static int grid_blocks = 0;
    if (grid_blocks == 0) {
        if (n_in != 16 || in_sizes[0] != T * D || out_size != T * D || ws_size < WS_END) {
            fprintf(stderr, "kernel_launch: shape/ws mismatch n_in %d in0 %d out %d ws %zu (need %zu)\n", n_in, n_in > 0 ? in_sizes[0] : -1, out_size, ws_size, (size_t)WS_END);
            grid_blocks = -1; return;
        }
        int dev = 0, cus = 0, per_cu = 0;
        hipGetDevice(&dev); hipDeviceGetAttribute(&cus, hipDeviceAttributeMultiprocessorCount, dev);
        if (hipFuncSetAttribute((const void*)mk_fwd, hipFuncAttributeMaxDynamicSharedMemorySize, LDS_BYTES) != hipSuccess) { fprintf(stderr, "kernel_launch: hipFuncSetAttribute failed\n"); grid_blocks = -1; return; }
        if (hipOccupancyMaxActiveBlocksPerMultiprocessor(&per_cu, (const void*)mk_fwd, NTHREADS, LDS_BYTES) != hipSuccess || per_cu < 1) { fprintf(stderr, "kernel_launch: occupancy query says %d blocks/CU\n", per_cu); grid_blocks = -1; return; }
        grid_blocks = cus;
        fprintf(stderr, "kernel_launch: cus %d per_cu %d grid %d\n", cus, per_cu, grid_blocks);
    }
    if (grid_blocks < 0) return;
    Params p{};
    p.x = (const float*)d_in[0]; p.c = (const float*)d_in[1]; p.pos = (const int*)d_in[2]; p.norm_w = (const float*)d_in[3]; p.ada_w = (const float*)d_in[4];
    p.ada_b = (const float*)d_in[5]; p.w_in = (const float*)d_in[6]; p.qnw = (const float*)d_in[7]; p.w_uq = (const float*)d_in[8]; p.kvnw = (const float*)d_in[9];
    p.w_ukv = (const float*)d_in[10]; p.w_g2 = (const float*)d_in[11]; p.b_g2 = (const float*)d_in[12]; p.gnw = (const float*)d_in[13]; p.w_out = (const float*)d_in[14];
    p.fnw = (const float*)d_in[15]; p.out = (float*)d_out; p.ws = (unsigned char*)d_ws;
    void* args[] = {&p};
    hipError_t e = hipLaunchCooperativeKernel((void*)mk_fwd, dim3(grid_blocks), dim3(NTHREADS), args, LDS_BYTES, stream);
    if (e != hipSuccess) fprintf(stderr, "cooperative launch failed: %s (grid %d)\n", hipGetErrorString(e), grid_blocks);
}
```

```cpp
#include <hip/hip_runtime.h>
#include <hip/hip_cooperative_groups.h>
namespace cg = cooperative_groups;
#include <cstdio>
#include <cstdint>
#include <cmath>

typedef unsigned short bf16_t;
typedef short bf16x8 __attribute__((ext_vector_type(8)));
typedef float f32x4 __attribute__((ext_vector_type(4)));
typedef unsigned u32x4 __attribute__((ext_vector_type(4)));
typedef unsigned u32x2 __attribute__((ext_vector_type(2)));

constexpr int D = 1024, NB = 32, S = 2048, T = NB * S, DEPTH = 2, CH = 64;
constexpr int NIN = 2736, NP = 2816;
constexpr float EPS = 1e-6f;
constexpr int P_RQ = 0, P_RK = 256, P_RV = 512, P_RZ = 768, P_MQ = 1024, P_MKV = 1280, P_KPE = 1408, P_GG = 1440, P_PAD = 1456,
              P_MZ = 1536, P_GQ = 2048, P_GK = 2176, P_GV = 2304, P_GZ = 2560;
constexpr float QSCALE = 0.10206207261596577f * 1.4426950408889634f;

constexpr size_t MiB = 1u << 20;
constexpr size_t WS_CTL = 0;
constexpr size_t WS_ADA = 1 * MiB;
constexpr size_t WS_CS32 = 2 * MiB;
constexpr size_t WS_CS16 = 18 * MiB;
constexpr size_t WS_WIN = 26 * MiB;
constexpr size_t WS_WUQ = 38 * MiB;
constexpr size_t WS_WUKV = 39 * MiB;
constexpr size_t WS_WOUT = 40 * MiB;
constexpr size_t WS_RSQ = 44 * MiB;
constexpr size_t WS_RSKV = 45 * MiB;
constexpr size_t WS_GG = 46 * MiB;
constexpr size_t WS_H = 50 * MiB;
constexpr size_t WS_PROJ = 178 * MiB;
constexpr size_t WS_Q = 530 * MiB;
constexpr size_t WS_KV = 626 * MiB;
constexpr size_t WS_MIX = 754 * MiB;
constexpr size_t WS_GCUM = 882 * MiB;
constexpr size_t WS_END = 914 * MiB;

__device__ __forceinline__ unsigned f2bf(float f) { unsigned u = __builtin_bit_cast(unsigned, f); return (u + 0x7fffu + ((u >> 16) & 1u)) >> 16; }
__device__ __forceinline__ unsigned pk2(float lo, float hi) { return f2bf(lo) | (f2bf(hi) << 16); }
__device__ __forceinline__ float bf2f(bf16_t v) { return __builtin_bit_cast(float, (unsigned)v << 16); }
__device__ __forceinline__ float silu_f(float x) { return x / (1.f + __expf(-x)); }

__host__ __device__ inline int in_logical(int p) {
    if (p < 512) { int c = p & 63; return (p & ~63) + (c >> 1) + 32 * (c & 1); }
    if (p < 1408) return p;
    if (p < 1440) { int c = p - 1408; return 1408 + (c >> 1) + 16 * (c & 1); }
    if (p < 1456) return 2464 + (p - 1440);
    if (p < 1536) return -1;
    if (p < 2048) return 1440 + (p - 1536);
    if (p < 2304) return 1952 + (p - 2048);
    if (p < 2560) return 2208 + (p - 2304);
    return 2480 + (p - 2560);
}
__host__ __device__ inline int uq_logical(int p) {
    int h = p / 96, c = p % 96;
    if (c < 64) return p;
    int cc = c - 64; return h * 96 + 64 + (cc >> 1) + 16 * (cc & 1);
}

struct Params {
    const float* x; const float* c; const int* pos; const float* norm_w; const float* ada_w; const float* ada_b; const float* w_in; const float* qnw;
    const float* w_uq; const float* kvnw; const float* w_ukv; const float* w_g2; const float* b_g2; const float* gnw; const float* w_out; const float* fnw;
    float* out; unsigned char* ws;
};
struct Ctx { int tid, lane, wave, gw, NGW; long gt, GT; };
__device__ __forceinline__ Ctx fresh(const Ctx& c) { Ctx r = c; asm volatile("" : "+v"(r.lane), "+v"(r.tid)); asm volatile("" : "+s"(r.gw)); r.gt = (long)blockIdx.x * 512 + r.tid; return r; }

__device__ __forceinline__ float wave_sum(float v) {
#pragma unroll
    for (int o = 1; o < 64; o <<= 1) v += __shfl_xor(v, o);
    return v;
}

__device__ __forceinline__ void ph_prep(const Params& p, const Ctx& c) {
    unsigned char* ws = p.ws;
    bf16_t* WinT = (bf16_t*)(ws + WS_WIN); bf16_t* WuqT = (bf16_t*)(ws + WS_WUQ); bf16_t* WukvT = (bf16_t*)(ws + WS_WUKV); bf16_t* WoutT = (bf16_t*)(ws + WS_WOUT);
    float2* CS32 = (float2*)(ws + WS_CS32); float2* CS16 = (float2*)(ws + WS_CS16); float* ADA = (float*)(ws + WS_ADA);
    const long gsz = c.GT, g0 = c.gt;
    for (long i = g0; i < (long)DEPTH * NP * 1024; i += gsz) {
        int k = (int)(i & 1023); long r = i >> 10; int pp = (int)(r % NP), l = (int)(r / NP);
        int lc = in_logical(pp);
        float v = lc >= 0 ? p.w_in[((size_t)l * 1024 + k) * NIN + lc] : 0.f;
        WinT[i] = (bf16_t)f2bf(v);
    }
    for (long i = g0; i < (long)DEPTH * 768 * 256; i += gsz) {
        int k = (int)(i & 255); long r = i >> 8; int pp = (int)(r % 768), l = (int)(r / 768);
        WuqT[i] = (bf16_t)f2bf(p.qnw[l * 256 + k] * p.w_uq[((size_t)l * 256 + k) * 768 + uq_logical(pp)]);
    }
    for (long i = g0; i < (long)DEPTH * 1024 * 128; i += gsz) {
        int k = (int)(i & 127); long r = i >> 7; int n = (int)(r % 1024), l = (int)(r / 1024);
        WukvT[i] = (bf16_t)f2bf(p.kvnw[l * 128 + k] * p.w_ukv[((size_t)l * 128 + k) * 1024 + n]);
    }
    for (long i = g0; i < (long)DEPTH * 1024 * 1024; i += gsz) {
        int k = (int)(i & 1023); long r = i >> 10; int n = (int)(r % 1024), l = (int)(r / 1024);
        WoutT[i] = (bf16_t)f2bf(p.w_out[((size_t)l * 1024 + k) * 1024 + n]);
    }
    for (long i = g0; i < (long)T * 32; i += gsz) {
        int j = (int)(i & 31); int t = (int)(i >> 5);
        double inv = pow(10000.0, -(double)j / 32.0), a = (double)p.pos[t] * inv; double s, cc; sincos(a, &s, &cc);
        CS32[i] = make_float2((float)cc, (float)s);
    }
    for (long i = g0; i < (long)T * 16; i += gsz) {
        int j = (int)(i & 15); int t = (int)(i >> 4);
        double inv = pow(10000.0, -(double)j / 16.0), a = (double)p.pos[t] * inv; double s, cc; sincos(a, &s, &cc);
        CS16[i] = make_float2((float)cc, (float)s);
    }
    for (long i = g0; i < (long)DEPTH * NB * 3072; i += gsz) {
        int n = (int)(i % 3072), b = (int)((i / 3072) % NB), l = (int)(i / (3072 * NB));
        float acc = 0.f;
        for (int k = 0; k < 1024; ++k) acc = fmaf(silu_f(p.c[b * 1024 + k]), p.ada_w[((size_t)l * 1024 + k) * 3072 + n], acc);
        ADA[i] = acc + p.ada_b[l * 3072 + n];
    }
}

__device__ __forceinline__ void ph_norm(const Ctx& c, const float* x, const float* nw, const float* ADA_l, bf16_t* H) {
    const int lane = c.lane;
    for (int row = c.gw; row < T; row += c.NGW) {
        const int b = row / S;
        const f32x4* xr = (const f32x4*)(x + (size_t)row * D) + lane;
        f32x4 v[4]; float s = 0.f;
#pragma unroll
        for (int j = 0; j < 4; ++j) { v[j] = xr[64 * j]; s += v[j].x * v[j].x + v[j].y * v[j].y + v[j].z * v[j].z + v[j].w * v[j].w; }
        const float rstd = rsqrtf(wave_sum(s) * (1.f / D) + EPS);
        const float* shift = ADA_l + (size_t)b * 3072; const float* scale = shift + 1024;
        u32x2* o = (u32x2*)(H + (size_t)row * D) + lane;
#pragma unroll
        for (int j = 0; j < 4; ++j) {
            const int c0 = 4 * lane + 256 * j; const f32x4 w = *(const f32x4*)(nw + c0), sc = *(const f32x4*)(scale + c0), sh = *(const f32x4*)(shift + c0);
            f32x4 y;
            y.x = v[j].x * rstd * w.x * (1.f + sc.x) + sh.x; y.y = v[j].y * rstd * w.y * (1.f + sc.y) + sh.y;
            y.z = v[j].z * rstd * w.z * (1.f + sc.z) + sh.z; y.w = v[j].w * rstd * w.w * (1.f + sc.w) + sh.w;
            u32x2 pk; pk.x = pk2(y.x, y.y); pk.y = pk2(y.z, y.w); o[64 * j] = pk;
        }
    }
}

__device__ __forceinline__ void ph_final(const Ctx& c, const float* x, const float* w, float* out) {
    const int lane = c.lane;
    for (int row = c.gw; row < T; row += c.NGW) {
        const f32x4* xr = (const f32x4*)(x + (size_t)row * D) + lane;
        f32x4 v[4]; float s = 0.f;
#pragma unroll
        for (int j = 0; j < 4; ++j) { v[j] = xr[64 * j]; s += v[j].x * v[j].x + v[j].y * v[j].y + v[j].z * v[j].z + v[j].w * v[j].w; }
        const float rstd = rsqrtf(wave_sum(s) * (1.f / D) + EPS);
        f32x4* o = (f32x4*)(out + (size_t)row * D) + lane;
#pragma unroll
        for (int j = 0; j < 4; ++j) { const f32x4 ww = *(const f32x4*)(w + 4 * lane + 256 * j); o[64 * j] = v[j] * rstd * ww; }
    }
}

__device__ __forceinline__ f32x4 rope4(f32x4 v, float2 a, float2 b) { f32x4 o; o.x = v.x * a.x - v.y * a.y; o.y = v.y * a.x + v.x * a.y; o.z = v.z * b.x - v.w * b.y; o.w = v.w * b.x + v.z * b.y; return o; }
__device__ __forceinline__ f32x4 silu4(f32x4 v) { v.x = silu_f(v.x); v.y = silu_f(v.y); v.z = silu_f(v.z); v.w = silu_f(v.w); return v; }
struct EpiIn {
    bf16_t* PROJ; float* GG; const float2* CS32; const float2* CS16;
    __device__ __forceinline__ void operator()(int row, int col, f32x4 v) const {
        if (col < 512) {
            const int j = (col & 63) >> 1; v = rope4(v, CS32[(size_t)row * 32 + j], CS32[(size_t)row * 32 + j + 1]);
            if (col >= 256) v = v * 0.125f;
        } else if (col < 768) {
        } else if (col < 1024) { v = silu4(v);
        } else if (col < 1408) {
        } else if (col < 1440) {
            const int j = (col - 1408) >> 1; v = rope4(v, CS16[(size_t)row * 16 + j], CS16[(size_t)row * 16 + j + 1]);
        } else if (col < 1456) { *(f32x4*)(GG + (size_t)row * 16 + (col - 1440)) = v; return;
        } else if (col < 1536) { return;
        } else if (col < 2048) { v = silu4(v);
        } else if (col < 2176) {
        } else if (col < 2304) { v = v * 0.17677669529663687f;
        } else if (col < 2560) {
        } else { v = silu4(v); }
        u32x2 pk; pk.x = pk2(v.x, v.y); pk.y = pk2(v.z, v.w); *(u32x2*)(PROJ + (size_t)row * NP + col) = pk;
    }
};
struct EpiQ {
    bf16_t* Q; const float* RSQ; const float2* CS16;
    __device__ __forceinline__ void operator()(int row, int col, f32x4 v) const {
        v = v * RSQ[row]; const int cc = col % 96;
        if (cc >= 64) { const int j = (cc - 64) >> 1; v = rope4(v, CS16[(size_t)row * 16 + j], CS16[(size_t)row * 16 + j + 1]); }
        v = v * QSCALE;
        u32x2 pk; pk.x = pk2(v.x, v.y); pk.y = pk2(v.z, v.w); *(u32x2*)(Q + (size_t)row * 768 + col) = pk;
    }
};
struct EpiKV {
    bf16_t* KV; const float* RSKV;
    __device__ __forceinline__ void operator()(int row, int col, f32x4 v) const {
        v = v * RSKV[row];
        u32x2 pk; pk.x = pk2(v.x, v.y); pk.y = pk2(v.z, v.w); *(u32x2*)(KV + (size_t)row * 1024 + col) = pk;
    }
};
struct EpiOut {
    const float* xi; float* xo; const float* ADA_l;
    __device__ __forceinline__ void operator()(int row, int col, f32x4 v) const {
        const int b = row / S; const f32x4 g = *(const f32x4*)(ADA_l + (size_t)b * 3072 + 2048 + col);
        const f32x4 xv = *(const f32x4*)(xi + (size_t)row * D + col);
        *(f32x4*)(xo + (size_t)row * D + col) = xv + g * v;
    }
};

namespace pg8 {
#define PG8_LAS __attribute__((address_space(3)))
constexpr int BM = 256, BK = 64, HALF = 128, HTB = HALF * BK * 2  , STAGE_BYTES = 8 * HTB, NXCD = 8, WGM = 8;

__host__ __device__ __forceinline__ int lds_byte(int r, int c) { const int st = (r >> 4) * 2 + (c >> 5), rr = r & 15, cc = c & 31, ob = rr * 64 + cc * 2; return st * 1024 + (ob ^ (((ob >> 9) & 1) << 5)); }
__host__ __device__ __forceinline__ void stage_rc(int b, int& R, int& C) { const int st = b / 1024, sb = b % 1024, swz = sb ^ (((sb >> 9) & 1) << 5); R = (st >> 1) * 16 + swz / 64; C = (st & 1) * 32 + (swz % 64) / 2; }
__host__ __device__ __forceinline__ int perm32(int rho) { const int n = rho >> 4, i = rho & 15; return 8 * (i >> 2) + 4 * n + (i & 3); }

struct Unit { int pm, pn; };
struct Gemm { const bf16_t* A; const bf16_t* Bt; int M, N, K, lda; };

struct StaticOrder {
    int nM, nN, nwg, G, c;
    __host__ __device__ void init(int M, int N, int G_, int c_) { nM = M / BM; nN = N / BM; nwg = nM * nN; G = G_; c = c_; }
    __host__ __device__ bool next(int i, Unit& u) const {
        const long L = (long)i * G + c; if (L >= nwg) return false;
        int wgid = (int)L; { const int q = nwg / NXCD, r = nwg % NXCD, xcd = wgid % NXCD, off = wgid / NXCD; wgid = (xcd < r ? xcd * (q + 1) : r * (q + 1) + (xcd - r) * q) + off; }
        const int nig = WGM * nN, gid = wgid / nig, fm = gid * WGM, gsz = (nM - fm) < WGM ? (nM - fm) : WGM;
        u.pm = fm + ((wgid % nig) % gsz); u.pn = (wgid % nig) / gsz; return true;
    }
    __device__ __forceinline__ void a_ready(const Unit&) const {}
    __device__ __forceinline__ void done(const Unit&) const {}
};

template <class Epi, class Sched, bool ALIGN_EPI = false, bool SP2 = false>
__device__ __forceinline__ void gemm_phase(PG8_LAS unsigned char* lds, const Gemm g, const Sched& S, const Epi& E) {
    int tid_ = threadIdx.x; asm volatile("" : "+v"(tid_));
    const int tid = tid_, wid = __builtin_amdgcn_readfirstlane(tid >> 6), lane = tid & 63, wr = wid >> 2, wc = wid & 3, fr = lane & 15, fq = lane >> 4;
    const int K = g.K, nt = K / BK;
    unsigned voffA[2], voffB[2];
#pragma unroll
    for (int i = 0; i < 2; ++i) { int R, C; stage_rc(tid * 16 + i * 8192, R, C); const int Rb = Epi::PERM ? ((R & ~31) + perm32(R & 31)) : R;
        voffA[i] = (unsigned)(R * g.lda + C) * 2u; voffB[i] = (unsigned)(Rb * K + C) * 2u; }
    const size_t kstep = (size_t)(BK * 2);
    const size_t hstep = (size_t)HALF * K * 2;
    const size_t tstep = 2 * hstep; const size_t hstepA = (size_t)HALF * g.lda * 2, tstepA = 2 * hstepA;
    const unsigned ldsw = (unsigned)wid * 1024u;
    const int aoff = lds_byte(wr * 64 + fr, fq * 8), boff = lds_byte(wc * 32 + fr, fq * 8);
#define PG8_SA(b, h) (((b) * 2 + (h)) * HTB)
#define PG8_SB(b, h) ((4 + (b) * 2 + (h)) * HTB)
#define PG8_STAGE(bufoff, gbase, voff) do { _Pragma("unroll") for (int _i = 0; _i < 2; ++_i) \
        __builtin_amdgcn_global_load_lds((const unsigned*)((const char*)(gbase) + (voff)[_i]), (PG8_LAS unsigned*)(lds + (bufoff) + ldsw + _i * 8192), 16, 0, 0); } while (0)
#define PG8_LDA(dst, b, h) do { _Pragma("unroll") for (int m = 0; m < 4; ++m) _Pragma("unroll") for (int k = 0; k < 2; ++k) dst[m][k] = *(const PG8_LAS bf16x8*)(lds + PG8_SA(b, h) + aoff + m * 2048 + k * 1024); } while (0)
#define PG8_LDB(dst, b, h) do { _Pragma("unroll") for (int n = 0; n < 2; ++n) _Pragma("unroll") for (int k = 0; k < 2; ++k) dst[n][k] = *(const PG8_LAS bf16x8*)(lds + PG8_SB(b, h) + boff + n * 2048 + k * 1024); } while (0)
#define PG8_MMA(ai, bj, At, Bt) do { __builtin_amdgcn_s_setprio(1); _Pragma("unroll") for (int m = 0; m < 4; ++m) _Pragma("unroll") for (int n = 0; n < 2; ++n) _Pragma("unroll") for (int k = 0; k < 2; ++k) \
        acc[ai][bj][m][n] = __builtin_amdgcn_mfma_f32_16x16x32_bf16(Bt[n][k], At[m][k], acc[ai][bj][m][n], 0, 0, 0); __builtin_amdgcn_s_setprio(0); } while (0)
#define PG8_WAIT_V(n) asm volatile("s_waitcnt vmcnt(" #n ")" ::: "memory")
#define PG8_WAIT_L(n) asm volatile("s_waitcnt lgkmcnt(" #n ")" ::: "memory")
#define PG8_BAR __builtin_amdgcn_s_barrier()
#define PG8_SCHED __builtin_amdgcn_sched_barrier(0)
    Unit cur, nxt; int ui = 0;
    if (!S.next(0, cur)) return;
    f32x4 acc[2][2][4][2];
#pragma unroll
    for (int a = 0; a < 2; ++a)
#pragma unroll
        for (int b = 0; b < 2; ++b)
#pragma unroll
            for (int m = 0; m < 4; ++m)
#pragma unroll
                for (int n = 0; n < 2; ++n) acc[a][b][m][n] = (f32x4){0.f, 0.f, 0.f, 0.f};
    bf16x8 At[4][2], B0[2][2], B1[2][2];
    const char* cA = (const char*)g.A + (size_t)cur.pm * tstepA; const char* cB = (const char*)g.Bt + (size_t)cur.pn * tstep;
    S.a_ready(cur);
    if constexpr (SP2) {
        PG8_STAGE(PG8_SB(0, 0), cB, voffB); PG8_STAGE(PG8_SB(0, 1), cB + hstep, voffB); PG8_STAGE(PG8_SA(0, 0), cA, voffA); PG8_STAGE(PG8_SA(0, 1), cA + hstepA, voffA);
        if (wr == 1) PG8_BAR;
        PG8_WAIT_V(2); PG8_BAR;
        PG8_STAGE(PG8_SB(1, 0), cB + kstep, voffB); PG8_STAGE(PG8_SA(1, 0), cA + kstep, voffA); PG8_STAGE(PG8_SB(1, 1), cB + hstep + kstep, voffB);
        PG8_WAIT_V(6); PG8_BAR;
    } else {
        PG8_STAGE(PG8_SB(0, 0), cB, voffB); PG8_STAGE(PG8_SA(0, 0), cA, voffA); PG8_STAGE(PG8_SB(0, 1), cB + hstep, voffB); PG8_STAGE(PG8_SA(0, 1), cA + hstepA, voffA);
        if (wr == 1) PG8_BAR;
        PG8_WAIT_V(4); PG8_BAR;
        PG8_STAGE(PG8_SB(1, 0), cB + kstep, voffB); PG8_STAGE(PG8_SA(1, 0), cA + kstep, voffA); PG8_STAGE(PG8_SB(1, 1), cB + hstep + kstep, voffB);
        PG8_WAIT_V(6); PG8_BAR;
    }
    for (;;) {
        const bool has_next = S.next(ui + 1, nxt);
        const char* nA = has_next ? (const char*)g.A + (size_t)nxt.pm * tstepA : cA; const char* nB = has_next ? (const char*)g.Bt + (size_t)nxt.pn * tstep : cB;
        for (int t = 0; t < nt; t += 2) {
            const bool last = (t == nt - 2);
            const char* a1 = cA + (size_t)(t + 1) * kstep;
            const char* a2 = last ? nA : cA + (size_t)(t + 2) * kstep; const char* b2 = last ? nB : cB + (size_t)(t + 2) * kstep;
            const char* a3 = a2 + kstep; const char* b3 = b2 + kstep;
            if (last && has_next) S.a_ready(nxt);
            if constexpr (SP2) {
            PG8_LDB(B0, 0, 0); PG8_LDB(B1, 0, 1); PG8_SCHED; PG8_LDA(At, 0, 0); PG8_STAGE(PG8_SA(1, 1), a1 + hstepA, voffA);
            PG8_WAIT_V(8); PG8_WAIT_L(0); PG8_BAR; PG8_MMA(0, 0, At, B0); PG8_MMA(0, 1, At, B1); PG8_BAR; PG8_SCHED;
            PG8_LDA(At, 0, 1); PG8_STAGE(PG8_SB(0, 0), b2, voffB); PG8_STAGE(PG8_SB(0, 1), b2 + hstep, voffB); PG8_STAGE(PG8_SA(0, 0), a2, voffA);
            PG8_WAIT_V(8); PG8_WAIT_L(0); PG8_BAR; PG8_MMA(1, 0, At, B0); PG8_MMA(1, 1, At, B1); PG8_BAR; PG8_SCHED;
            PG8_LDB(B0, 1, 0); PG8_LDB(B1, 1, 1); PG8_SCHED; PG8_LDA(At, 1, 0); PG8_STAGE(PG8_SA(0, 1), a2 + hstepA, voffA);
            PG8_WAIT_V(8); PG8_WAIT_L(0); PG8_BAR; PG8_MMA(0, 0, At, B0); PG8_MMA(0, 1, At, B1); PG8_BAR; PG8_SCHED;
            PG8_LDA(At, 1, 1); PG8_STAGE(PG8_SB(1, 0), b3, voffB); PG8_STAGE(PG8_SB(1, 1), b3 + hstep, voffB); PG8_STAGE(PG8_SA(1, 0), a3, voffA);
            PG8_WAIT_V(8); PG8_WAIT_L(0); PG8_BAR; PG8_MMA(1, 0, At, B0); PG8_MMA(1, 1, At, B1); PG8_BAR; PG8_SCHED;
            } else {
            PG8_LDB(B0, 0, 0); PG8_SCHED; PG8_LDA(At, 0, 0); PG8_STAGE(PG8_SA(1, 1), a1 + hstepA, voffA);
            PG8_WAIT_L(8); PG8_BAR; PG8_WAIT_L(0); PG8_MMA(0, 0, At, B0); PG8_BAR; PG8_SCHED;
            PG8_LDB(B1, 0, 1); PG8_STAGE(PG8_SB(0, 0), b2, voffB);
            PG8_BAR; PG8_WAIT_L(0); PG8_MMA(0, 1, At, B1); PG8_BAR;
            PG8_LDA(At, 0, 1); PG8_STAGE(PG8_SA(0, 0), a2, voffA);
            PG8_BAR; PG8_WAIT_L(0); PG8_MMA(1, 0, At, B0); PG8_BAR; PG8_SCHED;
            PG8_STAGE(PG8_SB(0, 1), b2 + hstep, voffB);
            PG8_WAIT_V(6); PG8_BAR; PG8_MMA(1, 1, At, B1); PG8_BAR;
            PG8_LDB(B0, 1, 0); PG8_SCHED; PG8_LDA(At, 1, 0); PG8_STAGE(PG8_SA(0, 1), a2 + hstepA, voffA);
            PG8_WAIT_L(8); PG8_BAR; PG8_WAIT_L(0); PG8_MMA(0, 0, At, B0); PG8_BAR; PG8_SCHED;
            PG8_LDB(B1, 1, 1); PG8_STAGE(PG8_SB(1, 0), b3, voffB);
            PG8_BAR; PG8_WAIT_L(0); PG8_MMA(0, 1, At, B1); PG8_BAR;
            PG8_LDA(At, 1, 1); PG8_STAGE(PG8_SA(1, 0), a3, voffA);
            PG8_BAR; PG8_WAIT_L(0); PG8_MMA(1, 0, At, B0); PG8_BAR; PG8_SCHED;
            PG8_STAGE(PG8_SB(1, 1), b3 + hstep, voffB);
            PG8_WAIT_V(6); PG8_BAR; PG8_MMA(1, 1, At, B1); PG8_BAR;
            }
        }
        if constexpr (ALIGN_EPI) { if (wr == 0) PG8_BAR; }
        if constexpr (!Epi::AFTER_DRAIN) { E(acc, cur, wr, wc, fr, fq); S.done(cur); }
        if (!has_next) break;
#pragma unroll
        for (int a = 0; a < 2; ++a)
#pragma unroll
            for (int b = 0; b < 2; ++b)
#pragma unroll
                for (int m = 0; m < 4; ++m)
#pragma unroll
                    for (int n = 0; n < 2; ++n) acc[a][b][m][n] = (f32x4){0.f, 0.f, 0.f, 0.f};
        cur = nxt; cA = nA; cB = nB; ++ui;
        if constexpr (ALIGN_EPI) { if (wr == 1) PG8_BAR; }
    }
    PG8_WAIT_V(0);
    if constexpr (!ALIGN_EPI) { if (wr == 0) PG8_BAR; }
    PG8_BAR;
    if constexpr (Epi::AFTER_DRAIN) { E.fused(acc, cur, wr, wc, fr, fq, lds, wid, lane); S.done(cur); }
#undef PG8_SA
#undef PG8_SB
#undef PG8_STAGE
#undef PG8_LDA
#undef PG8_LDB
#undef PG8_MMA
#undef PG8_WAIT_V
#undef PG8_WAIT_L
#undef PG8_BAR
#undef PG8_SCHED
}
}

template <class E> struct EpiAd {
    static constexpr bool PERM = false, AFTER_DRAIN = false;
    E e;
    __device__ __forceinline__ void operator()(const f32x4 (&acc)[2][2][4][2], const pg8::Unit& u, int wr, int wc, int fr, int fq) const {
#pragma unroll
        for (int ai = 0; ai < 2; ++ai)
#pragma unroll
            for (int m = 0; m < 4; ++m) {
                const int row = u.pm * 256 + ai * 128 + wr * 64 + m * 16 + fr;
#pragma unroll
                for (int bj = 0; bj < 2; ++bj)
#pragma unroll
                    for (int n = 0; n < 2; ++n) e(row, u.pn * 256 + bj * 128 + wc * 32 + n * 16 + 4 * fq, acc[ai][bj][m][n]);
            }
    }
};
template <class E> __device__ __forceinline__ void run_gemm(PG8_LAS unsigned char* lds, const bf16_t* A, int lda, const bf16_t* Bt, int M, int N, int K, const E& e) {
    int Ko = K; asm volatile("" : "+s"(Ko));
    pg8::Gemm g{A, Bt, M, N, Ko, lda}; pg8::StaticOrder S; S.init(M, N, (int)gridDim.x, (int)blockIdx.x);
    EpiAd<E> ad{e};
    pg8::gemm_phase<EpiAd<E>, pg8::StaticOrder, true, true>(lds, g, S, ad);
}

template <class Epi>
__device__ __forceinline__ void gemm_wave(const Ctx& c, const bf16_t* A, int lda, const bf16_t* Bt, int M, int N, int K, const Epi& epi) {
    const int fr = c.lane & 15, fq = c.lane >> 4; const int ntn = N / 64, nt = (M / 32) * ntn;
    for (int tile = c.gw; tile < nt; tile += c.NGW) {
        const int m0 = (tile / ntn) * 32, n0 = (tile % ntn) * 64;
        f32x4 acc[2][4];
#pragma unroll
        for (int i = 0; i < 2; ++i)
#pragma unroll
            for (int j = 0; j < 4; ++j) acc[i][j] = (f32x4){0.f, 0.f, 0.f, 0.f};
        const bf16_t* ap = A + (size_t)(m0 + fr) * lda + fq * 8; const bf16_t* bp = Bt + (size_t)(n0 + fr) * K + fq * 8;
        for (int k0 = 0; k0 < K; k0 += 32) {
            bf16x8 a[2], b[4];
#pragma unroll
            for (int i = 0; i < 2; ++i) a[i] = *(const bf16x8*)(ap + (size_t)(16 * i) * lda + k0);
#pragma unroll
            for (int j = 0; j < 4; ++j) b[j] = *(const bf16x8*)(bp + (size_t)(16 * j) * K + k0);
#pragma unroll
            for (int i = 0; i < 2; ++i)
#pragma unroll
                for (int j = 0; j < 4; ++j) acc[i][j] = __builtin_amdgcn_mfma_f32_16x16x32_bf16(b[j], a[i], acc[i][j], 0, 0, 0);
        }
#pragma unroll
        for (int i = 0; i < 2; ++i)
#pragma unroll
            for (int j = 0; j < 4; ++j) epi(m0 + 16 * i + fr, n0 + 16 * j + 4 * fq, acc[i][j]);
    }
}

__device__ __forceinline__ void ph_rstd(const Ctx& c, const bf16_t* PROJ, float* RSQ, float* RSKV) {
    const int lane = c.lane;
    for (int row = c.gw; row < T; row += c.NGW) {
        const bf16_t* p = PROJ + (size_t)row * NP;
        float s = 0.f;
#pragma unroll
        for (int j = 0; j < 4; ++j) { const float v = bf2f(p[P_MQ + lane + 64 * j]); s += v * v; }
        s = wave_sum(s);
        float s2 = 0.f;
#pragma unroll
        for (int j = 0; j < 2; ++j) { const float v = bf2f(p[P_MKV + lane + 64 * j]); s2 += v * v; }
        s2 = wave_sum(s2);
        if (lane == 0) { RSQ[row] = rsqrtf(s * (1.f / 256.f) + EPS); RSKV[row] = rsqrtf(s2 * (1.f / 128.f) + EPS); }
    }
}

__device__ __forceinline__ void ph_attn_naive(const Ctx& c, const bf16_t* Q, const bf16_t* KV, const bf16_t* PROJ, bf16_t* MIX) {
    const int lane = c.lane;
    for (int W = c.gw; W < (T / 64) * 16; W += c.NGW) {
        const int cgk = W >> 4, h = (W >> 1) & 7, vh = W & 1; const int t = cgk * 64 + lane; const int b = (cgk * 64) / S; const int nk = ((cgk * 64) % S) + 64; const int kb = b * S;
        float q[96];
        const bf16_t* qp = Q + (size_t)t * 768 + h * 96;
#pragma unroll
        for (int d = 0; d < 96; ++d) q[d] = bf2f(qp[d]);
        float o[32];
#pragma unroll
        for (int e = 0; e < 32; ++e) o[e] = 0.f;
        float m = -1e30f, l = 0.f;
        for (int j = 0; j < nk; ++j) {
            const bf16_t* kn = KV + (size_t)(kb + j) * 1024 + h * 128; const bf16_t* kp = PROJ + (size_t)(kb + j) * NP + P_KPE;
            float s = 0.f;
#pragma unroll
            for (int d = 0; d < 64; ++d) s = fmaf(q[d], bf2f(kn[d]), s);
#pragma unroll
            for (int d = 0; d < 32; ++d) s = fmaf(q[64 + d], bf2f(kp[d]), s);
            const float mn = fmaxf(m, s); const float sc = exp2f(m - mn), pp = exp2f(s - mn); m = mn; l = l * sc + pp;
#pragma unroll
            for (int e = 0; e < 32; ++e) o[e] = o[e] * sc + pp * bf2f(kn[64 + vh * 32 + e]);
        }
        const float rl = 1.f / l;
        const bf16_t* z = PROJ + (size_t)t * NP + P_MZ + h * 64 + vh * 32; bf16_t* mo = MIX + (size_t)t * 1024 + 256 + h * 64 + vh * 32;
#pragma unroll
        for (int e = 0; e < 32; ++e) mo[e] = (bf16_t)f2bf(o[e] * rl * bf2f(z[e]));
    }
}

__device__ __forceinline__ void ph_ret_naive(const Ctx& c, const bf16_t* PROJ, bf16_t* MIX) {
    const int lane = c.lane;
    for (int W = c.gw; W < (T / 64) * 4; W += c.NGW) {
        const int cgk = W >> 2, h = W & 3; const int t = cgk * 64 + lane; const int b = (cgk * 64) / S; const int nk = ((cgk * 64) % S) + 64; const int kb = b * S;
        const float lg = log1pf(-exp2f(-5.f - (float)h));
        float q[64];
        const bf16_t* qp = PROJ + (size_t)t * NP + P_RQ + h * 64;
#pragma unroll
        for (int d = 0; d < 64; ++d) q[d] = bf2f(qp[d]);
        float o[64];
#pragma unroll
        for (int e = 0; e < 64; ++e) o[e] = 0.f;
        const int ti = t - kb;
        for (int j = 0; j < nk; ++j) {
            const bf16_t* kr = PROJ + (size_t)(kb + j) * NP + P_RK + h * 64; const bf16_t* vr = PROJ + (size_t)(kb + j) * NP + P_RV + h * 64;
            float s = 0.f;
#pragma unroll
            for (int d = 0; d < 64; ++d) s = fmaf(q[d], bf2f(kr[d]), s);
            const int dd = ti - j; s *= __expf(lg * (float)(dd < 0 ? -dd : dd));
#pragma unroll
            for (int e = 0; e < 64; ++e) o[e] = fmaf(s, bf2f(vr[e]), o[e]);
        }
        float ss = 0.f;
#pragma unroll
        for (int e = 0; e < 64; ++e) ss += o[e] * o[e];
        const float rstd = rsqrtf(ss * (1.f / 64.f) + EPS);
        const bf16_t* z = PROJ + (size_t)t * NP + P_RZ + h * 64; bf16_t* mo = MIX + (size_t)t * 1024 + h * 64;
#pragma unroll
        for (int e = 0; e < 64; ++e) mo[e] = (bf16_t)f2bf(o[e] * rstd * bf2f(z[e]));
    }
}

__device__ __forceinline__ void ph_gla_la(const Ctx& c, const float* GG, const float* w_g2, const float* b_g2, float* G) {
    for (long i = c.gt; i < (long)T * 128; i += c.GT) {
        const int n = (int)(i & 127); const long t = i >> 7;
        float z = b_g2[n];
#pragma unroll
        for (int r = 0; r < 16; ++r) z = fmaf(GG[t * 16 + r], w_g2[r * 128 + n], z);
        const float ls = fminf(z, 0.f) - log1pf(__expf(-fabsf(z)));
        G[i] = ls * (1.f / 16.f);
    }
}
__device__ __forceinline__ void ph_gla_cum(const Ctx& c, float* G) {
    if (c.gt < NB * 128) {
        const int b = (int)(c.gt >> 7), n = (int)(c.gt & 127); float acc = 0.f;
        for (int s = 0; s < S; ++s) { const size_t i = ((size_t)b * S + s) * 128 + n; acc += G[i]; G[i] = acc; }
    }
}
__device__ __forceinline__ void ph_gla_naive(const Ctx& c, const bf16_t* PROJ, const float* G, const float* gnw, bf16_t* MIX, float* ldsf) {
    const int lane = c.lane;
    for (int W = c.gw; W < (T / 64) * 4; W += c.NGW) {
        const int cgk = W >> 2, h = W & 3; const int t = cgk * 64 + lane; const int b = (cgk * 64) / S; const int nk = ((cgk * 64) % S) + 64; const int kb = b * S;
        float q[32], gi[32];
        const bf16_t* qp = PROJ + (size_t)t * NP + P_GQ + h * 32;
#pragma unroll
        for (int d = 0; d < 32; ++d) { q[d] = bf2f(qp[d]); gi[d] = G[(size_t)t * 128 + h * 32 + d]; }
        float ss = 0.f; float o[32];
        float* o0 = ldsf + c.wave * 2048 + lane;
#pragma unroll 1
        for (int vh = 0; vh < 2; ++vh) {
#pragma unroll
            for (int e = 0; e < 32; ++e) o[e] = 0.f;
            for (int j = 0; j < nk; ++j) {
                const bf16_t* kr = PROJ + (size_t)(kb + j) * NP + P_GK + h * 32; const bf16_t* vr = PROJ + (size_t)(kb + j) * NP + P_GV + h * 64 + vh * 32;
                const float* gj = G + (size_t)(kb + j) * 128 + h * 32;
                float s = 0.f;
#pragma unroll
                for (int d = 0; d < 32; ++d) s = fmaf(q[d] * bf2f(kr[d]), __expf(-fabsf(gi[d] - gj[d])), s);
#pragma unroll
                for (int e = 0; e < 32; ++e) o[e] = fmaf(s, bf2f(vr[e]), o[e]);
            }
#pragma unroll
            for (int e = 0; e < 32; ++e) ss += o[e] * o[e];
            if (vh == 0) {
#pragma unroll
                for (int e = 0; e < 32; ++e) o0[e * 64] = o[e];
            }
        }
        const float rstd = rsqrtf(ss * (1.f / 64.f) + EPS);
        const bf16_t* z = PROJ + (size_t)t * NP + P_GZ + h * 64; bf16_t* mo = MIX + (size_t)t * 1024 + 768 + h * 64;
#pragma unroll
        for (int e = 0; e < 32; ++e) mo[e] = (bf16_t)f2bf(o0[e * 64] * rstd * gnw[e] * bf2f(z[e]));
#pragma unroll
        for (int e = 0; e < 32; ++e) mo[32 + e] = (bf16_t)f2bf(o[e] * rstd * gnw[32 + e] * bf2f(z[32 + e]));
    }
}

constexpr int NTHREADS = 512;
constexpr int LDS_BYTES = 147456;
__global__ void __launch_bounds__(NTHREADS, 2) mk_fwd(Params p) {
    extern __shared__ __attribute__((aligned(16))) unsigned char lds[];
    cg::grid_group grid = cg::this_grid();
    Ctx c; c.tid = threadIdx.x; c.lane = c.tid & 63; c.wave = __builtin_amdgcn_readfirstlane(c.tid >> 6);
    c.gw = blockIdx.x * (NTHREADS / 64) + c.wave; c.NGW = gridDim.x * (NTHREADS / 64);
    c.gt = (long)blockIdx.x * NTHREADS + c.tid; c.GT = (long)gridDim.x * NTHREADS;
    unsigned char* ws = p.ws;
    float* ADA = (float*)(ws + WS_ADA); const float2* CS32 = (const float2*)(ws + WS_CS32); const float2* CS16 = (const float2*)(ws + WS_CS16);
    bf16_t* WinT = (bf16_t*)(ws + WS_WIN); bf16_t* WuqT = (bf16_t*)(ws + WS_WUQ); bf16_t* WukvT = (bf16_t*)(ws + WS_WUKV); bf16_t* WoutT = (bf16_t*)(ws + WS_WOUT);
    float* RSQ = (float*)(ws + WS_RSQ); float* RSKV = (float*)(ws + WS_RSKV); float* GG = (float*)(ws + WS_GG);
    bf16_t* H = (bf16_t*)(ws + WS_H); bf16_t* PROJ = (bf16_t*)(ws + WS_PROJ); bf16_t* Q = (bf16_t*)(ws + WS_Q); bf16_t* KV = (bf16_t*)(ws + WS_KV); bf16_t* MIX = (bf16_t*)(ws + WS_MIX);
    float* GC = (float*)(ws + WS_GCUM);
    PG8_LAS unsigned char* ldsp = (PG8_LAS unsigned char*)lds;

    ph_prep(p, fresh(c));
    grid.sync();
#pragma unroll 1
    for (int l = 0; l < DEPTH; ++l) {
        const float* xin = (l == 0) ? p.x : p.out;
        const float* ADA_l = ADA + (size_t)l * NB * 3072;
        ph_norm(fresh(c), xin, p.norm_w + l * D, ADA_l, H);
        grid.sync();
        run_gemm(ldsp, H, D, WinT + (size_t)l * NP * 1024, T, NP, 1024, EpiIn{PROJ, GG, CS32, CS16});
        grid.sync();
        ph_rstd(fresh(c), PROJ, RSQ, RSKV);
        ph_gla_la(fresh(c), GG, p.w_g2 + (size_t)l * 16 * 128, p.b_g2 + l * 128, GC);
        grid.sync();
        run_gemm(ldsp, PROJ + P_MQ, NP, WuqT + (size_t)l * 768 * 256, T, 768, 256, EpiQ{Q, RSQ, CS16});
        run_gemm(ldsp, PROJ + P_MKV, NP, WukvT + (size_t)l * 1024 * 128, T, 1024, 128, EpiKV{KV, RSKV});
        ph_gla_cum(fresh(c), GC);
        grid.sync();
        ph_attn_naive(fresh(c), Q, KV, PROJ, MIX);
        ph_ret_naive(fresh(c), PROJ, MIX);
        ph_gla_naive(fresh(c), PROJ, GC, p.gnw + l * 64, MIX, (float*)lds);
        grid.sync();
        run_gemm(ldsp, MIX, 1024, WoutT + (size_t)l * 1024 * 1024, T, 1024, 1024, EpiOut{xin, p.out, ADA_l});
        grid.sync();
    }
    ph_final(fresh(c), p.out, p.fnw, p.out);
}

extern "C" void kernel_launch(void* const* d_in, const int* in_sizes, int n_in, void* d_out, int out_size, void* d_ws, size_t ws_size, hipStream_t stream) {
    static int grid_blocks = 0;
    if (grid_blocks == 0) {
        if (n_in != 16 || in_sizes[0] != T * D || out_size != T * D || ws_size < WS_END) {
            fprintf(stderr, "kernel_launch: shape/ws mismatch n_in %d in0 %d out %d ws %zu (need %zu)\n", n_in, n_in > 0 ? in_sizes[0] : -1, out_size, ws_size, (size_t)WS_END);
            grid_blocks = -1; return;
        }
        int dev = 0, cus = 0, per_cu = 0;
        hipGetDevice(&dev); hipDeviceGetAttribute(&cus, hipDeviceAttributeMultiprocessorCount, dev);
        if (hipFuncSetAttribute((const void*)mk_fwd, hipFuncAttributeMaxDynamicSharedMemorySize, LDS_BYTES) != hipSuccess) { fprintf(stderr, "kernel_launch: hipFuncSetAttribute failed\n"); grid_blocks = -1; return; }
        if (hipOccupancyMaxActiveBlocksPerMultiprocessor(&per_cu, (const void*)mk_fwd, NTHREADS, LDS_BYTES) != hipSuccess || per_cu < 1) { fprintf(stderr, "kernel_launch: occupancy query says %d blocks/CU\n", per_cu); grid_blocks = -1; return; }
        grid_blocks = cus;
        fprintf(stderr, "kernel_launch: cus %d per_cu %d grid %d\n", cus, per_cu, grid_blocks);
    }
    if (grid_blocks < 0) return;
    Params p{};
    p.x = (const float*)d_in[0]; p.c = (const float*)d_in[1]; p.pos = (const int*)d_in[2]; p.norm_w = (const float*)d_in[3]; p.ada_w = (const float*)d_in[4];
    p.ada_b = (const float*)d_in[5]; p.w_in = (const float*)d_in[6]; p.qnw = (const float*)d_in[7]; p.w_uq = (const float*)d_in[8]; p.kvnw = (const float*)d_in[9];
    p.w_ukv = (const float*)d_in[10]; p.w_g2 = (const float*)d_in[11]; p.b_g2 = (const float*)d_in[12]; p.gnw = (const float*)d_in[13]; p.w_out = (const float*)d_in[14];
    p.fnw = (const float*)d_in[15]; p.out = (float*)d_out; p.ws = (unsigned char*)d_ws;
    void* args[] = {&p};
    hipError_t e = hipLaunchCooperativeKernel((void*)mk_fwd, dim3(grid_blocks), dim3(NTHREADS), args, LDS_BYTES, stream);
    if (e != hipSuccess) fprintf(stderr, "cooperative launch failed: %s (grid %d)\n", hipGetErrorString(e), grid_blocks);
}
```

```cpp
#include <hip/hip_runtime.h>
#include <hip/hip_cooperative_groups.h>
namespace cg = cooperative_groups;
#include <cstdio>
#include <cstdint>
#include <cmath>

typedef unsigned short bf16_t;
typedef short bf16x8 __attribute__((ext_vector_type(8)));
typedef float f32x4 __attribute__((ext_vector_type(4)));
typedef unsigned u32x4 __attribute__((ext_vector_type(4)));
typedef unsigned u32x2 __attribute__((ext_vector_type(2)));

constexpr int D = 1024, NB = 32, S = 2048, T = NB * S, DEPTH = 2, CH = 64;
constexpr int NIN = 2736, NP = 2816;
constexpr float EPS = 1e-6f;
constexpr int P_RQ = 0, P_RK = 256, P_RV = 512, P_RZ = 768, P_MQ = 1024, P_MKV = 1280, P_KPE = 1408, P_GG = 1440, P_PAD = 1456,
              P_MZ = 1536, P_GQ = 2048, P_GK = 2176, P_GV = 2304, P_GZ = 2560;
constexpr float QSCALE = 0.10206207261596577f * 1.4426950408889634f;

constexpr size_t MiB = 1u << 20;
constexpr size_t WS_CTL = 0;
constexpr size_t WS_ADA = 1 * MiB;
constexpr size_t WS_CS32 = 2 * MiB;
constexpr size_t WS_CS16 = 18 * MiB;
constexpr size_t WS_WIN = 26 * MiB;
constexpr size_t WS_WUQ = 38 * MiB;
constexpr size_t WS_WUKV = 39 * MiB;
constexpr size_t WS_WOUT = 40 * MiB;
constexpr size_t WS_RSQ = 44 * MiB;
constexpr size_t WS_RSKV = 45 * MiB;
constexpr size_t WS_GG = 46 * MiB;
constexpr size_t WS_H = 50 * MiB;
constexpr size_t WS_PROJ = 178 * MiB;
constexpr size_t WS_Q = 530 * MiB;
constexpr size_t WS_KV = 626 * MiB;
constexpr size_t WS_MIX = 754 * MiB;
constexpr size_t WS_GCUM = 882 * MiB;
constexpr size_t WS_END = 914 * MiB;

__device__ __forceinline__ unsigned f2bf(float f) { unsigned u = __builtin_bit_cast(unsigned, f); return (u + 0x7fffu + ((u >> 16) & 1u)) >> 16; }
__device__ __forceinline__ unsigned pk2(float lo, float hi) { return f2bf(lo) | (f2bf(hi) << 16); }
__device__ __forceinline__ float bf2f(bf16_t v) { return __builtin_bit_cast(float, (unsigned)v << 16); }
__device__ __forceinline__ float silu_f(float x) { return x / (1.f + __expf(-x)); }

__host__ __device__ inline int in_logical(int p) {
    if (p < 512) { int c = p & 63; return (p & ~63) + (c >> 1) + 32 * (c & 1); }
    if (p < 1408) return p;
    if (p < 1440) { int c = p - 1408; return 1408 + (c >> 1) + 16 * (c & 1); }
    if (p < 1456) return 2464 + (p - 1440);
    if (p < 1536) return -1;
    if (p < 2048) return 1440 + (p - 1536);
    if (p < 2304) return 1952 + (p - 2048);
    if (p < 2560) return 2208 + (p - 2304);
    return 2480 + (p - 2560);
}
__host__ __device__ inline int uq_logical(int p) {
    int h = p / 96, c = p % 96;
    if (c < 64) return p;
    int cc = c - 64; return h * 96 + 64 + (cc >> 1) + 16 * (cc & 1);
}

struct Params {
    const float* x; const float* c; const int* pos; const float* norm_w; const float* ada_w; const float* ada_b; const float* w_in; const float* qnw;
    const float* w_uq; const float* kvnw; const float* w_ukv; const float* w_g2; const float* b_g2; const float* gnw; const float* w_out; const float* fnw;
    float* out; unsigned char* ws;
};
struct Ctx { int tid, lane, wave, gw, NGW; long gt, GT; };
__device__ __forceinline__ Ctx fresh(const Ctx& c) { Ctx r = c; asm volatile("" : "+v"(r.lane), "+v"(r.tid)); asm volatile("" : "+s"(r.gw)); r.gt = (long)blockIdx.x * 512 + r.tid; return r; }

__device__ __forceinline__ float wave_sum(float v) {
#pragma unroll
    for (int o = 1; o < 64; o <<= 1) v += __shfl_xor(v, o);
    return v;
}

__device__ __forceinline__ void ph_prep(const Params& p, const Ctx& c) {
    unsigned char* ws = p.ws;
    bf16_t* WinT = (bf16_t*)(ws + WS_WIN); bf16_t* WuqT = (bf16_t*)(ws + WS_WUQ); bf16_t* WukvT = (bf16_t*)(ws + WS_WUKV); bf16_t* WoutT = (bf16_t*)(ws + WS_WOUT);
    float2* CS32 = (float2*)(ws + WS_CS32); float2* CS16 = (float2*)(ws + WS_CS16); float* ADA = (float*)(ws + WS_ADA);
    const long gsz = c.GT, g0 = c.gt;
    for (long i = g0; i < (long)DEPTH * NP * 1024; i += gsz) {
        int k = (int)(i & 1023); long r = i >> 10; int pp = (int)(r % NP), l = (int)(r / NP);
        int lc = in_logical(pp);
        float v = lc >= 0 ? p.w_in[((size_t)l * 1024 + k) * NIN + lc] : 0.f;
        WinT[i] = (bf16_t)f2bf(v);
    }
    for (long i = g0; i < (long)DEPTH * 768 * 256; i += gsz) {
        int k = (int)(i & 255); long r = i >> 8; int pp = (int)(r % 768), l = (int)(r / 768);
        WuqT[i] = (bf16_t)f2bf(p.qnw[l * 256 + k] * p.w_uq[((size_t)l * 256 + k) * 768 + uq_logical(pp)]);
    }
    for (long i = g0; i < (long)DEPTH * 1024 * 128; i += gsz) {
        int k = (int)(i & 127); long r = i >> 7; int n = (int)(r % 1024), l = (int)(r / 1024);
        WukvT[i] = (bf16_t)f2bf(p.kvnw[l * 128 + k] * p.w_ukv[((size_t)l * 128 + k) * 1024 + n]);
    }
    for (long i = g0; i < (long)DEPTH * 1024 * 1024; i += gsz) {
        int k = (int)(i & 1023); long r = i >> 10; int n = (int)(r % 1024), l = (int)(r / 1024);
        WoutT[i] = (bf16_t)f2bf(p.w_out[((size_t)l * 1024 + k) * 1024 + n]);
    }
    for (long i = g0; i < (long)T * 32; i += gsz) {
        int j = (int)(i & 31); int t = (int)(i >> 5);
        double inv = pow(10000.0, -(double)j / 32.0), a = (double)p.pos[t] * inv; double s, cc; sincos(a, &s, &cc);
        CS32[i] = make_float2((float)cc, (float)s);
    }
    for (long i = g0; i < (long)T * 16; i += gsz) {
        int j = (int)(i & 15); int t = (int)(i >> 4);
        double inv = pow(10000.0, -(double)j / 16.0), a = (double)p.pos[t] * inv; double s, cc; sincos(a, &s, &cc);
        CS16[i] = make_float2((float)cc, (float)s);
    }
    for (long i = g0; i < (long)DEPTH * NB * 3072; i += gsz) {
        int n = (int)(i % 3072), b = (int)((i / 3072) % NB), l = (int)(i / (3072 * NB));
        float acc = 0.f;
        for (int k = 0; k < 1024; ++k) acc = fmaf(silu_f(p.c[b * 1024 + k]), p.ada_w[((size_t)l * 1024 + k) * 3072 + n], acc);
        ADA[i] = acc + p.ada_b[l * 3072 + n];
    }
}

__device__ __forceinline__ void ph_norm(const Ctx& c, const float* x, const float* nw, const float* ADA_l, bf16_t* H) {
    const int lane = c.lane;
    for (int row = c.gw; row < T; row += c.NGW) {
        const int b = row / S;
        const f32x4* xr = (const f32x4*)(x + (size_t)row * D) + lane;
        f32x4 v[4]; float s = 0.f;
#pragma unroll
        for (int j = 0; j < 4; ++j) { v[j] = xr[64 * j]; s += v[j].x * v[j].x + v[j].y * v[j].y + v[j].z * v[j].z + v[j].w * v[j].w; }
        const float rstd = rsqrtf(wave_sum(s) * (1.f / D) + EPS);
        const float* shift = ADA_l + (size_t)b * 3072; const float* scale = shift + 1024;
        u32x2* o = (u32x2*)(H + (size_t)row * D) + lane;
#pragma unroll
        for (int j = 0; j < 4; ++j) {
            const int c0 = 4 * lane + 256 * j; const f32x4 w = *(const f32x4*)(nw + c0), sc = *(const f32x4*)(scale + c0), sh = *(const f32x4*)(shift + c0);
            f32x4 y;
            y.x = v[j].x * rstd * w.x * (1.f + sc.x) + sh.x; y.y = v[j].y * rstd * w.y * (1.f + sc.y) + sh.y;
            y.z = v[j].z * rstd * w.z * (1.f + sc.z) + sh.z; y.w = v[j].w * rstd * w.w * (1.f + sc.w) + sh.w;
            u32x2 pk; pk.x = pk2(y.x, y.y); pk.y = pk2(y.z, y.w); o[64 * j] = pk;
        }
    }
}

__device__ __forceinline__ void ph_final(const Ctx& c, const float* x, const float* w, float* out) {
    const int lane = c.lane;
    for (int row = c.gw; row < T; row += c.NGW) {
        const f32x4* xr = (const f32x4*)(x + (size_t)row * D) + lane;
        f32x4 v[4]; float s = 0.f;
#pragma unroll
        for (int j = 0; j < 4; ++j) { v[j] = xr[64 * j]; s += v[j].x * v[j].x + v[j].y * v[j].y + v[j].z * v[j].z + v[j].w * v[j].w; }
        const float rstd = rsqrtf(wave_sum(s) * (1.f / D) + EPS);
        f32x4* o = (f32x4*)(out + (size_t)row * D) + lane;
#pragma unroll
        for (int j = 0; j < 4; ++j) { const f32x4 ww = *(const f32x4*)(w + 4 * lane + 256 * j); o[64 * j] = v[j] * rstd * ww; }
    }
}

__device__ __forceinline__ f32x4 rope4(f32x4 v, float2 a, float2 b) { f32x4 o; o.x = v.x * a.x - v.y * a.y; o.y = v.y * a.x + v.x * a.y; o.z = v.z * b.x - v.w * b.y; o.w = v.w * b.x + v.z * b.y; return o; }
__device__ __forceinline__ f32x4 silu4(f32x4 v) { v.x = silu_f(v.x); v.y = silu_f(v.y); v.z = silu_f(v.z); v.w = silu_f(v.w); return v; }
struct EpiIn {
    bf16_t* PROJ; float* GG; const float2* CS32; const float2* CS16;
    __device__ __forceinline__ void operator()(int row, int col, f32x4 v) const {
        if (col < 512) {
            const int j = (col & 63) >> 1; v = rope4(v, CS32[(size_t)row * 32 + j], CS32[(size_t)row * 32 + j + 1]);
            if (col >= 256) v = v * 0.125f;
        } else if (col < 768) {
        } else if (col < 1024) { v = silu4(v);
        } else if (col < 1408) {
        } else if (col < 1440) {
            const int j = (col - 1408) >> 1; v = rope4(v, CS16[(size_t)row * 16 + j], CS16[(size_t)row * 16 + j + 1]);
        } else if (col < 1456) { *(f32x4*)(GG + (size_t)row * 16 + (col - 1440)) = v; return;
        } else if (col < 1536) { return;
        } else if (col < 2048) { v = silu4(v);
        } else if (col < 2176) {
        } else if (col < 2304) { v = v * 0.17677669529663687f;
        } else if (col < 2560) {
        } else { v = silu4(v); }
        u32x2 pk; pk.x = pk2(v.x, v.y); pk.y = pk2(v.z, v.w); *(u32x2*)(PROJ + (size_t)row * NP + col) = pk;
    }
};
struct EpiQ {
    bf16_t* Q; const float* RSQ; const float2* CS16;
    __device__ __forceinline__ void operator()(int row, int col, f32x4 v) const {
        v = v * RSQ[row]; const int cc = col % 96;
        if (cc >= 64) { const int j = (cc - 64) >> 1; v = rope4(v, CS16[(size_t)row * 16 + j], CS16[(size_t)row * 16 + j + 1]); }
        v = v * QSCALE;
        u32x2 pk; pk.x = pk2(v.x, v.y); pk.y = pk2(v.z, v.w); *(u32x2*)(Q + (size_t)row * 768 + col) = pk;
    }
};
struct EpiKV {
    bf16_t* KV; const float* RSKV;
    __device__ __forceinline__ void operator()(int row, int col, f32x4 v) const {
        v = v * RSKV[row];
        u32x2 pk; pk.x = pk2(v.x, v.y); pk.y = pk2(v.z, v.w); *(u32x2*)(KV + (size_t)row * 1024 + col) = pk;
    }
};
struct EpiOut {
    const float* xi; float* xo; const float* ADA_l;
    __device__ __forceinline__ void operator()(int row, int col, f32x4 v) const {
        const int b = row / S; const f32x4 g = *(const f32x4*)(ADA_l + (size_t)b * 3072 + 2048 + col);
        const f32x4 xv = *(const f32x4*)(xi + (size_t)row * D + col);
        *(f32x4*)(xo + (size_t)row * D + col) = xv + g * v;
    }
};

namespace pg8 {
#define PG8_LAS __attribute__((address_space(3)))
constexpr int BM = 256, BK = 64, HALF = 128, HTB = HALF * BK * 2  , STAGE_BYTES = 8 * HTB, NXCD = 8, WGM = 8;

__host__ __device__ __forceinline__ int lds_byte(int r, int c) { const int st = (r >> 4) * 2 + (c >> 5), rr = r & 15, cc = c & 31, ob = rr * 64 + cc * 2; return st * 1024 + (ob ^ (((ob >> 9) & 1) << 5)); }
__host__ __device__ __forceinline__ void stage_rc(int b, int& R, int& C) { const int st = b / 1024, sb = b % 1024, swz = sb ^ (((sb >> 9) & 1) << 5); R = (st >> 1) * 16 + swz / 64; C = (st & 1) * 32 + (swz % 64) / 2; }
__host__ __device__ __forceinline__ int perm32(int rho) { const int n = rho >> 4, i = rho & 15; return 8 * (i >> 2) + 4 * n + (i & 3); }

struct Unit { int pm, pn; };
struct Gemm { const bf16_t* A; const bf16_t* Bt; int M, N, K, lda; };

struct StaticOrder {
    int nM, nN, nwg, G, c;
    __host__ __device__ void init(int M, int N, int G_, int c_) { nM = M / BM; nN = N / BM; nwg = nM * nN; G = G_; c = c_; }
    __host__ __device__ bool next(int i, Unit& u) const {
        const long L = (long)i * G + c; if (L >= nwg) return false;
        int wgid = (int)L; { const int q = nwg / NXCD, r = nwg % NXCD, xcd = wgid % NXCD, off = wgid / NXCD; wgid = (xcd < r ? xcd * (q + 1) : r * (q + 1) + (xcd - r) * q) + off; }
        const int nig = WGM * nN, gid = wgid / nig, fm = gid * WGM, gsz = (nM - fm) < WGM ? (nM - fm) : WGM;
        u.pm = fm + ((wgid % nig) % gsz); u.pn = (wgid % nig) / gsz; return true;
    }
    __device__ __forceinline__ void a_ready(const Unit&) const {}
    __device__ __forceinline__ void done(const Unit&) const {}
};

template <class Epi, class Sched, bool ALIGN_EPI = false, bool SP2 = false>
__device__ __forceinline__ void gemm_phase(PG8_LAS unsigned char* lds, const Gemm g, const Sched& S, const Epi& E) {
    int tid_ = threadIdx.x; asm volatile("" : "+v"(tid_));
    const int tid = tid_, wid = __builtin_amdgcn_readfirstlane(tid >> 6), lane = tid & 63, wr = wid >> 2, wc = wid & 3, fr = lane & 15, fq = lane >> 4;
    const int K = g.K, nt = K / BK;
    unsigned voffA[2], voffB[2];
#pragma unroll
    for (int i = 0; i < 2; ++i) { int R, C; stage_rc(tid * 16 + i * 8192, R, C); const int Rb = Epi::PERM ? ((R & ~31) + perm32(R & 31)) : R;
        voffA[i] = (unsigned)(R * g.lda + C) * 2u; voffB[i] = (unsigned)(Rb * K + C) * 2u; }
    const size_t kstep = (size_t)(BK * 2);
    const size_t hstep = (size_t)HALF * K * 2;
    const size_t tstep = 2 * hstep; const size_t hstepA = (size_t)HALF * g.lda * 2, tstepA = 2 * hstepA;
    const unsigned ldsw = (unsigned)wid * 1024u;
    const int aoff = lds_byte(wr * 64 + fr, fq * 8), boff = lds_byte(wc * 32 + fr, fq * 8);
#define PG8_SA(b, h) (((b) * 2 + (h)) * HTB)
#define PG8_SB(b, h) ((4 + (b) * 2 + (h)) * HTB)
#define PG8_STAGE(bufoff, gbase, voff) do { _Pragma("unroll") for (int _i = 0; _i < 2; ++_i) \
        __builtin_amdgcn_global_load_lds((const unsigned*)((const char*)(gbase) + (voff)[_i]), (PG8_LAS unsigned*)(lds + (bufoff) + ldsw + _i * 8192), 16, 0, 0); } while (0)
#define PG8_LDA(dst, b, h) do { _Pragma("unroll") for (int m = 0; m < 4; ++m) _Pragma("unroll") for (int k = 0; k < 2; ++k) dst[m][k] = *(const PG8_LAS bf16x8*)(lds + PG8_SA(b, h) + aoff + m * 2048 + k * 1024); } while (0)
#define PG8_LDB(dst, b, h) do { _Pragma("unroll") for (int n = 0; n < 2; ++n) _Pragma("unroll") for (int k = 0; k < 2; ++k) dst[n][k] = *(const PG8_LAS bf16x8*)(lds + PG8_SB(b, h) + boff + n * 2048 + k * 1024); } while (0)
#define PG8_MMA(ai, bj, At, Bt) do { __builtin_amdgcn_s_setprio(1); _Pragma("unroll") for (int m = 0; m < 4; ++m) _Pragma("unroll") for (int n = 0; n < 2; ++n) _Pragma("unroll") for (int k = 0; k < 2; ++k) \
        acc[ai][bj][m][n] = __builtin_amdgcn_mfma_f32_16x16x32_bf16(Bt[n][k], At[m][k], acc[ai][bj][m][n], 0, 0, 0); __builtin_amdgcn_s_setprio(0); } while (0)
#define PG8_WAIT_V(n) asm volatile("s_waitcnt vmcnt(" #n ")" ::: "memory")
#define PG8_WAIT_L(n) asm volatile("s_waitcnt lgkmcnt(" #n ")" ::: "memory")
#define PG8_BAR __builtin_amdgcn_s_barrier()
#define PG8_SCHED __builtin_amdgcn_sched_barrier(0)
    Unit cur, nxt; int ui = 0;
    if (!S.next(0, cur)) return;
    f32x4 acc[2][2][4][2];
#pragma unroll
    for (int a = 0; a < 2; ++a)
#pragma unroll
        for (int b = 0; b < 2; ++b)
#pragma unroll
            for (int m = 0; m < 4; ++m)
#pragma unroll
                for (int n = 0; n < 2; ++n) acc[a][b][m][n] = (f32x4){0.f, 0.f, 0.f, 0.f};
    bf16x8 At[4][2], B0[2][2], B1[2][2];
    const char* cA = (const char*)g.A + (size_t)cur.pm * tstepA; const char* cB = (const char*)g.Bt + (size_t)cur.pn * tstep;
    S.a_ready(cur);
    if constexpr (SP2) {
        PG8_STAGE(PG8_SB(0, 0), cB, voffB); PG8_STAGE(PG8_SB(0, 1), cB + hstep, voffB); PG8_STAGE(PG8_SA(0, 0), cA, voffA); PG8_STAGE(PG8_SA(0, 1), cA + hstepA, voffA);
        if (wr == 1) PG8_BAR;
        PG8_WAIT_V(2); PG8_BAR;
        PG8_STAGE(PG8_SB(1, 0), cB + kstep, voffB); PG8_STAGE(PG8_SA(1, 0), cA + kstep, voffA); PG8_STAGE(PG8_SB(1, 1), cB + hstep + kstep, voffB);
        PG8_WAIT_V(6); PG8_BAR;
    } else {
        PG8_STAGE(PG8_SB(0, 0), cB, voffB); PG8_STAGE(PG8_SA(0, 0), cA, voffA); PG8_STAGE(PG8_SB(0, 1), cB + hstep, voffB); PG8_STAGE(PG8_SA(0, 1), cA + hstepA, voffA);
        if (wr == 1) PG8_BAR;
        PG8_WAIT_V(4); PG8_BAR;
        PG8_STAGE(PG8_SB(1, 0), cB + kstep, voffB); PG8_STAGE(PG8_SA(1, 0), cA + kstep, voffA); PG8_STAGE(PG8_SB(1, 1), cB + hstep + kstep, voffB);
        PG8_WAIT_V(6); PG8_BAR;
    }
    for (;;) {
        const bool has_next = S.next(ui + 1, nxt);
        const char* nA = has_next ? (const char*)g.A + (size_t)nxt.pm * tstepA : cA; const char* nB = has_next ? (const char*)g.Bt + (size_t)nxt.pn * tstep : cB;
        for (int t = 0; t < nt; t += 2) {
            const bool last = (t == nt - 2);
            const char* a1 = cA + (size_t)(t + 1) * kstep;
            const char* a2 = last ? nA : cA + (size_t)(t + 2) * kstep; const char* b2 = last ? nB : cB + (size_t)(t + 2) * kstep;
            const char* a3 = a2 + kstep; const char* b3 = b2 + kstep;
            if (last && has_next) S.a_ready(nxt);
            if constexpr (SP2) {
            PG8_LDB(B0, 0, 0); PG8_LDB(B1, 0, 1); PG8_SCHED; PG8_LDA(At, 0, 0); PG8_STAGE(PG8_SA(1, 1), a1 + hstepA, voffA);
            PG8_WAIT_V(8); PG8_WAIT_L(0); PG8_BAR; PG8_MMA(0, 0, At, B0); PG8_MMA(0, 1, At, B1); PG8_BAR; PG8_SCHED;
            PG8_LDA(At, 0, 1); PG8_STAGE(PG8_SB(0, 0), b2, voffB); PG8_STAGE(PG8_SB(0, 1), b2 + hstep, voffB); PG8_STAGE(PG8_SA(0, 0), a2, voffA);
            PG8_WAIT_V(8); PG8_WAIT_L(0); PG8_BAR; PG8_MMA(1, 0, At, B0); PG8_MMA(1, 1, At, B1); PG8_BAR; PG8_SCHED;
            PG8_LDB(B0, 1, 0); PG8_LDB(B1, 1, 1); PG8_SCHED; PG8_LDA(At, 1, 0); PG8_STAGE(PG8_SA(0, 1), a2 + hstepA, voffA);
            PG8_WAIT_V(8); PG8_WAIT_L(0); PG8_BAR; PG8_MMA(0, 0, At, B0); PG8_MMA(0, 1, At, B1); PG8_BAR; PG8_SCHED;
            PG8_LDA(At, 1, 1); PG8_STAGE(PG8_SB(1, 0), b3, voffB); PG8_STAGE(PG8_SB(1, 1), b3 + hstep, voffB); PG8_STAGE(PG8_SA(1, 0), a3, voffA);
            PG8_WAIT_V(8); PG8_WAIT_L(0); PG8_BAR; PG8_MMA(1, 0, At, B0); PG8_MMA(1, 1, At, B1); PG8_BAR; PG8_SCHED;
            } else {
            PG8_LDB(B0, 0, 0); PG8_SCHED; PG8_LDA(At, 0, 0); PG8_STAGE(PG8_SA(1, 1), a1 + hstepA, voffA);
            PG8_WAIT_L(8); PG8_BAR; PG8_WAIT_L(0); PG8_MMA(0, 0, At, B0); PG8_BAR; PG8_SCHED;
            PG8_LDB(B1, 0, 1); PG8_STAGE(PG8_SB(0, 0), b2, voffB);
            PG8_BAR; PG8_WAIT_L(0); PG8_MMA(0, 1, At, B1); PG8_BAR;
            PG8_LDA(At, 0, 1); PG8_STAGE(PG8_SA(0, 0), a2, voffA);
            PG8_BAR; PG8_WAIT_L(0); PG8_MMA(1, 0, At, B0); PG8_BAR; PG8_SCHED;
            PG8_STAGE(PG8_SB(0, 1), b2 + hstep, voffB);
            PG8_WAIT_V(6); PG8_BAR; PG8_MMA(1, 1, At, B1); PG8_BAR;
            PG8_LDB(B0, 1, 0); PG8_SCHED; PG8_LDA(At, 1, 0); PG8_STAGE(PG8_SA(0, 1), a2 + hstepA, voffA);
            PG8_WAIT_L(8); PG8_BAR; PG8_WAIT_L(0); PG8_MMA(0, 0, At, B0); PG8_BAR; PG8_SCHED;
            PG8_LDB(B1, 1, 1); PG8_STAGE(PG8_SB(1, 0), b3, voffB);
            PG8_BAR; PG8_WAIT_L(0); PG8_MMA(0, 1, At, B1); PG8_BAR;
            PG8_LDA(At, 1, 1); PG8_STAGE(PG8_SA(1, 0), a3, voffA);
            PG8_BAR; PG8_WAIT_L(0); PG8_MMA(1, 0, At, B0); PG8_BAR; PG8_SCHED;
            PG8_STAGE(PG8_SB(1, 1), b3 + hstep, voffB);
            PG8_WAIT_V(6); PG8_BAR; PG8_MMA(1, 1, At, B1); PG8_BAR;
            }
        }
        if constexpr (ALIGN_EPI) { if (wr == 0) PG8_BAR; }
        if constexpr (!Epi::AFTER_DRAIN) { E(acc, cur, wr, wc, fr, fq); S.done(cur); }
        if (!has_next) break;
#pragma unroll
        for (int a = 0; a < 2; ++a)
#pragma unroll
            for (int b = 0; b < 2; ++b)
#pragma unroll
                for (int m = 0; m < 4; ++m)
#pragma unroll
                    for (int n = 0; n < 2; ++n) acc[a][b][m][n] = (f32x4){0.f, 0.f, 0.f, 0.f};
        cur = nxt; cA = nA; cB = nB; ++ui;
        if constexpr (ALIGN_EPI) { if (wr == 1) PG8_BAR; }
    }
    PG8_WAIT_V(0);
    if constexpr (!ALIGN_EPI) { if (wr == 0) PG8_BAR; }
    PG8_BAR;
    if constexpr (Epi::AFTER_DRAIN) { E.fused(acc, cur, wr, wc, fr, fq, lds, wid, lane); S.done(cur); }
#undef PG8_SA
#undef PG8_SB
#undef PG8_STAGE
#undef PG8_LDA
#undef PG8_LDB
#undef PG8_MMA
#undef PG8_WAIT_V
#undef PG8_WAIT_L
#undef PG8_BAR
#undef PG8_SCHED
}
}

template <class E> struct EpiAd {
    static constexpr bool PERM = false, AFTER_DRAIN = false;
    E e;
    __device__ __forceinline__ void operator()(const f32x4 (&acc)[2][2][4][2], const pg8::Unit& u, int wr, int wc, int fr, int fq) const {
#pragma unroll
        for (int ai = 0; ai < 2; ++ai)
#pragma unroll
            for (int m = 0; m < 4; ++m) {
                const int row = u.pm * 256 + ai * 128 + wr * 64 + m * 16 + fr;
#pragma unroll
                for (int bj = 0; bj < 2; ++bj)
#pragma unroll
                    for (int n = 0; n < 2; ++n) e(row, u.pn * 256 + bj * 128 + wc * 32 + n * 16 + 4 * fq, acc[ai][bj][m][n]);
            }
    }
};
template <class E> __device__ __forceinline__ void run_gemm(PG8_LAS unsigned char* lds, const bf16_t* A, int lda, const bf16_t* Bt, int M, int N, int K, const E& e) {
    int Ko = K; asm volatile("" : "+s"(Ko));
    pg8::Gemm g{A, Bt, M, N, Ko, lda}; pg8::StaticOrder S; S.init(M, N, (int)gridDim.x, (int)blockIdx.x);
    EpiAd<E> ad{e};
    pg8::gemm_phase<EpiAd<E>, pg8::StaticOrder, true, true>(lds, g, S, ad);
}

template <class Epi>
__device__ __forceinline__ void gemm_wave(const Ctx& c, const bf16_t* A, int lda, const bf16_t* Bt, int M, int N, int K, const Epi& epi) {
    const int fr = c.lane & 15, fq = c.lane >> 4; const int ntn = N / 64, nt = (M / 32) * ntn;
    for (int tile = c.gw; tile < nt; tile += c.NGW) {
        const int m0 = (tile / ntn) * 32, n0 = (tile % ntn) * 64;
        f32x4 acc[2][4];
#pragma unroll
        for (int i = 0; i < 2; ++i)
#pragma unroll
            for (int j = 0; j < 4; ++j) acc[i][j] = (f32x4){0.f, 0.f, 0.f, 0.f};
        const bf16_t* ap = A + (size_t)(m0 + fr) * lda + fq * 8; const bf16_t* bp = Bt + (size_t)(n0 + fr) * K + fq * 8;
        for (int k0 = 0; k0 < K; k0 += 32) {
            bf16x8 a[2], b[4];
#pragma unroll
            for (int i = 0; i < 2; ++i) a[i] = *(const bf16x8*)(ap + (size_t)(16 * i) * lda + k0);
#pragma unroll
            for (int j = 0; j < 4; ++j) b[j] = *(const bf16x8*)(bp + (size_t)(16 * j) * K + k0);
#pragma unroll
            for (int i = 0; i < 2; ++i)
#pragma unroll
                for (int j = 0; j < 4; ++j) acc[i][j] = __builtin_amdgcn_mfma_f32_16x16x32_bf16(b[j], a[i], acc[i][j], 0, 0, 0);
        }
#pragma unroll
        for (int i = 0; i < 2; ++i)
#pragma unroll
            for (int j = 0; j < 4; ++j) epi(m0 + 16 * i + fr, n0 + 16 * j + 4 * fq, acc[i][j]);
    }
}

__device__ __forceinline__ void ph_rstd(const Ctx& c, const bf16_t* PROJ, float* RSQ, float* RSKV) {
    const int lane = c.lane;
    for (int row = c.gw; row < T; row += c.NGW) {
        const bf16_t* p = PROJ + (size_t)row * NP;
        float s = 0.f;
#pragma unroll
        for (int j = 0; j < 4; ++j) { const float v = bf2f(p[P_MQ + lane + 64 * j]); s += v * v; }
        s = wave_sum(s);
        float s2 = 0.f;
#pragma unroll
        for (int j = 0; j < 2; ++j) { const float v = bf2f(p[P_MKV + lane + 64 * j]); s2 += v * v; }
        s2 = wave_sum(s2);
        if (lane == 0) { RSQ[row] = rsqrtf(s * (1.f / 256.f) + EPS); RSKV[row] = rsqrtf(s2 * (1.f / 128.f) + EPS); }
    }
}

__device__ __forceinline__ void ph_attn_naive(const Ctx& c, const bf16_t* Q, const bf16_t* KV, const bf16_t* PROJ, bf16_t* MIX) {
    const int lane = c.lane;
    for (int W = c.gw; W < (T / 64) * 16; W += c.NGW) {
        const int cgk = W >> 4, h = (W >> 1) & 7, vh = W & 1; const int t = cgk * 64 + lane; const int b = (cgk * 64) / S; const int nk = ((cgk * 64) % S) + 64; const int kb = b * S;
        float q[96];
        const bf16_t* qp = Q + (size_t)t * 768 + h * 96;
#pragma unroll
        for (int d = 0; d < 96; ++d) q[d] = bf2f(qp[d]);
        float o[32];
#pragma unroll
        for (int e = 0; e < 32; ++e) o[e] = 0.f;
        float m = -1e30f, l = 0.f;
        for (int j = 0; j < nk; ++j) {
            const bf16_t* kn = KV + (size_t)(kb + j) * 1024 + h * 128; const bf16_t* kp = PROJ + (size_t)(kb + j) * NP + P_KPE;
            float s = 0.f;
#pragma unroll
            for (int d = 0; d < 64; ++d) s = fmaf(q[d], bf2f(kn[d]), s);
#pragma unroll
            for (int d = 0; d < 32; ++d) s = fmaf(q[64 + d], bf2f(kp[d]), s);
            const float mn = fmaxf(m, s); const float sc = exp2f(m - mn), pp = exp2f(s - mn); m = mn; l = l * sc + pp;
#pragma unroll
            for (int e = 0; e < 32; ++e) o[e] = o[e] * sc + pp * bf2f(kn[64 + vh * 32 + e]);
        }
        const float rl = 1.f / l;
        const bf16_t* z = PROJ + (size_t)t * NP + P_MZ + h * 64 + vh * 32; bf16_t* mo = MIX + (size_t)t * 1024 + 256 + h * 64 + vh * 32;
#pragma unroll
        for (int e = 0; e < 32; ++e) mo[e] = (bf16_t)f2bf(o[e] * rl * bf2f(z[e]));
    }
}

__device__ __forceinline__ void ph_ret_naive(const Ctx& c, const bf16_t* PROJ, bf16_t* MIX) {
    const int lane = c.lane;
    for (int W = c.gw; W < (T / 64) * 4; W += c.NGW) {
        const int cgk = W >> 2, h = W & 3; const int t = cgk * 64 + lane; const int b = (cgk * 64) / S; const int nk = ((cgk * 64) % S) + 64; const int kb = b * S;
        const float lg = log1pf(-exp2f(-5.f - (float)h));
        float q[64];
        const bf16_t* qp = PROJ + (size_t)t * NP + P_RQ + h * 64;
#pragma unroll
        for (int d = 0; d < 64; ++d) q[d] = bf2f(qp[d]);
        float o[64];
#pragma unroll
        for (int e = 0; e < 64; ++e) o[e] = 0.f;
        const int ti = t - kb;
        for (int j = 0; j < nk; ++j) {
            const bf16_t* kr = PROJ + (size_t)(kb + j) * NP + P_RK + h * 64; const bf16_t* vr = PROJ + (size_t)(kb + j) * NP + P_RV + h * 64;
            float s = 0.f;
#pragma unroll
            for (int d = 0; d < 64; ++d) s = fmaf(q[d], bf2f(kr[d]), s);
            const int dd = ti - j; s *= __expf(lg * (float)(dd < 0 ? -dd : dd));
#pragma unroll
            for (int e = 0; e < 64; ++e) o[e] = fmaf(s, bf2f(vr[e]), o[e]);
        }
        float ss = 0.f;
#pragma unroll
        for (int e = 0; e < 64; ++e) ss += o[e] * o[e];
        const float rstd = rsqrtf(ss * (1.f / 64.f) + EPS);
        const bf16_t* z = PROJ + (size_t)t * NP + P_RZ + h * 64; bf16_t* mo = MIX + (size_t)t * 1024 + h * 64;
#pragma unroll
        for (int e = 0; e < 64; ++e) mo[e] = (bf16_t)f2bf(o[e] * rstd * bf2f(z[e]));
    }
}

__device__ __forceinline__ void ph_gla_la(const Ctx& c, const float* GG, const float* w_g2, const float* b_g2, float* G) {
    for (long i = c.gt; i < (long)T * 128; i += c.GT) {
        const int n = (int)(i & 127); const long t = i >> 7;
        float z = b_g2[n];
#pragma unroll
        for (int r = 0; r < 16; ++r) z = fmaf(GG[t * 16 + r], w_g2[r * 128 + n], z);
        const float ls = fminf(z, 0.f) - log1pf(__expf(-fabsf(z)));
        G[i] = ls * (1.f / 16.f);
    }
}
__device__ __forceinline__ void ph_gla_cum(const Ctx& c, float* G) {
    if (c.gt < NB * 128) {
        const int b = (int)(c.gt >> 7), n = (int)(c.gt & 127); float acc = 0.f;
        for (int s = 0; s < S; ++s) { const size_t i = ((size_t)b * S + s) * 128 + n; acc += G[i]; G[i] = acc; }
    }
}
__device__ __forceinline__ void ph_gla_naive(const Ctx& c, const bf16_t* PROJ, const float* G, const float* gnw, bf16_t* MIX, float* ldsf) {
    const int lane = c.lane;
    for (int W = c.gw; W < (T / 64) * 4; W += c.NGW) {
        const int cgk = W >> 2, h = W & 3; const int t = cgk * 64 + lane; const int b = (cgk * 64) / S; const int nk = ((cgk * 64) % S) + 64; const int kb = b * S;
        float q[32], gi[32];
        const bf16_t* qp = PROJ + (size_t)t * NP + P_GQ + h * 32;
#pragma unroll
        for (int d = 0; d < 32; ++d) { q[d] = bf2f(qp[d]); gi[d] = G[(size_t)t * 128 + h * 32 + d]; }
        float ss = 0.f; float o[32];
        float* o0 = ldsf + c.wave * 2048 + lane;
#pragma unroll 1
        for (int vh = 0; vh < 2; ++vh) {
#pragma unroll
            for (int e = 0; e < 32; ++e) o[e] = 0.f;
            for (int j = 0; j < nk; ++j) {
                const bf16_t* kr = PROJ + (size_t)(kb + j) * NP + P_GK + h * 32; const bf16_t* vr = PROJ + (size_t)(kb + j) * NP + P_GV + h * 64 + vh * 32;
                const float* gj = G + (size_t)(kb + j) * 128 + h * 32;
                float s = 0.f;
#pragma unroll
                for (int d = 0; d < 32; ++d) s = fmaf(q[d] * bf2f(kr[d]), __expf(-fabsf(gi[d] - gj[d])), s);
#pragma unroll
                for (int e = 0; e < 32; ++e) o[e] = fmaf(s, bf2f(vr[e]), o[e]);
            }
#pragma unroll
            for (int e = 0; e < 32; ++e) ss += o[e] * o[e];
            if (vh == 0) {
#pragma unroll
                for (int e = 0; e < 32; ++e) o0[e * 64] = o[e];
            }
        }
        const float rstd = rsqrtf(ss * (1.f / 64.f) + EPS);
        const bf16_t* z = PROJ + (size_t)t * NP + P_GZ + h * 64; bf16_t* mo = MIX + (size_t)t * 1024 + 768 + h * 64;
#pragma unroll
        for (int e = 0; e < 32; ++e) mo[e] = (bf16_t)f2bf(o0[e * 64] * rstd * gnw[e] * bf2f(z[e]));
#pragma unroll
        for (int e = 0; e < 32; ++e) mo[32 + e] = (bf16_t)f2bf(o[e] * rstd * gnw[32 + e] * bf2f(z[32 + e]));
    }
}

namespace att {
typedef short s16x4 __attribute__((ext_vector_type(4)));
typedef float f32x16 __attribute__((ext_vector_type(16)));
constexpr int KROW = 208, SHM_K = 64 * KROW, SHM_V = 64 * 64 * 2;
constexpr int L_K = 0, L_V = 2 * SHM_K, L_WS = L_V + 2 * SHM_V, L_END = L_WS + 8 * 64 * 4;
constexpr float THR = 4.f;
#define ASBAR() __builtin_amdgcn_sched_barrier(0)
__device__ __forceinline__ int crow(int r, int hi) { return (r & 3) + 8 * (r >> 2) + 4 * hi; }
__device__ __forceinline__ unsigned cvtpk(float lo, float hi) { unsigned r; asm volatile("v_cvt_pk_bf16_f32 %0, %1, %2" : "=v"(r) : "v"(lo), "v"(hi)); return r; }

__device__ __forceinline__ void partialSM(f32x16& p0, f32x16& p1, float& m_reg, float& mn, float& alpha) {
  float pmax = p0[0];
#pragma unroll
  for (int r = 1; r < 16; ++r) pmax = fmaxf(pmax, p0[r]);
#pragma unroll
  for (int r = 0; r < 16; ++r) pmax = fmaxf(pmax, p1[r]);
  { auto rr = __builtin_amdgcn_permlane32_swap(__float_as_uint(pmax), __float_as_uint(pmax), false, false);
    pmax = fmaxf(__uint_as_float(rr[0]), __uint_as_float(rr[1])); }
  if (__builtin_expect(__all(pmax - m_reg <= THR), 1)) { mn = m_reg; alpha = 1.f; }
  else { mn = fmaxf(m_reg, pmax); alpha = __builtin_amdgcn_exp2f(m_reg - mn); m_reg = mn; }
#pragma unroll
  for (int r = 0; r < 16; ++r) p0[r] = p0[r] - mn;
#pragma unroll
  for (int r = 0; r < 16; ++r) p1[r] = p1[r] - mn;
#pragma unroll
  for (int r = 0; r < 16; ++r) p0[r] = __builtin_amdgcn_exp2f(p0[r]);
}
__device__ __forceinline__ void finishSM(f32x16& p0, f32x16& p1, float alpha, float& l_reg, bf16x8& pa0, bf16x8& pa1, bf16x8& pa2, bf16x8& pa3) {
#pragma unroll
  for (int r = 0; r < 16; ++r) p1[r] = __builtin_amdgcn_exp2f(p1[r]);
  float ps = 0;
#pragma unroll
  for (int r = 0; r < 16; ++r) ps += p0[r];
#pragma unroll
  for (int r = 0; r < 16; ++r) ps += p1[r];
  { auto rr = __builtin_amdgcn_permlane32_swap(__float_as_uint(ps), __float_as_uint(ps), false, false);
    ps = __uint_as_float(rr[0]) + __uint_as_float(rr[1]); }
  l_reg = l_reg * alpha + ps;
#define PK4(P, BASE, OUT) do { unsigned a0 = cvtpk(P[BASE + 0], P[BASE + 1]), a1 = cvtpk(P[BASE + 2], P[BASE + 3]);   \
    unsigned b0 = cvtpk(P[BASE + 4], P[BASE + 5]), b1 = cvtpk(P[BASE + 6], P[BASE + 7]);                              \
    auto r0 = __builtin_amdgcn_permlane32_swap(a0, b0, false, false); auto r1 = __builtin_amdgcn_permlane32_swap(a1, b1, false, false); \
    u32x4 w = {r0[0], r1[0], r0[1], r1[1]}; OUT = *reinterpret_cast<bf16x8*>(&w); } while (0)
  PK4(p0, 0, pa0); PK4(p0, 8, pa1); PK4(p1, 0, pa2); PK4(p1, 8, pa3);
#undef PK4
}
__device__ __forceinline__ void qkt(f32x16& p0, f32x16& p1, const char* Ks, const bf16x8* qr, int r32, int hi) {
  p0 = f32x16{}; p1 = f32x16{};
  const char* kb = Ks + r32 * KROW + hi * 16;
#pragma unroll
  for (int d0 = 0; d0 < 6; ++d0) {
    bf16x8 b0 = *reinterpret_cast<const bf16x8*>(kb + d0 * 32);
    bf16x8 b1 = *reinterpret_cast<const bf16x8*>(kb + 32 * KROW + d0 * 32);
    p0 = __builtin_amdgcn_mfma_f32_32x32x16_bf16(b0, qr[d0], p0, 0, 0, 0);
    p1 = __builtin_amdgcn_mfma_f32_32x32x16_bf16(b1, qr[d0], p1, 0, 0, 0); }
}
__device__ __forceinline__ int v_st(int k, int c) { const int kk = (k & ~0xC) | ((k & 4) << 1) | ((k & 8) >> 1); return ((kk >> 3) * 2 + (c >> 5)) * 512 + ((kk & 7) * 32 + (c & 31)) * 2; }
__device__ __forceinline__ int v_rd_base(int lane) { return ((lane & 3) << 3) | (((lane >> 2) & 3) << 6) | (((lane >> 4) & 1) << 5) | (((lane >> 5) & 1) << 8); }
constexpr int v_rd_off(int d0, int ks, int half) { return d0 * 512 + ks * 2048 + half * 1024; }
template <int OFF> __device__ __forceinline__ s16x4 tr_read(int vb) {
  s16x4 r; asm volatile("ds_read_b64_tr_b16 %0, %1 offset:%2" : "=&v"(r) : "v"(vb), "i"(OFF) : "memory"); return r;
}
template <int D0> __device__ __forceinline__ void pv_one(f32x16& od, int vb, bf16x8 pa0, bf16x8 pa1, bf16x8 pa2, bf16x8 pa3) {
  const s16x4 l0 = tr_read<v_rd_off(D0, 0, 0)>(vb), h0 = tr_read<v_rd_off(D0, 0, 1)>(vb), l1 = tr_read<v_rd_off(D0, 1, 0)>(vb), h1 = tr_read<v_rd_off(D0, 1, 1)>(vb);
  const s16x4 l2 = tr_read<v_rd_off(D0, 2, 0)>(vb), h2 = tr_read<v_rd_off(D0, 2, 1)>(vb), l3 = tr_read<v_rd_off(D0, 3, 0)>(vb), h3 = tr_read<v_rd_off(D0, 3, 1)>(vb);
  asm volatile("s_waitcnt lgkmcnt(0)" ::: "memory"); ASBAR();
#define PK(L, H) (bf16x8){L[0], L[1], L[2], L[3], H[0], H[1], H[2], H[3]}
  od = __builtin_amdgcn_mfma_f32_32x32x16_bf16(pa0, PK(l0, h0), od, 0, 0, 0);
  od = __builtin_amdgcn_mfma_f32_32x32x16_bf16(pa1, PK(l1, h1), od, 0, 0, 0);
  od = __builtin_amdgcn_mfma_f32_32x32x16_bf16(pa2, PK(l2, h2), od, 0, 0, 0);
  od = __builtin_amdgcn_mfma_f32_32x32x16_bf16(pa3, PK(l3, h3), od, 0, 0, 0);
#undef PK
}
__device__ __forceinline__ void pv_d0(f32x16* o, int vb, bf16x8 pa0, bf16x8 pa1, bf16x8 pa2, bf16x8 pa3) {
  pv_one<0>(o[0], vb, pa0, pa1, pa2, pa3); pv_one<1>(o[1], vb, pa0, pa1, pa2, pa3);
}

__device__ __forceinline__ void attn_unit(const bf16_t* __restrict__ Q, const bf16_t* __restrict__ KV, const bf16_t* __restrict__ PROJ, bf16_t* __restrict__ MIX,
                                          int h, int tq0, int kb0, int NT, char* lds) {
  int tid_ = threadIdx.x; asm volatile("" : "+v"(tid_));
  const int tid = tid_, wid = __builtin_amdgcn_readfirstlane(tid >> 6), lane = tid & 63, r32 = lane & 31, hi = lane >> 5;
  char* V_lds = lds + L_V; char* K_lds = lds + L_K;
  float* ws = (float*)(lds + L_WS) + wid * 64; float* li_l = ws; float* al_l = ws + 32;
  const int tmax = NT - 4 + (wid >> 1);
  float m_reg = -1e30f, l_reg = 0; f32x16 o[2] = {}; bf16x8 qr[6];
  const bf16_t* Qw = Q + (size_t)(tq0 + wid * 32 + r32) * 768 + h * 96 + hi * 8;
#pragma unroll
  for (int d0 = 0; d0 < 6; ++d0) qr[d0] = *reinterpret_cast<const bf16x8*>(Qw + d0 * 16);
  const int srow = tid >> 3, sch = tid & 7, prow = (tid & 255) >> 2, pch = tid & 3;
  const bf16_t* Kn = KV + (size_t)(kb0 + srow) * 1024 + h * 128 + sch * 8;
  const bf16_t* Kp = PROJ + (size_t)(kb0 + prow) * NP + P_KPE + pch * 8;
  const int kst = srow * KROW + sch * 16, pst = prow * KROW + 128 + pch * 16, vst = v_st(srow, sch * 8);
  const int vb0 = (int)(uintptr_t)V_lds + v_rd_base(lane);
  struct { bf16x8 kn, vv, kp; } sr_[2];
#define SLOAD(i, k0) do { sr_[i].kn = *reinterpret_cast<const bf16x8*>(Kn + (size_t)(k0) * 1024); sr_[i].vv = *reinterpret_cast<const bf16x8*>(Kn + (size_t)(k0) * 1024 + 64); \
    sr_[i].kp = *reinterpret_cast<const bf16x8*>(Kp + (size_t)(k0) * NP); } while (0)
#define SWRITE(b, i) do { *(bf16x8*)(K_lds + (b) * SHM_K + kst) = sr_[i].kn; *(bf16x8*)(K_lds + (b) * SHM_K + pst) = sr_[i].kp; *(bf16x8*)(V_lds + (b) * SHM_V + vst) = sr_[i].vv; } while (0)
#define SWAIT() asm volatile("s_waitcnt vmcnt(3)" ::: "memory")
#define RESC(a) do { if (__any((a) < 1.f)) { if (hi == 0) al_l[r32] = (a); asm volatile("s_waitcnt lgkmcnt(0)" ::: "memory"); \
    _Pragma("unroll") for (int d = 0; d < 2; ++d) _Pragma("unroll") for (int r = 0; r < 16; ++r) o[d][r] *= al_l[crow(r, hi)]; } } while (0)
#define MASKT(P0, P1, tt) do { if ((tt) > tmax) { _Pragma("unroll") for (int r = 0; r < 16; ++r) { P0[r] = -1e30f; P1[r] = -1e30f; } } } while (0)
  f32x16 pA0, pA1, pB0, pB1; float mnA, mnB, alA, alB; bf16x8 pa0, pa1, pa2, pa3;
  constexpr int SE = 0, SO = 1;
  SLOAD(SE, 0); asm volatile("s_waitcnt vmcnt(0)" ::: "memory"); SWRITE(0, SE); __syncthreads();
  qkt(pA0, pA1, K_lds, qr, r32, hi); partialSM(pA0, pA1, m_reg, mnA, alA);
  SLOAD(SO, 64); if (2 < NT) SLOAD(SE, 2 * 64);
  SWAIT(); SWRITE(1, SO); __syncthreads();
  for (int j = 1; j + 1 < NT; j += 2) {
    ASBAR(); qkt(pB0, pB1, K_lds + SHM_K, qr, r32, hi); MASKT(pB0, pB1, j);
    finishSM(pA0, pA1, alA, l_reg, pa0, pa1, pa2, pa3); ASBAR();
    SLOAD(SO, (j + 2) * 64); ASBAR();
    pv_d0(o, vb0, pa0, pa1, pa2, pa3); partialSM(pB0, pB1, m_reg, mnB, alB);
    __syncthreads(); SWAIT(); SWRITE(0, SE);
    RESC(alB); __syncthreads();
    ASBAR(); qkt(pA0, pA1, K_lds, qr, r32, hi); MASKT(pA0, pA1, j + 1);
    finishSM(pB0, pB1, alB, l_reg, pa0, pa1, pa2, pa3); ASBAR();
    if (j + 3 < NT) SLOAD(SE, (j + 3) * 64); ASBAR();
    pv_d0(o, vb0 + SHM_V, pa0, pa1, pa2, pa3); partialSM(pA0, pA1, m_reg, mnA, alA);
    __syncthreads(); SWAIT(); SWRITE(1, SO);
    RESC(alA); __syncthreads();
  }
  ASBAR(); qkt(pB0, pB1, K_lds + SHM_K, qr, r32, hi); MASKT(pB0, pB1, NT - 1);
  finishSM(pA0, pA1, alA, l_reg, pa0, pa1, pa2, pa3); ASBAR();
  pv_d0(o, vb0, pa0, pa1, pa2, pa3); partialSM(pB0, pB1, m_reg, mnB, alB);
  __syncthreads(); RESC(alB);
  finishSM(pB0, pB1, alB, l_reg, pa0, pa1, pa2, pa3); ASBAR();
  pv_d0(o, vb0 + SHM_V, pa0, pa1, pa2, pa3);
  if (hi == 0) li_l[r32] = l_reg; asm volatile("s_waitcnt lgkmcnt(0)" ::: "memory");
  float rli[16];
#pragma unroll
  for (int r = 0; r < 16; ++r) rli[r] = __builtin_amdgcn_rcpf(li_l[crow(r, hi)]);
#pragma unroll
  for (int r = 0; r < 16; ++r) { const size_t t = (size_t)(tq0 + wid * 32 + crow(r, hi));
#pragma unroll
    for (int d0 = 0; d0 < 2; ++d0) { const int col = h * 64 + d0 * 32 + r32;
      MIX[t * 1024 + 256 + col] = (bf16_t)f2bf(o[d0][r] * rli[r] * bf2f(PROJ[t * NP + P_MZ + col])); } }
#undef SLOAD
#undef SWRITE
#undef SWAIT
#undef RESC
#undef MASKT
}
__device__ __forceinline__ void attn_phase(const bf16_t* Q, const bf16_t* KV, const bf16_t* PROJ, bf16_t* MIX, char* lds) {
  const int G = gridDim.x, bx = blockIdx.x; const int v = (G % 8 == 0) ? (bx % 8) * (G / 8) + bx / 8 : bx;
  for (int bh = v; bh < NB * 8; bh += G) {
    const int b = bh >> 3, h = bh & 7;
    for (int qb = 0; qb < S / 256; ++qb) attn_unit(Q, KV, PROJ, MIX, h, b * S + qb * 256, b * S, 4 * (qb + 1), lds);
  }
}
#undef ASBAR
}

constexpr int NTHREADS = 512;
constexpr int LDS_BYTES = 147456;
__global__ void __launch_bounds__(NTHREADS, 2) mk_fwd(Params p) {
    extern __shared__ __attribute__((aligned(16))) unsigned char lds[];
    cg::grid_group grid = cg::this_grid();
    Ctx c; c.tid = threadIdx.x; c.lane = c.tid & 63; c.wave = __builtin_amdgcn_readfirstlane(c.tid >> 6);
    c.gw = blockIdx.x * (NTHREADS / 64) + c.wave; c.NGW = gridDim.x * (NTHREADS / 64);
    c.gt = (long)blockIdx.x * NTHREADS + c.tid; c.GT = (long)gridDim.x * NTHREADS;
    unsigned char* ws = p.ws;
    float* ADA = (float*)(ws + WS_ADA); const float2* CS32 = (const float2*)(ws + WS_CS32); const float2* CS16 = (const float2*)(ws + WS_CS16);
    bf16_t* WinT = (bf16_t*)(ws + WS_WIN); bf16_t* WuqT = (bf16_t*)(ws + WS_WUQ); bf16_t* WukvT = (bf16_t*)(ws + WS_WUKV); bf16_t* WoutT = (bf16_t*)(ws + WS_WOUT);
    float* RSQ = (float*)(ws + WS_RSQ); float* RSKV = (float*)(ws + WS_RSKV); float* GG = (float*)(ws + WS_GG);
    bf16_t* H = (bf16_t*)(ws + WS_H); bf16_t* PROJ = (bf16_t*)(ws + WS_PROJ); bf16_t* Q = (bf16_t*)(ws + WS_Q); bf16_t* KV = (bf16_t*)(ws + WS_KV); bf16_t* MIX = (bf16_t*)(ws + WS_MIX);
    float* GC = (float*)(ws + WS_GCUM);
    PG8_LAS unsigned char* ldsp = (PG8_LAS unsigned char*)lds;

    ph_prep(p, fresh(c));
    grid.sync();
#pragma unroll 1
    for (int l = 0; l < DEPTH; ++l) {
        const float* xin = (l == 0) ? p.x : p.out;
        const float* ADA_l = ADA + (size_t)l * NB * 3072;
        ph_norm(fresh(c), xin, p.norm_w + l * D, ADA_l, H);
        grid.sync();
        run_gemm(ldsp, H, D, WinT + (size_t)l * NP * 1024, T, NP, 1024, EpiIn{PROJ, GG, CS32, CS16});
        grid.sync();
        ph_rstd(fresh(c), PROJ, RSQ, RSKV);
        ph_gla_la(fresh(c), GG, p.w_g2 + (size_t)l * 16 * 128, p.b_g2 + l * 128, GC);
        grid.sync();
        run_gemm(ldsp, PROJ + P_MQ, NP, WuqT + (size_t)l * 768 * 256, T, 768, 256, EpiQ{Q, RSQ, CS16});
        run_gemm(ldsp, PROJ + P_MKV, NP, WukvT + (size_t)l * 1024 * 128, T, 1024, 128, EpiKV{KV, RSKV});
        ph_gla_cum(fresh(c), GC);
        grid.sync();
        att::attn_phase(Q, KV, PROJ, MIX, (char*)lds);
        ph_ret_naive(fresh(c), PROJ, MIX);
        ph_gla_naive(fresh(c), PROJ, GC, p.gnw + l * 64, MIX, (float*)lds);
        grid.sync();
        run_gemm(ldsp, MIX, 1024, WoutT + (size_t)l * 1024 * 1024, T, 1024, 1024, EpiOut{xin, p.out, ADA_l});
        grid.sync();
    }
    ph_final(fresh(c), p.out, p.fnw, p.out);
}

extern "C" void kernel_launch(void* const* d_in, const int* in_sizes, int n_in, void* d_out, int out_size, void* d_ws, size_t ws_size, hipStream_t stream) {
    static int grid_blocks = 0;
    if (grid_blocks == 0) {
        if (n_in != 16 || in_sizes[0] != T * D || out_size != T * D || ws_size < WS_END) {
            fprintf(stderr, "kernel_launch: shape/ws mismatch n_in %d in0 %d out %d ws %zu (need %zu)\n", n_in, n_in > 0 ? in_sizes[0] : -1, out_size, ws_size, (size_t)WS_END);
            grid_blocks = -1; return;
        }
        int dev = 0, cus = 0, per_cu = 0;
        hipGetDevice(&dev); hipDeviceGetAttribute(&cus, hipDeviceAttributeMultiprocessorCount, dev);
        if (hipFuncSetAttribute((const void*)mk_fwd, hipFuncAttributeMaxDynamicSharedMemorySize, LDS_BYTES) != hipSuccess) { fprintf(stderr, "kernel_launch: hipFuncSetAttribute failed\n"); grid_blocks = -1; return; }
        if (hipOccupancyMaxActiveBlocksPerMultiprocessor(&per_cu, (const void*)mk_fwd, NTHREADS, LDS_BYTES) != hipSuccess || per_cu < 1) { fprintf(stderr, "kernel_launch: occupancy query says %d blocks/CU\n", per_cu); grid_blocks = -1; return; }
        grid_blocks = cus;
        fprintf(stderr, "kernel_launch: cus %d per_cu %d grid %d\n", cus, per_cu, grid_blocks);
    }
    if (grid_blocks < 0) return;
    Params p{};
    p.x = (const float*)d_in[0]; p.c = (const float*)d_in[1]; p.pos = (const int*)d_in[2]; p.norm_w = (const float*)d_in[3]; p.ada_w = (const float*)d_in[4];
    p.ada_b = (const float*)d_in[5]; p.w_in = (const float*)d_in[6]; p.qnw = (const float*)d_in[7]; p.w_uq = (const float*)d_in[8]; p.kvnw = (const float*)d_in[9];
    p.w_ukv = (const float*)d_in[10]; p.w_g2 = (const float*)d_in[11]; p.b_g2 = (const float*)d_in[12]; p.gnw = (const float*)d_in[13]; p.w_out = (const float*)d_in[14];
    p.fnw = (const float*)d_in[15]; p.out = (float*)d_out; p.ws = (unsigned char*)d_ws;
    void* args[] = {&p};
    hipError_t e = hipLaunchCooperativeKernel((void*)mk_fwd, dim3(grid_blocks), dim3(NTHREADS), args, LDS_BYTES, stream);
    if (e != hipSuccess) fprintf(stderr, "cooperative launch failed: %s (grid %d)\n", hipGetErrorString(e), grid_blocks);
}
```

```cpp
#include <hip/hip_runtime.h>
#include <hip/hip_cooperative_groups.h>
namespace cg = cooperative_groups;
#include <cstdio>
#include <cstdint>
#include <cmath>

typedef unsigned short bf16_t;
typedef short bf16x8 __attribute__((ext_vector_type(8)));
typedef float f32x4 __attribute__((ext_vector_type(4)));
typedef unsigned u32x4 __attribute__((ext_vector_type(4)));
typedef unsigned u32x2 __attribute__((ext_vector_type(2)));

constexpr int D = 1024, NB = 32, S = 2048, T = NB * S, DEPTH = 2, CH = 64;
constexpr int NIN = 2736, NP = 2816;
constexpr float EPS = 1e-6f;
constexpr int P_RQ = 0, P_RK = 256, P_RV = 512, P_RZ = 768, P_MQ = 1024, P_MKV = 1280, P_KPE = 1408, P_GG = 1440, P_PAD = 1456,
              P_MZ = 1536, P_GQ = 2048, P_GK = 2176, P_GV = 2304, P_GZ = 2560;
constexpr float QSCALE = 0.10206207261596577f * 1.4426950408889634f;

constexpr size_t MiB = 1u << 20;
constexpr size_t WS_CTL = 0;
constexpr size_t WS_ADA = 1 * MiB;
constexpr size_t WS_CS32 = 2 * MiB;
constexpr size_t WS_CS16 = 18 * MiB;
constexpr size_t WS_WIN = 26 * MiB;
constexpr size_t WS_WUQ = 38 * MiB;
constexpr size_t WS_WUKV = 39 * MiB;
constexpr size_t WS_WOUT = 40 * MiB;
constexpr size_t WS_RSQ = 44 * MiB;
constexpr size_t WS_RSKV = 45 * MiB;
constexpr size_t WS_GG = 46 * MiB;
constexpr size_t WS_H = 50 * MiB;
constexpr size_t WS_PROJ = 178 * MiB;
constexpr size_t WS_Q = 530 * MiB;
constexpr size_t WS_KV = 626 * MiB;
constexpr size_t WS_MIX = 754 * MiB;
constexpr size_t WS_GCUM = 882 * MiB;
constexpr size_t WS_END = 914 * MiB;

__device__ __forceinline__ unsigned f2bf(float f) { unsigned u = __builtin_bit_cast(unsigned, f); return (u + 0x7fffu + ((u >> 16) & 1u)) >> 16; }
__device__ __forceinline__ unsigned pk2(float lo, float hi) { return f2bf(lo) | (f2bf(hi) << 16); }
__device__ __forceinline__ float bf2f(bf16_t v) { return __builtin_bit_cast(float, (unsigned)v << 16); }
__device__ __forceinline__ float silu_f(float x) { return x / (1.f + __expf(-x)); }

__host__ __device__ inline int in_logical(int p) {
    if (p < 512) { int c = p & 63; return (p & ~63) + (c >> 1) + 32 * (c & 1); }
    if (p < 1408) return p;
    if (p < 1440) { int c = p - 1408; return 1408 + (c >> 1) + 16 * (c & 1); }
    if (p < 1456) return 2464 + (p - 1440);
    if (p < 1536) return -1;
    if (p < 2048) return 1440 + (p - 1536);
    if (p < 2304) return 1952 + (p - 2048);
    if (p < 2560) return 2208 + (p - 2304);
    return 2480 + (p - 2560);
}
__host__ __device__ inline int uq_logical(int p) {
    int h = p / 96, c = p % 96;
    if (c < 64) return p;
    int cc = c - 64; return h * 96 + 64 + (cc >> 1) + 16 * (cc & 1);
}

struct Params {
    const float* x; const float* c; const int* pos; const float* norm_w; const float* ada_w; const float* ada_b; const float* w_in; const float* qnw;
    const float* w_uq; const float* kvnw; const float* w_ukv; const float* w_g2; const float* b_g2; const float* gnw; const float* w_out; const float* fnw;
    float* out; unsigned char* ws;
};
struct Ctx { int tid, lane, wave, gw, NGW; long gt, GT; };
__device__ __forceinline__ Ctx fresh(const Ctx& c) { Ctx r = c; asm volatile("" : "+v"(r.lane), "+v"(r.tid)); asm volatile("" : "+s"(r.gw)); r.gt = (long)blockIdx.x * 512 + r.tid; return r; }

__device__ __forceinline__ float wave_sum(float v) {
#pragma unroll
    for (int o = 1; o < 64; o <<= 1) v += __shfl_xor(v, o);
    return v;
}

__device__ __forceinline__ void ph_prep(const Params& p, const Ctx& c) {
    unsigned char* ws = p.ws;
    bf16_t* WinT = (bf16_t*)(ws + WS_WIN); bf16_t* WuqT = (bf16_t*)(ws + WS_WUQ); bf16_t* WukvT = (bf16_t*)(ws + WS_WUKV); bf16_t* WoutT = (bf16_t*)(ws + WS_WOUT);
    float2* CS32 = (float2*)(ws + WS_CS32); float2* CS16 = (float2*)(ws + WS_CS16); float* ADA = (float*)(ws + WS_ADA);
    const long gsz = c.GT, g0 = c.gt;
    for (long i = g0; i < (long)DEPTH * NP * 1024; i += gsz) {
        int k = (int)(i & 1023); long r = i >> 10; int pp = (int)(r % NP), l = (int)(r / NP);
        int lc = in_logical(pp);
        float v = lc >= 0 ? p.w_in[((size_t)l * 1024 + k) * NIN + lc] : 0.f;
        WinT[i] = (bf16_t)f2bf(v);
    }
    for (long i = g0; i < (long)DEPTH * 768 * 256; i += gsz) {
        int k = (int)(i & 255); long r = i >> 8; int pp = (int)(r % 768), l = (int)(r / 768);
        WuqT[i] = (bf16_t)f2bf(p.qnw[l * 256 + k] * p.w_uq[((size_t)l * 256 + k) * 768 + uq_logical(pp)]);
    }
    for (long i = g0; i < (long)DEPTH * 1024 * 128; i += gsz) {
        int k = (int)(i & 127); long r = i >> 7; int n = (int)(r % 1024), l = (int)(r / 1024);
        WukvT[i] = (bf16_t)f2bf(p.kvnw[l * 128 + k] * p.w_ukv[((size_t)l * 128 + k) * 1024 + n]);
    }
    for (long i = g0; i < (long)DEPTH * 1024 * 1024; i += gsz) {
        int k = (int)(i & 1023); long r = i >> 10; int n = (int)(r % 1024), l = (int)(r / 1024);
        WoutT[i] = (bf16_t)f2bf(p.w_out[((size_t)l * 1024 + k) * 1024 + n]);
    }
    for (long i = g0; i < (long)T * 32; i += gsz) {
        int j = (int)(i & 31); int t = (int)(i >> 5);
        double inv = pow(10000.0, -(double)j / 32.0), a = (double)p.pos[t] * inv; double s, cc; sincos(a, &s, &cc);
        CS32[i] = make_float2((float)cc, (float)s);
    }
    for (long i = g0; i < (long)T * 16; i += gsz) {
        int j = (int)(i & 15); int t = (int)(i >> 4);
        double inv = pow(10000.0, -(double)j / 16.0), a = (double)p.pos[t] * inv; double s, cc; sincos(a, &s, &cc);
        CS16[i] = make_float2((float)cc, (float)s);
    }
    for (long i = g0; i < (long)DEPTH * NB * 3072; i += gsz) {
        int n = (int)(i % 3072), b = (int)((i / 3072) % NB), l = (int)(i / (3072 * NB));
        float acc = 0.f;
        for (int k = 0; k < 1024; ++k) acc = fmaf(silu_f(p.c[b * 1024 + k]), p.ada_w[((size_t)l * 1024 + k) * 3072 + n], acc);
        ADA[i] = acc + p.ada_b[l * 3072 + n];
    }
}

__device__ __forceinline__ void ph_norm(const Ctx& c, const float* x, const float* nw, const float* ADA_l, bf16_t* H) {
    const int lane = c.lane;
    for (int row = c.gw; row < T; row += c.NGW) {
        const int b = row / S;
        const f32x4* xr = (const f32x4*)(x + (size_t)row * D) + lane;
        f32x4 v[4]; float s = 0.f;
#pragma unroll
        for (int j = 0; j < 4; ++j) { v[j] = xr[64 * j]; s += v[j].x * v[j].x + v[j].y * v[j].y + v[j].z * v[j].z + v[j].w * v[j].w; }
        const float rstd = rsqrtf(wave_sum(s) * (1.f / D) + EPS);
        const float* shift = ADA_l + (size_t)b * 3072; const float* scale = shift + 1024;
        u32x2* o = (u32x2*)(H + (size_t)row * D) + lane;
#pragma unroll
        for (int j = 0; j < 4; ++j) {
            const int c0 = 4 * lane + 256 * j; const f32x4 w = *(const f32x4*)(nw + c0), sc = *(const f32x4*)(scale + c0), sh = *(const f32x4*)(shift + c0);
            f32x4 y;
            y.x = v[j].x * rstd * w.x * (1.f + sc.x) + sh.x; y.y = v[j].y * rstd * w.y * (1.f + sc.y) + sh.y;
            y.z = v[j].z * rstd * w.z * (1.f + sc.z) + sh.z; y.w = v[j].w * rstd * w.w * (1.f + sc.w) + sh.w;
            u32x2 pk; pk.x = pk2(y.x, y.y); pk.y = pk2(y.z, y.w); o[64 * j] = pk;
        }
    }
}

__device__ __forceinline__ void ph_final(const Ctx& c, const float* x, const float* w, float* out) {
    const int lane = c.lane;
    for (int row = c.gw; row < T; row += c.NGW) {
        const f32x4* xr = (const f32x4*)(x + (size_t)row * D) + lane;
        f32x4 v[4]; float s = 0.f;
#pragma unroll
        for (int j = 0; j < 4; ++j) { v[j] = xr[64 * j]; s += v[j].x * v[j].x + v[j].y * v[j].y + v[j].z * v[j].z + v[j].w * v[j].w; }
        const float rstd = rsqrtf(wave_sum(s) * (1.f / D) + EPS);
        f32x4* o = (f32x4*)(out + (size_t)row * D) + lane;
#pragma unroll
        for (int j = 0; j < 4; ++j) { const f32x4 ww = *(const f32x4*)(w + 4 * lane + 256 * j); o[64 * j] = v[j] * rstd * ww; }
    }
}

__device__ __forceinline__ f32x4 rope4(f32x4 v, float2 a, float2 b) { f32x4 o; o.x = v.x * a.x - v.y * a.y; o.y = v.y * a.x + v.x * a.y; o.z = v.z * b.x - v.w * b.y; o.w = v.w * b.x + v.z * b.y; return o; }
__device__ __forceinline__ f32x4 silu4(f32x4 v) { v.x = silu_f(v.x); v.y = silu_f(v.y); v.z = silu_f(v.z); v.w = silu_f(v.w); return v; }
struct EpiIn {
    bf16_t* PROJ; float* GG; const float2* CS32; const float2* CS16;
    __device__ __forceinline__ void operator()(int row, int col, f32x4 v) const {
        if (col < 512) {
            const int j = (col & 63) >> 1; v = rope4(v, CS32[(size_t)row * 32 + j], CS32[(size_t)row * 32 + j + 1]);
            if (col >= 256) v = v * 0.125f;
        } else if (col < 768) {
        } else if (col < 1024) { v = silu4(v);
        } else if (col < 1408) {
        } else if (col < 1440) {
            const int j = (col - 1408) >> 1; v = rope4(v, CS16[(size_t)row * 16 + j], CS16[(size_t)row * 16 + j + 1]);
        } else if (col < 1456) { *(f32x4*)(GG + (size_t)row * 16 + (col - 1440)) = v; return;
        } else if (col < 1536) { return;
        } else if (col < 2048) { v = silu4(v);
        } else if (col < 2176) {
        } else if (col < 2304) { v = v * 0.17677669529663687f;
        } else if (col < 2560) {
        } else { v = silu4(v); }
        u32x2 pk; pk.x = pk2(v.x, v.y); pk.y = pk2(v.z, v.w); *(u32x2*)(PROJ + (size_t)row * NP + col) = pk;
    }
};
struct EpiQ {
    bf16_t* Q; const float* RSQ; const float2* CS16;
    __device__ __forceinline__ void operator()(int row, int col, f32x4 v) const {
        v = v * RSQ[row]; const int cc = col % 96;
        if (cc >= 64) { const int j = (cc - 64) >> 1; v = rope4(v, CS16[(size_t)row * 16 + j], CS16[(size_t)row * 16 + j + 1]); }
        v = v * QSCALE;
        u32x2 pk; pk.x = pk2(v.x, v.y); pk.y = pk2(v.z, v.w); *(u32x2*)(Q + (size_t)row * 768 + col) = pk;
    }
};
struct EpiKV {
    bf16_t* KV; const float* RSKV;
    __device__ __forceinline__ void operator()(int row, int col, f32x4 v) const {
        v = v * RSKV[row];
        u32x2 pk; pk.x = pk2(v.x, v.y); pk.y = pk2(v.z, v.w); *(u32x2*)(KV + (size_t)row * 1024 + col) = pk;
    }
};
struct EpiOut {
    const float* xi; float* xo; const float* ADA_l;
    __device__ __forceinline__ void operator()(int row, int col, f32x4 v) const {
        const int b = row / S; const f32x4 g = *(const f32x4*)(ADA_l + (size_t)b * 3072 + 2048 + col);
        const f32x4 xv = *(const f32x4*)(xi + (size_t)row * D + col);
        *(f32x4*)(xo + (size_t)row * D + col) = xv + g * v;
    }
};

namespace pg8 {
#define PG8_LAS __attribute__((address_space(3)))
constexpr int BM = 256, BK = 64, HALF = 128, HTB = HALF * BK * 2  , STAGE_BYTES = 8 * HTB, NXCD = 8, WGM = 8;

__host__ __device__ __forceinline__ int lds_byte(int r, int c) { const int st = (r >> 4) * 2 + (c >> 5), rr = r & 15, cc = c & 31, ob = rr * 64 + cc * 2; return st * 1024 + (ob ^ (((ob >> 9) & 1) << 5)); }
__host__ __device__ __forceinline__ void stage_rc(int b, int& R, int& C) { const int st = b / 1024, sb = b % 1024, swz = sb ^ (((sb >> 9) & 1) << 5); R = (st >> 1) * 16 + swz / 64; C = (st & 1) * 32 + (swz % 64) / 2; }
__host__ __device__ __forceinline__ int perm32(int rho) { const int n = rho >> 4, i = rho & 15; return 8 * (i >> 2) + 4 * n + (i & 3); }

struct Unit { int pm, pn; };
struct Gemm { const bf16_t* A; const bf16_t* Bt; int M, N, K, lda; };

struct StaticOrder {
    int nM, nN, nwg, G, c;
    __host__ __device__ void init(int M, int N, int G_, int c_) { nM = M / BM; nN = N / BM; nwg = nM * nN; G = G_; c = c_; }
    __host__ __device__ bool next(int i, Unit& u) const {
        const long L = (long)i * G + c; if (L >= nwg) return false;
        int wgid = (int)L; { const int q = nwg / NXCD, r = nwg % NXCD, xcd = wgid % NXCD, off = wgid / NXCD; wgid = (xcd < r ? xcd * (q + 1) : r * (q + 1) + (xcd - r) * q) + off; }
        const int nig = WGM * nN, gid = wgid / nig, fm = gid * WGM, gsz = (nM - fm) < WGM ? (nM - fm) : WGM;
        u.pm = fm + ((wgid % nig) % gsz); u.pn = (wgid % nig) / gsz; return true;
    }
    __device__ __forceinline__ void a_ready(const Unit&) const {}
    __device__ __forceinline__ void done(const Unit&) const {}
};

template <class Epi, class Sched, bool ALIGN_EPI = false, bool SP2 = false>
__device__ __forceinline__ void gemm_phase(PG8_LAS unsigned char* lds, const Gemm g, const Sched& S, const Epi& E) {
    int tid_ = threadIdx.x; asm volatile("" : "+v"(tid_));
    const int tid = tid_, wid = __builtin_amdgcn_readfirstlane(tid >> 6), lane = tid & 63, wr = wid >> 2, wc = wid & 3, fr = lane & 15, fq = lane >> 4;
    const int K = g.K, nt = K / BK;
    unsigned voffA[2], voffB[2];
#pragma unroll
    for (int i = 0; i < 2; ++i) { int R, C; stage_rc(tid * 16 + i * 8192, R, C); const int Rb = Epi::PERM ? ((R & ~31) + perm32(R & 31)) : R;
        voffA[i] = (unsigned)(R * g.lda + C) * 2u; voffB[i] = (unsigned)(Rb * K + C) * 2u; }
    const size_t kstep = (size_t)(BK * 2);
    const size_t hstep = (size_t)HALF * K * 2;
    const size_t tstep = 2 * hstep; const size_t hstepA = (size_t)HALF * g.lda * 2, tstepA = 2 * hstepA;
    const unsigned ldsw = (unsigned)wid * 1024u;
    const int aoff = lds_byte(wr * 64 + fr, fq * 8), boff = lds_byte(wc * 32 + fr, fq * 8);
#define PG8_SA(b, h) (((b) * 2 + (h)) * HTB)
#define PG8_SB(b, h) ((4 + (b) * 2 + (h)) * HTB)
#define PG8_STAGE(bufoff, gbase, voff) do { _Pragma("unroll") for (int _i = 0; _i < 2; ++_i) \
        __builtin_amdgcn_global_load_lds((const unsigned*)((const char*)(gbase) + (voff)[_i]), (PG8_LAS unsigned*)(lds + (bufoff) + ldsw + _i * 8192), 16, 0, 0); } while (0)
#define PG8_LDA(dst, b, h) do { _Pragma("unroll") for (int m = 0; m < 4; ++m) _Pragma("unroll") for (int k = 0; k < 2; ++k) dst[m][k] = *(const PG8_LAS bf16x8*)(lds + PG8_SA(b, h) + aoff + m * 2048 + k * 1024); } while (0)
#define PG8_LDB(dst, b, h) do { _Pragma("unroll") for (int n = 0; n < 2; ++n) _Pragma("unroll") for (int k = 0; k < 2; ++k) dst[n][k] = *(const PG8_LAS bf16x8*)(lds + PG8_SB(b, h) + boff + n * 2048 + k * 1024); } while (0)
#define PG8_MMA(ai, bj, At, Bt) do { __builtin_amdgcn_s_setprio(1); _Pragma("unroll") for (int m = 0; m < 4; ++m) _Pragma("unroll") for (int n = 0; n < 2; ++n) _Pragma("unroll") for (int k = 0; k < 2; ++k) \
        acc[ai][bj][m][n] = __builtin_amdgcn_mfma_f32_16x16x32_bf16(Bt[n][k], At[m][k], acc[ai][bj][m][n], 0, 0, 0); __builtin_amdgcn_s_setprio(0); } while (0)
#define PG8_WAIT_V(n) asm volatile("s_waitcnt vmcnt(" #n ")" ::: "memory")
#define PG8_WAIT_L(n) asm volatile("s_waitcnt lgkmcnt(" #n ")" ::: "memory")
#define PG8_BAR __builtin_amdgcn_s_barrier()
#define PG8_SCHED __builtin_amdgcn_sched_barrier(0)
    Unit cur, nxt; int ui = 0;
    if (!S.next(0, cur)) return;
    f32x4 acc[2][2][4][2];
#pragma unroll
    for (int a = 0; a < 2; ++a)
#pragma unroll
        for (int b = 0; b < 2; ++b)
#pragma unroll
            for (int m = 0; m < 4; ++m)
#pragma unroll
                for (int n = 0; n < 2; ++n) acc[a][b][m][n] = (f32x4){0.f, 0.f, 0.f, 0.f};
    bf16x8 At[4][2], B0[2][2], B1[2][2];
    const char* cA = (const char*)g.A + (size_t)cur.pm * tstepA; const char* cB = (const char*)g.Bt + (size_t)cur.pn * tstep;
    S.a_ready(cur);
    if constexpr (SP2) {
        PG8_STAGE(PG8_SB(0, 0), cB, voffB); PG8_STAGE(PG8_SB(0, 1), cB + hstep, voffB); PG8_STAGE(PG8_SA(0, 0), cA, voffA); PG8_STAGE(PG8_SA(0, 1), cA + hstepA, voffA);
        if (wr == 1) PG8_BAR;
        PG8_WAIT_V(2); PG8_BAR;
        PG8_STAGE(PG8_SB(1, 0), cB + kstep, voffB); PG8_STAGE(PG8_SA(1, 0), cA + kstep, voffA); PG8_STAGE(PG8_SB(1, 1), cB + hstep + kstep, voffB);
        PG8_WAIT_V(6); PG8_BAR;
    } else {
        PG8_STAGE(PG8_SB(0, 0), cB, voffB); PG8_STAGE(PG8_SA(0, 0), cA, voffA); PG8_STAGE(PG8_SB(0, 1), cB + hstep, voffB); PG8_STAGE(PG8_SA(0, 1), cA + hstepA, voffA);
        if (wr == 1) PG8_BAR;
        PG8_WAIT_V(4); PG8_BAR;
        PG8_STAGE(PG8_SB(1, 0), cB + kstep, voffB); PG8_STAGE(PG8_SA(1, 0), cA + kstep, voffA); PG8_STAGE(PG8_SB(1, 1), cB + hstep + kstep, voffB);
        PG8_WAIT_V(6); PG8_BAR;
    }
    for (;;) {
        const bool has_next = S.next(ui + 1, nxt);
        const char* nA = has_next ? (const char*)g.A + (size_t)nxt.pm * tstepA : cA; const char* nB = has_next ? (const char*)g.Bt + (size_t)nxt.pn * tstep : cB;
        for (int t = 0; t < nt; t += 2) {
            const bool last = (t == nt - 2);
            const char* a1 = cA + (size_t)(t + 1) * kstep;
            const char* a2 = last ? nA : cA + (size_t)(t + 2) * kstep; const char* b2 = last ? nB : cB + (size_t)(t + 2) * kstep;
            const char* a3 = a2 + kstep; const char* b3 = b2 + kstep;
            if (last && has_next) S.a_ready(nxt);
            if constexpr (SP2) {
            PG8_LDB(B0, 0, 0); PG8_LDB(B1, 0, 1); PG8_SCHED; PG8_LDA(At, 0, 0); PG8_STAGE(PG8_SA(1, 1), a1 + hstepA, voffA);
            PG8_WAIT_V(8); PG8_WAIT_L(0); PG8_BAR; PG8_MMA(0, 0, At, B0); PG8_MMA(0, 1, At, B1); PG8_BAR; PG8_SCHED;
            PG8_LDA(At, 0, 1); PG8_STAGE(PG8_SB(0, 0), b2, voffB); PG8_STAGE(PG8_SB(0, 1), b2 + hstep, voffB); PG8_STAGE(PG8_SA(0, 0), a2, voffA);
            PG8_WAIT_V(8); PG8_WAIT_L(0); PG8_BAR; PG8_MMA(1, 0, At, B0); PG8_MMA(1, 1, At, B1); PG8_BAR; PG8_SCHED;
            PG8_LDB(B0, 1, 0); PG8_LDB(B1, 1, 1); PG8_SCHED; PG8_LDA(At, 1, 0); PG8_STAGE(PG8_SA(0, 1), a2 + hstepA, voffA);
            PG8_WAIT_V(8); PG8_WAIT_L(0); PG8_BAR; PG8_MMA(0, 0, At, B0); PG8_MMA(0, 1, At, B1); PG8_BAR; PG8_SCHED;
            PG8_LDA(At, 1, 1); PG8_STAGE(PG8_SB(1, 0), b3, voffB); PG8_STAGE(PG8_SB(1, 1), b3 + hstep, voffB); PG8_STAGE(PG8_SA(1, 0), a3, voffA);
            PG8_WAIT_V(8); PG8_WAIT_L(0); PG8_BAR; PG8_MMA(1, 0, At, B0); PG8_MMA(1, 1, At, B1); PG8_BAR; PG8_SCHED;
            } else {
            PG8_LDB(B0, 0, 0); PG8_SCHED; PG8_LDA(At, 0, 0); PG8_STAGE(PG8_SA(1, 1), a1 + hstepA, voffA);
            PG8_WAIT_L(8); PG8_BAR; PG8_WAIT_L(0); PG8_MMA(0, 0, At, B0); PG8_BAR; PG8_SCHED;
            PG8_LDB(B1, 0, 1); PG8_STAGE(PG8_SB(0, 0), b2, voffB);
            PG8_BAR; PG8_WAIT_L(0); PG8_MMA(0, 1, At, B1); PG8_BAR;
            PG8_LDA(At, 0, 1); PG8_STAGE(PG8_SA(0, 0), a2, voffA);
            PG8_BAR; PG8_WAIT_L(0); PG8_MMA(1, 0, At, B0); PG8_BAR; PG8_SCHED;
            PG8_STAGE(PG8_SB(0, 1), b2 + hstep, voffB);
            PG8_WAIT_V(6); PG8_BAR; PG8_MMA(1, 1, At, B1); PG8_BAR;
            PG8_LDB(B0, 1, 0); PG8_SCHED; PG8_LDA(At, 1, 0); PG8_STAGE(PG8_SA(0, 1), a2 + hstepA, voffA);
            PG8_WAIT_L(8); PG8_BAR; PG8_WAIT_L(0); PG8_MMA(0, 0, At, B0); PG8_BAR; PG8_SCHED;
            PG8_LDB(B1, 1, 1); PG8_STAGE(PG8_SB(1, 0), b3, voffB);
            PG8_BAR; PG8_WAIT_L(0); PG8_MMA(0, 1, At, B1); PG8_BAR;
            PG8_LDA(At, 1, 1); PG8_STAGE(PG8_SA(1, 0), a3, voffA);
            PG8_BAR; PG8_WAIT_L(0); PG8_MMA(1, 0, At, B0); PG8_BAR; PG8_SCHED;
            PG8_STAGE(PG8_SB(1, 1), b3 + hstep, voffB);
            PG8_WAIT_V(6); PG8_BAR; PG8_MMA(1, 1, At, B1); PG8_BAR;
            }
        }
        if constexpr (ALIGN_EPI) { if (wr == 0) PG8_BAR; }
        if constexpr (!Epi::AFTER_DRAIN) { E(acc, cur, wr, wc, fr, fq); S.done(cur); }
        if (!has_next) break;
#pragma unroll
        for (int a = 0; a < 2; ++a)
#pragma unroll
            for (int b = 0; b < 2; ++b)
#pragma unroll
                for (int m = 0; m < 4; ++m)
#pragma unroll
                    for (int n = 0; n < 2; ++n) acc[a][b][m][n] = (f32x4){0.f, 0.f, 0.f, 0.f};
        cur = nxt; cA = nA; cB = nB; ++ui;
        if constexpr (ALIGN_EPI) { if (wr == 1) PG8_BAR; }
    }
    PG8_WAIT_V(0);
    if constexpr (!ALIGN_EPI) { if (wr == 0) PG8_BAR; }
    PG8_BAR;
    if constexpr (Epi::AFTER_DRAIN) { E.fused(acc, cur, wr, wc, fr, fq, lds, wid, lane); S.done(cur); }
#undef PG8_SA
#undef PG8_SB
#undef PG8_STAGE
#undef PG8_LDA
#undef PG8_LDB
#undef PG8_MMA
#undef PG8_WAIT_V
#undef PG8_WAIT_L
#undef PG8_BAR
#undef PG8_SCHED
}
}

template <class E> struct EpiAd {
    static constexpr bool PERM = false, AFTER_DRAIN = false;
    E e;
    __device__ __forceinline__ void operator()(const f32x4 (&acc)[2][2][4][2], const pg8::Unit& u, int wr, int wc, int fr, int fq) const {
#pragma unroll
        for (int ai = 0; ai < 2; ++ai)
#pragma unroll
            for (int m = 0; m < 4; ++m) {
                const int row = u.pm * 256 + ai * 128 + wr * 64 + m * 16 + fr;
#pragma unroll
                for (int bj = 0; bj < 2; ++bj)
#pragma unroll
                    for (int n = 0; n < 2; ++n) e(row, u.pn * 256 + bj * 128 + wc * 32 + n * 16 + 4 * fq, acc[ai][bj][m][n]);
            }
    }
};
template <class E> __device__ __forceinline__ void run_gemm(PG8_LAS unsigned char* lds, const bf16_t* A, int lda, const bf16_t* Bt, int M, int N, int K, const E& e) {
    int Ko = K; asm volatile("" : "+s"(Ko));
    pg8::Gemm g{A, Bt, M, N, Ko, lda}; pg8::StaticOrder S; S.init(M, N, (int)gridDim.x, (int)blockIdx.x);
    EpiAd<E> ad{e};
    pg8::gemm_phase<EpiAd<E>, pg8::StaticOrder, true, true>(lds, g, S, ad);
}

template <class Epi>
__device__ __forceinline__ void gemm_wave(const Ctx& c, const bf16_t* A, int lda, const bf16_t* Bt, int M, int N, int K, const Epi& epi) {
    const int fr = c.lane & 15, fq = c.lane >> 4; const int ntn = N / 64, nt = (M / 32) * ntn;
    for (int tile = c.gw; tile < nt; tile += c.NGW) {
        const int m0 = (tile / ntn) * 32, n0 = (tile % ntn) * 64;
        f32x4 acc[2][4];
#pragma unroll
        for (int i = 0; i < 2; ++i)
#pragma unroll
            for (int j = 0; j < 4; ++j) acc[i][j] = (f32x4){0.f, 0.f, 0.f, 0.f};
        const bf16_t* ap = A + (size_t)(m0 + fr) * lda + fq * 8; const bf16_t* bp = Bt + (size_t)(n0 + fr) * K + fq * 8;
        for (int k0 = 0; k0 < K; k0 += 32) {
            bf16x8 a[2], b[4];
#pragma unroll
            for (int i = 0; i < 2; ++i) a[i] = *(const bf16x8*)(ap + (size_t)(16 * i) * lda + k0);
#pragma unroll
            for (int j = 0; j < 4; ++j) b[j] = *(const bf16x8*)(bp + (size_t)(16 * j) * K + k0);
#pragma unroll
            for (int i = 0; i < 2; ++i)
#pragma unroll
                for (int j = 0; j < 4; ++j) acc[i][j] = __builtin_amdgcn_mfma_f32_16x16x32_bf16(b[j], a[i], acc[i][j], 0, 0, 0);
        }
#pragma unroll
        for (int i = 0; i < 2; ++i)
#pragma unroll
            for (int j = 0; j < 4; ++j) epi(m0 + 16 * i + fr, n0 + 16 * j + 4 * fq, acc[i][j]);
    }
}

__device__ __forceinline__ void ph_rstd(const Ctx& c, const bf16_t* PROJ, float* RSQ, float* RSKV) {
    const int lane = c.lane;
    for (int row = c.gw; row < T; row += c.NGW) {
        const bf16_t* p = PROJ + (size_t)row * NP;
        float s = 0.f;
#pragma unroll
        for (int j = 0; j < 4; ++j) { const float v = bf2f(p[P_MQ + lane + 64 * j]); s += v * v; }
        s = wave_sum(s);
        float s2 = 0.f;
#pragma unroll
        for (int j = 0; j < 2; ++j) { const float v = bf2f(p[P_MKV + lane + 64 * j]); s2 += v * v; }
        s2 = wave_sum(s2);
        if (lane == 0) { RSQ[row] = rsqrtf(s * (1.f / 256.f) + EPS); RSKV[row] = rsqrtf(s2 * (1.f / 128.f) + EPS); }
    }
}

__device__ __forceinline__ void ph_attn_naive(const Ctx& c, const bf16_t* Q, const bf16_t* KV, const bf16_t* PROJ, bf16_t* MIX) {
    const int lane = c.lane;
    for (int W = c.gw; W < (T / 64) * 16; W += c.NGW) {
        const int cgk = W >> 4, h = (W >> 1) & 7, vh = W & 1; const int t = cgk * 64 + lane; const int b = (cgk * 64) / S; const int nk = ((cgk * 64) % S) + 64; const int kb = b * S;
        float q[96];
        const bf16_t* qp = Q + (size_t)t * 768 + h * 96;
#pragma unroll
        for (int d = 0; d < 96; ++d) q[d] = bf2f(qp[d]);
        float o[32];
#pragma unroll
        for (int e = 0; e < 32; ++e) o[e] = 0.f;
        float m = -1e30f, l = 0.f;
        for (int j = 0; j < nk; ++j) {
            const bf16_t* kn = KV + (size_t)(kb + j) * 1024 + h * 128; const bf16_t* kp = PROJ + (size_t)(kb + j) * NP + P_KPE;
            float s = 0.f;
#pragma unroll
            for (int d = 0; d < 64; ++d) s = fmaf(q[d], bf2f(kn[d]), s);
#pragma unroll
            for (int d = 0; d < 32; ++d) s = fmaf(q[64 + d], bf2f(kp[d]), s);
            const float mn = fmaxf(m, s); const float sc = exp2f(m - mn), pp = exp2f(s - mn); m = mn; l = l * sc + pp;
#pragma unroll
            for (int e = 0; e < 32; ++e) o[e] = o[e] * sc + pp * bf2f(kn[64 + vh * 32 + e]);
        }
        const float rl = 1.f / l;
        const bf16_t* z = PROJ + (size_t)t * NP + P_MZ + h * 64 + vh * 32; bf16_t* mo = MIX + (size_t)t * 1024 + 256 + h * 64 + vh * 32;
#pragma unroll
        for (int e = 0; e < 32; ++e) mo[e] = (bf16_t)f2bf(o[e] * rl * bf2f(z[e]));
    }
}

__device__ __forceinline__ void ph_ret_naive(const Ctx& c, const bf16_t* PROJ, bf16_t* MIX) {
    const int lane = c.lane;
    for (int W = c.gw; W < (T / 64) * 4; W += c.NGW) {
        const int cgk = W >> 2, h = W & 3; const int t = cgk * 64 + lane; const int b = (cgk * 64) / S; const int nk = ((cgk * 64) % S) + 64; const int kb = b * S;
        const float lg = log1pf(-exp2f(-5.f - (float)h));
        float q[64];
        const bf16_t* qp = PROJ + (size_t)t * NP + P_RQ + h * 64;
#pragma unroll
        for (int d = 0; d < 64; ++d) q[d] = bf2f(qp[d]);
        float o[64];
#pragma unroll
        for (int e = 0; e < 64; ++e) o[e] = 0.f;
        const int ti = t - kb;
        for (int j = 0; j < nk; ++j) {
            const bf16_t* kr = PROJ + (size_t)(kb + j) * NP + P_RK + h * 64; const bf16_t* vr = PROJ + (size_t)(kb + j) * NP + P_RV + h * 64;
            float s = 0.f;
#pragma unroll
            for (int d = 0; d < 64; ++d) s = fmaf(q[d], bf2f(kr[d]), s);
            const int dd = ti - j; s *= __expf(lg * (float)(dd < 0 ? -dd : dd));
#pragma unroll
            for (int e = 0; e < 64; ++e) o[e] = fmaf(s, bf2f(vr[e]), o[e]);
        }
        float ss = 0.f;
#pragma unroll
        for (int e = 0; e < 64; ++e) ss += o[e] * o[e];
        const float rstd = rsqrtf(ss * (1.f / 64.f) + EPS);
        const bf16_t* z = PROJ + (size_t)t * NP + P_RZ + h * 64; bf16_t* mo = MIX + (size_t)t * 1024 + h * 64;
#pragma unroll
        for (int e = 0; e < 64; ++e) mo[e] = (bf16_t)f2bf(o[e] * rstd * bf2f(z[e]));
    }
}

__device__ __forceinline__ void ph_gla_la(const Ctx& c, const float* GG, const float* w_g2, const float* b_g2, float* G) {
    for (long i = c.gt; i < (long)T * 128; i += c.GT) {
        const int n = (int)(i & 127); const long t = i >> 7;
        float z = b_g2[n];
#pragma unroll
        for (int r = 0; r < 16; ++r) z = fmaf(GG[t * 16 + r], w_g2[r * 128 + n], z);
        const float ls = fminf(z, 0.f) - log1pf(__expf(-fabsf(z)));
        G[i] = ls * (1.f / 16.f);
    }
}
__device__ __forceinline__ void ph_gla_cum(const Ctx& c, float* G) {
    if (c.gt < NB * 128) {
        const int b = (int)(c.gt >> 7), n = (int)(c.gt & 127); float acc = 0.f;
        for (int s = 0; s < S; ++s) { const size_t i = ((size_t)b * S + s) * 128 + n; acc += G[i]; G[i] = acc; }
    }
}
__device__ __forceinline__ void ph_gla_naive(const Ctx& c, const bf16_t* PROJ, const float* G, const float* gnw, bf16_t* MIX, float* ldsf) {
    const int lane = c.lane;
    for (int W = c.gw; W < (T / 64) * 4; W += c.NGW) {
        const int cgk = W >> 2, h = W & 3; const int t = cgk * 64 + lane; const int b = (cgk * 64) / S; const int nk = ((cgk * 64) % S) + 64; const int kb = b * S;
        float q[32], gi[32];
        const bf16_t* qp = PROJ + (size_t)t * NP + P_GQ + h * 32;
#pragma unroll
        for (int d = 0; d < 32; ++d) { q[d] = bf2f(qp[d]); gi[d] = G[(size_t)t * 128 + h * 32 + d]; }
        float ss = 0.f; float o[32];
        float* o0 = ldsf + c.wave * 2048 + lane;
#pragma unroll 1
        for (int vh = 0; vh < 2; ++vh) {
#pragma unroll
            for (int e = 0; e < 32; ++e) o[e] = 0.f;
            for (int j = 0; j < nk; ++j) {
                const bf16_t* kr = PROJ + (size_t)(kb + j) * NP + P_GK + h * 32; const bf16_t* vr = PROJ + (size_t)(kb + j) * NP + P_GV + h * 64 + vh * 32;
                const float* gj = G + (size_t)(kb + j) * 128 + h * 32;
                float s = 0.f;
#pragma unroll
                for (int d = 0; d < 32; ++d) s = fmaf(q[d] * bf2f(kr[d]), __expf(-fabsf(gi[d] - gj[d])), s);
#pragma unroll
                for (int e = 0; e < 32; ++e) o[e] = fmaf(s, bf2f(vr[e]), o[e]);
            }
#pragma unroll
            for (int e = 0; e < 32; ++e) ss += o[e] * o[e];
            if (vh == 0) {
#pragma unroll
                for (int e = 0; e < 32; ++e) o0[e * 64] = o[e];
            }
        }
        const float rstd = rsqrtf(ss * (1.f / 64.f) + EPS);
        const bf16_t* z = PROJ + (size_t)t * NP + P_GZ + h * 64; bf16_t* mo = MIX + (size_t)t * 1024 + 768 + h * 64;
#pragma unroll
        for (int e = 0; e < 32; ++e) mo[e] = (bf16_t)f2bf(o0[e * 64] * rstd * gnw[e] * bf2f(z[e]));
#pragma unroll
        for (int e = 0; e < 32; ++e) mo[32 + e] = (bf16_t)f2bf(o[e] * rstd * gnw[32 + e] * bf2f(z[32 + e]));
    }
}

namespace att {
typedef short s16x4 __attribute__((ext_vector_type(4)));
typedef float f32x16 __attribute__((ext_vector_type(16)));
constexpr int KROW = 208, SHM_K = 64 * KROW, SHM_V = 64 * 64 * 2;
constexpr int L_K = 0, L_V = 2 * SHM_K, L_WS = L_V + 2 * SHM_V, L_END = L_WS + 8 * 64 * 4;
constexpr float THR = 4.f;
#define ASBAR() __builtin_amdgcn_sched_barrier(0)
__device__ __forceinline__ int crow(int r, int hi) { return (r & 3) + 8 * (r >> 2) + 4 * hi; }
__device__ __forceinline__ unsigned cvtpk(float lo, float hi) { unsigned r; asm volatile("v_cvt_pk_bf16_f32 %0, %1, %2" : "=v"(r) : "v"(lo), "v"(hi)); return r; }

__device__ __forceinline__ void partialSM(f32x16& p0, f32x16& p1, float& m_reg, float& mn, float& alpha) {
  float pmax = p0[0];
#pragma unroll
  for (int r = 1; r < 16; ++r) pmax = fmaxf(pmax, p0[r]);
#pragma unroll
  for (int r = 0; r < 16; ++r) pmax = fmaxf(pmax, p1[r]);
  { auto rr = __builtin_amdgcn_permlane32_swap(__float_as_uint(pmax), __float_as_uint(pmax), false, false);
    pmax = fmaxf(__uint_as_float(rr[0]), __uint_as_float(rr[1])); }
  if (__builtin_expect(__all(pmax - m_reg <= THR), 1)) { mn = m_reg; alpha = 1.f; }
  else { mn = fmaxf(m_reg, pmax); alpha = __builtin_amdgcn_exp2f(m_reg - mn); m_reg = mn; }
#pragma unroll
  for (int r = 0; r < 16; ++r) p0[r] = p0[r] - mn;
#pragma unroll
  for (int r = 0; r < 16; ++r) p1[r] = p1[r] - mn;
#pragma unroll
  for (int r = 0; r < 16; ++r) p0[r] = __builtin_amdgcn_exp2f(p0[r]);
}
__device__ __forceinline__ void finishSM(f32x16& p0, f32x16& p1, float alpha, float& l_reg, bf16x8& pa0, bf16x8& pa1, bf16x8& pa2, bf16x8& pa3) {
#pragma unroll
  for (int r = 0; r < 16; ++r) p1[r] = __builtin_amdgcn_exp2f(p1[r]);
  float ps = 0;
#pragma unroll
  for (int r = 0; r < 16; ++r) ps += p0[r];
#pragma unroll
  for (int r = 0; r < 16; ++r) ps += p1[r];
  { auto rr = __builtin_amdgcn_permlane32_swap(__float_as_uint(ps), __float_as_uint(ps), false, false);
    ps = __uint_as_float(rr[0]) + __uint_as_float(rr[1]); }
  l_reg = l_reg * alpha + ps;
#define PK4(P, BASE, OUT) do { unsigned a0 = cvtpk(P[BASE + 0], P[BASE + 1]), a1 = cvtpk(P[BASE + 2], P[BASE + 3]);   \
    unsigned b0 = cvtpk(P[BASE + 4], P[BASE + 5]), b1 = cvtpk(P[BASE + 6], P[BASE + 7]);                              \
    auto r0 = __builtin_amdgcn_permlane32_swap(a0, b0, false, false); auto r1 = __builtin_amdgcn_permlane32_swap(a1, b1, false, false); \
    u32x4 w = {r0[0], r1[0], r0[1], r1[1]}; OUT = *reinterpret_cast<bf16x8*>(&w); } while (0)
  PK4(p0, 0, pa0); PK4(p0, 8, pa1); PK4(p1, 0, pa2); PK4(p1, 8, pa3);
#undef PK4
}
__device__ __forceinline__ void qkt(f32x16& p0, f32x16& p1, const char* Ks, const bf16x8* qr, int r32, int hi) {
  p0 = f32x16{}; p1 = f32x16{};
  const char* kb = Ks + r32 * KROW + hi * 16;
#pragma unroll
  for (int d0 = 0; d0 < 6; ++d0) {
    bf16x8 b0 = *reinterpret_cast<const bf16x8*>(kb + d0 * 32);
    bf16x8 b1 = *reinterpret_cast<const bf16x8*>(kb + 32 * KROW + d0 * 32);
    p0 = __builtin_amdgcn_mfma_f32_32x32x16_bf16(b0, qr[d0], p0, 0, 0, 0);
    p1 = __builtin_amdgcn_mfma_f32_32x32x16_bf16(b1, qr[d0], p1, 0, 0, 0); }
}
__device__ __forceinline__ int v_st(int k, int c) { const int kk = (k & ~0xC) | ((k & 4) << 1) | ((k & 8) >> 1); return ((kk >> 3) * 2 + (c >> 5)) * 512 + ((kk & 7) * 32 + (c & 31)) * 2; }
__device__ __forceinline__ int v_rd_base(int lane) { return ((lane & 3) << 3) | (((lane >> 2) & 3) << 6) | (((lane >> 4) & 1) << 5) | (((lane >> 5) & 1) << 8); }
constexpr int v_rd_off(int d0, int ks, int half) { return d0 * 512 + ks * 2048 + half * 1024; }
template <int OFF> __device__ __forceinline__ s16x4 tr_read(int vb) {
  s16x4 r; asm volatile("ds_read_b64_tr_b16 %0, %1 offset:%2" : "=&v"(r) : "v"(vb), "i"(OFF) : "memory"); return r;
}
template <int D0> __device__ __forceinline__ void pv_one(f32x16& od, int vb, bf16x8 pa0, bf16x8 pa1, bf16x8 pa2, bf16x8 pa3) {
  const s16x4 l0 = tr_read<v_rd_off(D0, 0, 0)>(vb), h0 = tr_read<v_rd_off(D0, 0, 1)>(vb), l1 = tr_read<v_rd_off(D0, 1, 0)>(vb), h1 = tr_read<v_rd_off(D0, 1, 1)>(vb);
  const s16x4 l2 = tr_read<v_rd_off(D0, 2, 0)>(vb), h2 = tr_read<v_rd_off(D0, 2, 1)>(vb), l3 = tr_read<v_rd_off(D0, 3, 0)>(vb), h3 = tr_read<v_rd_off(D0, 3, 1)>(vb);
  asm volatile("s_waitcnt lgkmcnt(0)" ::: "memory"); ASBAR();
#define PK(L, H) (bf16x8){L[0], L[1], L[2], L[3], H[0], H[1], H[2], H[3]}
  od = __builtin_amdgcn_mfma_f32_32x32x16_bf16(pa0, PK(l0, h0), od, 0, 0, 0);
  od = __builtin_amdgcn_mfma_f32_32x32x16_bf16(pa1, PK(l1, h1), od, 0, 0, 0);
  od = __builtin_amdgcn_mfma_f32_32x32x16_bf16(pa2, PK(l2, h2), od, 0, 0, 0);
  od = __builtin_amdgcn_mfma_f32_32x32x16_bf16(pa3, PK(l3, h3), od, 0, 0, 0);
#undef PK
}
__device__ __forceinline__ void pv_d0(f32x16* o, int vb, bf16x8 pa0, bf16x8 pa1, bf16x8 pa2, bf16x8 pa3) {
  pv_one<0>(o[0], vb, pa0, pa1, pa2, pa3); pv_one<1>(o[1], vb, pa0, pa1, pa2, pa3);
}

__device__ __forceinline__ void attn_unit(const bf16_t* __restrict__ Q, const bf16_t* __restrict__ KV, const bf16_t* __restrict__ PROJ, bf16_t* __restrict__ MIX,
                                          int h, int tq0, int kb0, int NT, char* lds) {
  int tid_ = threadIdx.x; asm volatile("" : "+v"(tid_));
  const int tid = tid_, wid = __builtin_amdgcn_readfirstlane(tid >> 6), lane = tid & 63, r32 = lane & 31, hi = lane >> 5;
  char* V_lds = lds + L_V; char* K_lds = lds + L_K;
  float* ws = (float*)(lds + L_WS) + wid * 64; float* li_l = ws; float* al_l = ws + 32;
  const int tmax = NT - 4 + (wid >> 1);
  float m_reg = -1e30f, l_reg = 0; f32x16 o[2] = {}; bf16x8 qr[6];
  const bf16_t* Qw = Q + (size_t)(tq0 + wid * 32 + r32) * 768 + h * 96 + hi * 8;
#pragma unroll
  for (int d0 = 0; d0 < 6; ++d0) qr[d0] = *reinterpret_cast<const bf16x8*>(Qw + d0 * 16);
  const int srow = tid >> 3, sch = tid & 7, prow = (tid & 255) >> 2, pch = tid & 3;
  const bf16_t* Kn = KV + (size_t)(kb0 + srow) * 1024 + h * 128 + sch * 8;
  const bf16_t* Kp = PROJ + (size_t)(kb0 + prow) * NP + P_KPE + pch * 8;
  const int kst = srow * KROW + sch * 16, pst = prow * KROW + 128 + pch * 16, vst = v_st(srow, sch * 8);
  const int vb0 = (int)(uintptr_t)V_lds + v_rd_base(lane);
  struct { bf16x8 kn, vv, kp; } sr_[2];
#define SLOAD(i, k0) do { sr_[i].kn = *reinterpret_cast<const bf16x8*>(Kn + (size_t)(k0) * 1024); sr_[i].vv = *reinterpret_cast<const bf16x8*>(Kn + (size_t)(k0) * 1024 + 64); \
    sr_[i].kp = *reinterpret_cast<const bf16x8*>(Kp + (size_t)(k0) * NP); } while (0)
#define SWRITE(b, i) do { *(bf16x8*)(K_lds + (b) * SHM_K + kst) = sr_[i].kn; *(bf16x8*)(K_lds + (b) * SHM_K + pst) = sr_[i].kp; *(bf16x8*)(V_lds + (b) * SHM_V + vst) = sr_[i].vv; } while (0)
#define SWAIT() asm volatile("s_waitcnt vmcnt(3)" ::: "memory")
#define RESC(a) do { if (__any((a) < 1.f)) { if (hi == 0) al_l[r32] = (a); asm volatile("s_waitcnt lgkmcnt(0)" ::: "memory"); \
    _Pragma("unroll") for (int d = 0; d < 2; ++d) _Pragma("unroll") for (int r = 0; r < 16; ++r) o[d][r] *= al_l[crow(r, hi)]; } } while (0)
#define MASKT(P0, P1, tt) do { if ((tt) > tmax) { _Pragma("unroll") for (int r = 0; r < 16; ++r) { P0[r] = -1e30f; P1[r] = -1e30f; } } } while (0)
  f32x16 pA0, pA1, pB0, pB1; float mnA, mnB, alA, alB; bf16x8 pa0, pa1, pa2, pa3;
  constexpr int SE = 0, SO = 1;
  SLOAD(SE, 0); asm volatile("s_waitcnt vmcnt(0)" ::: "memory"); SWRITE(0, SE); __syncthreads();
  qkt(pA0, pA1, K_lds, qr, r32, hi); partialSM(pA0, pA1, m_reg, mnA, alA);
  SLOAD(SO, 64); if (2 < NT) SLOAD(SE, 2 * 64);
  SWAIT(); SWRITE(1, SO); __syncthreads();
  for (int j = 1; j + 1 < NT; j += 2) {
    ASBAR(); qkt(pB0, pB1, K_lds + SHM_K, qr, r32, hi); MASKT(pB0, pB1, j);
    finishSM(pA0, pA1, alA, l_reg, pa0, pa1, pa2, pa3); ASBAR();
    SLOAD(SO, (j + 2) * 64); ASBAR();
    pv_d0(o, vb0, pa0, pa1, pa2, pa3); partialSM(pB0, pB1, m_reg, mnB, alB);
    __syncthreads(); SWAIT(); SWRITE(0, SE);
    RESC(alB); __syncthreads();
    ASBAR(); qkt(pA0, pA1, K_lds, qr, r32, hi); MASKT(pA0, pA1, j + 1);
    finishSM(pB0, pB1, alB, l_reg, pa0, pa1, pa2, pa3); ASBAR();
    if (j + 3 < NT) SLOAD(SE, (j + 3) * 64); ASBAR();
    pv_d0(o, vb0 + SHM_V, pa0, pa1, pa2, pa3); partialSM(pA0, pA1, m_reg, mnA, alA);
    __syncthreads(); SWAIT(); SWRITE(1, SO);
    RESC(alA); __syncthreads();
  }
  ASBAR(); qkt(pB0, pB1, K_lds + SHM_K, qr, r32, hi); MASKT(pB0, pB1, NT - 1);
  finishSM(pA0, pA1, alA, l_reg, pa0, pa1, pa2, pa3); ASBAR();
  pv_d0(o, vb0, pa0, pa1, pa2, pa3); partialSM(pB0, pB1, m_reg, mnB, alB);
  __syncthreads(); RESC(alB);
  finishSM(pB0, pB1, alB, l_reg, pa0, pa1, pa2, pa3); ASBAR();
  pv_d0(o, vb0 + SHM_V, pa0, pa1, pa2, pa3);
  if (hi == 0) li_l[r32] = l_reg; asm volatile("s_waitcnt lgkmcnt(0)" ::: "memory");
  float rli[16];
#pragma unroll
  for (int r = 0; r < 16; ++r) rli[r] = __builtin_amdgcn_rcpf(li_l[crow(r, hi)]);
#pragma unroll
  for (int r = 0; r < 16; ++r) { const size_t t = (size_t)(tq0 + wid * 32 + crow(r, hi));
#pragma unroll
    for (int d0 = 0; d0 < 2; ++d0) { const int col = h * 64 + d0 * 32 + r32;
      MIX[t * 1024 + 256 + col] = (bf16_t)f2bf(o[d0][r] * rli[r] * bf2f(PROJ[t * NP + P_MZ + col])); } }
#undef SLOAD
#undef SWRITE
#undef SWAIT
#undef RESC
#undef MASKT
}
__device__ __forceinline__ void attn_phase(const bf16_t* Q, const bf16_t* KV, const bf16_t* PROJ, bf16_t* MIX, char* lds) {
  const int G = gridDim.x, bx = blockIdx.x; const int v = (G % 8 == 0) ? (bx % 8) * (G / 8) + bx / 8 : bx;
  for (int bh = v; bh < NB * 8; bh += G) {
    const int b = bh >> 3, h = bh & 7;
    for (int qb = 0; qb < S / 256; ++qb) attn_unit(Q, KV, PROJ, MIX, h, b * S + qb * 256, b * S, 4 * (qb + 1), lds);
  }
}
#undef ASBAR
}

namespace chain {
#define LDS3 __attribute__((address_space(3)))
typedef short v4i16_t __attribute__((ext_vector_type(4)));
__device__ __forceinline__ bf16x8 tr2(const LDS3 char* p0, const LDS3 char* p1) {
  const v4i16_t a = __builtin_amdgcn_ds_read_tr16_b64_v4i16((LDS3 v4i16_t*)p0), b = __builtin_amdgcn_ds_read_tr16_b64_v4i16((LDS3 v4i16_t*)p1);
  return (bf16x8){a[0], a[1], a[2], a[3], b[0], b[1], b[2], b[3]};
}
__device__ __forceinline__ bf16x8 ld16(const LDS3 char* p) { return *(const LDS3 bf16x8*)p; }
__device__ __forceinline__ bf16x8 pack8(f32x4 a, f32x4 b) { u32x4 w = {pk2(a[0], a[1]), pk2(a[2], a[3]), pk2(b[0], b[1]), pk2(b[2], b[3])}; return __builtin_bit_cast(bf16x8, w); }
__device__ __forceinline__ float grp16_sum(float v) { v += __shfl_xor(v, 1); v += __shfl_xor(v, 2); v += __shfl_xor(v, 4); v += __shfl_xor(v, 8); return v; }
#define MFMA16(a, b, c) __builtin_amdgcn_mfma_f32_16x16x32_bf16((a), (b), (c), 0, 0, 0)
constexpr int RS = 144, TSZ = 64 * RS;
constexpr int RS2 = 80, TSZ2 = 64 * RS2;

__device__ __forceinline__ void ret_chain(const bf16_t* __restrict__ PROJ, bf16_t* __restrict__ MIX, int b, int h, LDS3 char* L) {
  int tid_ = threadIdx.x; asm volatile("" : "+v"(tid_));
  const int tid = tid_, wid = __builtin_amdgcn_readfirstlane(tid >> 6), lane = tid & 63, fr = lane & 15, g = lane >> 4, q4 = fr >> 2, p4 = fr & 3;
  constexpr int O_K = 0, O_V = 2 * TSZ, O_VS = 4 * TSZ, O_ST = 6 * TSZ;
  const float lg = log1pf(-exp2f(-5.f - (float)h));
  const int t00 = b * S;
  const int srow = tid >> 3, spc = tid & 7, sOff = srow * RS + spc * 16;
  const bf16_t* gk = PROJ + (size_t)(t00 + srow) * NP + P_RK + h * 64 + spc * 8;
  const float kwj = __expf(lg * (float)(63 - srow));
  const bool outw = wid < 4; const int rb = wid & 3;
  const bf16_t* gq = PROJ + (size_t)(t00 + 16 * rb + fr) * NP + P_RQ + h * 64 + 8 * g;
  float decay[4][4], qw[4];
#pragma unroll
  for (int jt = 0; jt < 4; ++jt)
#pragma unroll
    for (int r = 0; r < 4; ++r) { const int d = (16 * rb + fr) - (16 * jt + 4 * g + r); decay[jt][r] = __expf(lg * (float)(d < 0 ? -d : d)); }
#pragma unroll
  for (int r = 0; r < 4; ++r) qw[r] = __expf(lg * (float)(16 * rb + 4 * g + r + 1));
  const float a64 = __expf(lg * 64.f);
  f32x4 Sacc[4];
#pragma unroll
  for (int e = 0; e < 4; ++e) Sacc[e] = (f32x4){0.f, 0.f, 0.f, 0.f};
  __syncthreads();
  for (int i = tid; i < TSZ / 4; i += 512) ((LDS3 unsigned*)(L + O_ST))[i] = 0u;
  bf16x8 rk = *(const bf16x8*)gk, rv = *(const bf16x8*)(gk + 256), qf0 = *(const bf16x8*)gq, qf1 = *(const bf16x8*)(gq + 32);
  for (int n = 0; n < S / 64; ++n) {
    const int buf = n & 1;
    *(LDS3 bf16x8*)(L + O_K + buf * TSZ + sOff) = rk; *(LDS3 bf16x8*)(L + O_V + buf * TSZ + sOff) = rv;
    { f32x4 lo, hi2;
#pragma unroll
      for (int e = 0; e < 4; ++e) { lo[e] = bf2f((bf16_t)rv[e]) * kwj; hi2[e] = bf2f((bf16_t)rv[4 + e]) * kwj; }
      *(LDS3 bf16x8*)(L + O_VS + buf * TSZ + sOff) = pack8(lo, hi2); }
    const bf16x8 q0 = qf0, q1 = qf1;
    { const int nn = (n + 1 < S / 64) ? n + 1 : n; const size_t go = (size_t)nn * 64 * NP;
      rk = *(const bf16x8*)(gk + go); rv = *(const bf16x8*)(gk + go + 256); qf0 = *(const bf16x8*)(gq + go); qf1 = *(const bf16x8*)(gq + go + 32); }
    __syncthreads();
    const LDS3 char* KT = L + O_K + buf * TSZ; const LDS3 char* VT = L + O_V + buf * TSZ; const LDS3 char* VS = L + O_VS + buf * TSZ;
    if (outw) {
      const LDS3 char* STc = L + O_ST + buf * TSZ;
      f32x4 sT[4];
#pragma unroll
      for (int jt = 0; jt < 4; ++jt) {
        f32x4 a = (f32x4){0.f, 0.f, 0.f, 0.f};
        a = MFMA16(ld16(KT + (16 * jt + fr) * RS + 16 * g), q0, a);
        a = MFMA16(ld16(KT + (16 * jt + fr) * RS + 64 + 16 * g), q1, a);
#pragma unroll
        for (int r = 0; r < 4; ++r) a[r] *= decay[jt][r];
        sT[jt] = a;
      }
      const bf16x8 af0 = pack8(sT[0], sT[1]), af1 = pack8(sT[2], sT[3]);
      f32x4 o[4]; float ss[4] = {0.f, 0.f, 0.f, 0.f};
#pragma unroll
      for (int et = 0; et < 4; ++et) {
        f32x4 a = (f32x4){0.f, 0.f, 0.f, 0.f};
        a = MFMA16(q0, ld16(STc + (16 * et + fr) * RS + 16 * g), a);
        a = MFMA16(q1, ld16(STc + (16 * et + fr) * RS + 64 + 16 * g), a);
#pragma unroll
        for (int r = 0; r < 4; ++r) a[r] *= qw[r];
        a = MFMA16(af0, tr2(VT + (4 * g + q4) * RS + (16 * et + 4 * p4) * 2, VT + (16 + 4 * g + q4) * RS + (16 * et + 4 * p4) * 2), a);
        a = MFMA16(af1, tr2(VT + (32 + 4 * g + q4) * RS + (16 * et + 4 * p4) * 2, VT + (48 + 4 * g + q4) * RS + (16 * et + 4 * p4) * 2), a);
        o[et] = a;
#pragma unroll
        for (int r = 0; r < 4; ++r) ss[r] += a[r] * a[r];
      }
#pragma unroll
      for (int r = 0; r < 4; ++r) ss[r] = rsqrtf(grp16_sum(ss[r]) * (1.f / 64.f) + EPS);
#pragma unroll
      for (int r = 0; r < 4; ++r) { const size_t t = (size_t)(t00 + n * 64 + 16 * rb + 4 * g + r);
#pragma unroll
        for (int et = 0; et < 4; ++et) { const int e = h * 64 + 16 * et + fr;
          MIX[t * 1024 + e] = (bf16_t)f2bf(o[et][r] * ss[r] * bf2f(PROJ[t * NP + P_RZ + e])); } }
    } else {
      const int s = wid - 4; LDS3 char* STn = L + O_ST + (buf ^ 1) * TSZ;
      const bf16x8 kt0 = tr2(KT + (8 * g + q4) * RS + (16 * s + 4 * p4) * 2, KT + (8 * g + 4 + q4) * RS + (16 * s + 4 * p4) * 2);
      const bf16x8 kt1 = tr2(KT + (32 + 8 * g + q4) * RS + (16 * s + 4 * p4) * 2, KT + (32 + 8 * g + 4 + q4) * RS + (16 * s + 4 * p4) * 2);
#pragma unroll
      for (int et = 0; et < 4; ++et) {
        f32x4 a = Sacc[et] * a64;
        a = MFMA16(kt0, tr2(VS + (8 * g + q4) * RS + (16 * et + 4 * p4) * 2, VS + (8 * g + 4 + q4) * RS + (16 * et + 4 * p4) * 2), a);
        a = MFMA16(kt1, tr2(VS + (32 + 8 * g + q4) * RS + (16 * et + 4 * p4) * 2, VS + (32 + 8 * g + 4 + q4) * RS + (16 * et + 4 * p4) * 2), a);
        Sacc[et] = a;
        u32x2 w; w.x = pk2(a[0], a[1]); w.y = pk2(a[2], a[3]);
        *(LDS3 u32x2*)(STn + (16 * et + fr) * RS + (16 * s + 4 * g) * 2) = w;
      }
    }
  }
  __syncthreads();
}

__device__ __forceinline__ void gla_chain(const bf16_t* __restrict__ PROJ, const float* __restrict__ GG, const float* __restrict__ w_g2, const float* __restrict__ b_g2,
                                          const float* __restrict__ gnw, bf16_t* __restrict__ MIX, int b, int h, LDS3 char* L) {
  int tid_ = threadIdx.x; asm volatile("" : "+v"(tid_));
  const int tid = tid_, wid = __builtin_amdgcn_readfirstlane(tid >> 6), lane = tid & 63, fr = lane & 15, g = lane >> 4, q4 = fr >> 2, p4 = fr & 3;
  constexpr int O_QP = 0, O_QN = 2 * TSZ2, O_KN = 4 * TSZ2, O_KP = 6 * TSZ2, O_KD = 8 * TSZ2, O_V = 10 * TSZ2, O_ST = O_V + 2 * TSZ, O_AL = O_ST + 2 * TSZ2;
  const int t00 = b * S;
  const int srow = tid >> 3, spc = tid & 7, sOff = srow * RS + spc * 16;
  const bf16_t* gv = PROJ + (size_t)(t00 + srow) * NP + P_GV + h * 64 + spc * 8;
  const bf16_t* gqk = PROJ + (size_t)(t00 + lane) * NP + P_GQ + h * 32 + 4 * wid;
  const float* ggp = GG + (size_t)(t00 + lane) * 16;
  float wg[16][4], bg[4];
#pragma unroll
  for (int r = 0; r < 16; ++r)
#pragma unroll
    for (int d = 0; d < 4; ++d) wg[r][d] = w_g2[r * 128 + h * 32 + 4 * wid + d];
#pragma unroll
  for (int d = 0; d < 4; ++d) bg[d] = b_g2[h * 32 + 4 * wid + d];
  const bool outw = wid < 4; const int rb = wid & 3;
  const int sdt = wid & 1, set0 = ((wid >> 1) & 1) * 2;
  f32x4 Sacc[2];
  Sacc[0] = (f32x4){0.f, 0.f, 0.f, 0.f}; Sacc[1] = (f32x4){0.f, 0.f, 0.f, 0.f};
  __syncthreads();
  for (int i = tid; i < TSZ2 / 4; i += 512) ((LDS3 unsigned*)(L + O_ST))[i] = 0u;
  bf16x8 rv = *(const bf16x8*)gv; u32x2 rq = *(const u32x2*)gqk, rkk = *(const u32x2*)(gqk + 128);
  f32x4 rg0 = *(const f32x4*)ggp, rg1 = *(const f32x4*)(ggp + 4), rg2 = *(const f32x4*)(ggp + 8), rg3 = *(const f32x4*)(ggp + 12);
  for (int n = 0; n < S / 64; ++n) {
    const int buf = n & 1;
    *(LDS3 bf16x8*)(L + O_V + buf * TSZ + sOff) = rv;
    {
      const float gg[16] = {rg0[0], rg0[1], rg0[2], rg0[3], rg1[0], rg1[1], rg1[2], rg1[3], rg2[0], rg2[1], rg2[2], rg2[3], rg3[0], rg3[1], rg3[2], rg3[3]};
      float cum[4];
#pragma unroll
      for (int d = 0; d < 4; ++d) { float z = bg[d];
#pragma unroll
        for (int r = 0; r < 16; ++r) z = fmaf(gg[r], wg[r][d], z);
        cum[d] = (fminf(z, 0.f) - log1pf(__expf(-fabsf(z)))) * (1.f / 16.f); }
#pragma unroll
      for (int off = 1; off < 64; off <<= 1)
#pragma unroll
        for (int d = 0; d < 4; ++d) { const float t = __shfl_up(cum[d], off); if (lane >= off) cum[d] += t; }
      const float qv[4] = {bf2f((bf16_t)(rq.x & 0xffff)), bf2f((bf16_t)(rq.x >> 16)), bf2f((bf16_t)(rq.y & 0xffff)), bf2f((bf16_t)(rq.y >> 16))};
      const float kv[4] = {bf2f((bf16_t)(rkk.x & 0xffff)), bf2f((bf16_t)(rkk.x >> 16)), bf2f((bf16_t)(rkk.y & 0xffff)), bf2f((bf16_t)(rkk.y >> 16))};
      float qp[4], qn[4], kn[4], kp[4], kd[4];
#pragma unroll
      for (int d = 0; d < 4; ++d) { const float last = __shfl(cum[d], 63); const float ep = __expf(cum[d]), en = __expf(-cum[d]), ed = __expf(last - cum[d]);
        qp[d] = qv[d] * ep; qn[d] = qv[d] * en; kn[d] = kv[d] * en; kp[d] = kv[d] * ep; kd[d] = kv[d] * ed;
        if (lane == 0) ((LDS3 float*)(L + O_AL))[buf * 32 + 4 * wid + d] = __expf(last); }
      const int o2 = buf * TSZ2 + lane * RS2 + 8 * wid;
      u32x2 w;
      w.x = pk2(qp[0], qp[1]); w.y = pk2(qp[2], qp[3]); *(LDS3 u32x2*)(L + O_QP + o2) = w;
      w.x = pk2(qn[0], qn[1]); w.y = pk2(qn[2], qn[3]); *(LDS3 u32x2*)(L + O_QN + o2) = w;
      w.x = pk2(kn[0], kn[1]); w.y = pk2(kn[2], kn[3]); *(LDS3 u32x2*)(L + O_KN + o2) = w;
      w.x = pk2(kp[0], kp[1]); w.y = pk2(kp[2], kp[3]); *(LDS3 u32x2*)(L + O_KP + o2) = w;
      w.x = pk2(kd[0], kd[1]); w.y = pk2(kd[2], kd[3]); *(LDS3 u32x2*)(L + O_KD + o2) = w;
    }
    { const int nn = (n + 1 < S / 64) ? n + 1 : n; const size_t go = (size_t)nn * 64 * NP; const size_t gg2 = (size_t)nn * 64 * 16;
      rv = *(const bf16x8*)(gv + go); rq = *(const u32x2*)(gqk + go); rkk = *(const u32x2*)(gqk + go + 128);
      rg0 = *(const f32x4*)(ggp + gg2); rg1 = *(const f32x4*)(ggp + gg2 + 4); rg2 = *(const f32x4*)(ggp + gg2 + 8); rg3 = *(const f32x4*)(ggp + gg2 + 12); }
    __syncthreads();
    const LDS3 char* VT = L + O_V + buf * TSZ;
    if (outw) {
      const LDS3 char* QP = L + O_QP + buf * TSZ2; const LDS3 char* QN = L + O_QN + buf * TSZ2; const LDS3 char* KN = L + O_KN + buf * TSZ2; const LDS3 char* KP = L + O_KP + buf * TSZ2;
      const LDS3 char* STc = L + O_ST + buf * TSZ2;
      const bf16x8 qpf = ld16(QP + (16 * rb + fr) * RS2 + 16 * g), qnf = ld16(QN + (16 * rb + fr) * RS2 + 16 * g);
      f32x4 sT[4];
#pragma unroll
      for (int jt = 0; jt < 4; ++jt) {
        const f32x4 z4 = (f32x4){0.f, 0.f, 0.f, 0.f};
        const f32x4 past = MFMA16(ld16(KN + (16 * jt + fr) * RS2 + 16 * g), qpf, z4);
        const f32x4 fut = MFMA16(ld16(KP + (16 * jt + fr) * RS2 + 16 * g), qnf, z4);
#pragma unroll
        for (int r = 0; r < 4; ++r) sT[jt][r] = ((16 * rb + fr) >= (16 * jt + 4 * g + r)) ? past[r] : fut[r];
      }
      const bf16x8 af0 = pack8(sT[0], sT[1]), af1 = pack8(sT[2], sT[3]);
      f32x4 o[4]; float ss[4] = {0.f, 0.f, 0.f, 0.f};
#pragma unroll
      for (int et = 0; et < 4; ++et) {
        f32x4 a = (f32x4){0.f, 0.f, 0.f, 0.f};
        a = MFMA16(qpf, ld16(STc + (16 * et + fr) * RS2 + 16 * g), a);
        a = MFMA16(af0, tr2(VT + (4 * g + q4) * RS + (16 * et + 4 * p4) * 2, VT + (16 + 4 * g + q4) * RS + (16 * et + 4 * p4) * 2), a);
        a = MFMA16(af1, tr2(VT + (32 + 4 * g + q4) * RS + (16 * et + 4 * p4) * 2, VT + (48 + 4 * g + q4) * RS + (16 * et + 4 * p4) * 2), a);
        o[et] = a;
#pragma unroll
        for (int r = 0; r < 4; ++r) ss[r] += a[r] * a[r];
      }
#pragma unroll
      for (int r = 0; r < 4; ++r) ss[r] = rsqrtf(grp16_sum(ss[r]) * (1.f / 64.f) + EPS);
#pragma unroll
      for (int r = 0; r < 4; ++r) { const size_t t = (size_t)(t00 + n * 64 + 16 * rb + 4 * g + r);
#pragma unroll
        for (int et = 0; et < 4; ++et) { const int e = 16 * et + fr;
          MIX[t * 1024 + 768 + h * 64 + e] = (bf16_t)f2bf(o[et][r] * ss[r] * gnw[e] * bf2f(PROJ[t * NP + P_GZ + h * 64 + e])); } }
    } else {
      const LDS3 char* KD = L + O_KD + buf * TSZ2; LDS3 char* STn = L + O_ST + (buf ^ 1) * TSZ2; const LDS3 float* AL = (const LDS3 float*)(L + O_AL) + buf * 32;
      const bf16x8 kt0 = tr2(KD + (8 * g + q4) * RS2 + (16 * sdt + 4 * p4) * 2, KD + (8 * g + 4 + q4) * RS2 + (16 * sdt + 4 * p4) * 2);
      const bf16x8 kt1 = tr2(KD + (32 + 8 * g + q4) * RS2 + (16 * sdt + 4 * p4) * 2, KD + (32 + 8 * g + 4 + q4) * RS2 + (16 * sdt + 4 * p4) * 2);
      const f32x4 al = *(const LDS3 f32x4*)(AL + 16 * sdt + 4 * g);
#pragma unroll
      for (int e2 = 0; e2 < 2; ++e2) { const int et = set0 + e2;
        f32x4 a = Sacc[e2] * al;
        a = MFMA16(kt0, tr2(VT + (8 * g + q4) * RS + (16 * et + 4 * p4) * 2, VT + (8 * g + 4 + q4) * RS + (16 * et + 4 * p4) * 2), a);
        a = MFMA16(kt1, tr2(VT + (32 + 8 * g + q4) * RS + (16 * et + 4 * p4) * 2, VT + (32 + 8 * g + 4 + q4) * RS + (16 * et + 4 * p4) * 2), a);
        Sacc[e2] = a;
        u32x2 w; w.x = pk2(a[0], a[1]); w.y = pk2(a[2], a[3]);
        *(LDS3 u32x2*)(STn + (16 * et + fr) * RS2 + (16 * sdt + 4 * g) * 2) = w;
      }
    }
  }
  __syncthreads();
}
__device__ __forceinline__ void chain_phase(const bf16_t* PROJ, const float* GG, const float* w_g2, const float* b_g2, const float* gnw, bf16_t* MIX, LDS3 char* L) {
  const int G = gridDim.x, bx = blockIdx.x; const int v = (G % 8 == 0) ? (bx % 8) * (G / 8) + bx / 8 : bx;
  for (int c = v; c < NB * 8; c += G) {
    const int b = c >> 3, h = c & 3;
    if ((c >> 2) & 1) gla_chain(PROJ, GG, w_g2, b_g2, gnw, MIX, b, h, L); else ret_chain(PROJ, MIX, b, h, L);
  }
}
#undef MFMA16
}

constexpr int NTHREADS = 512;
constexpr int LDS_BYTES = 147456;
__global__ void __launch_bounds__(NTHREADS, 2) mk_fwd(Params p) {
    extern __shared__ __attribute__((aligned(16))) unsigned char lds[];
    cg::grid_group grid = cg::this_grid();
    Ctx c; c.tid = threadIdx.x; c.lane = c.tid & 63; c.wave = __builtin_amdgcn_readfirstlane(c.tid >> 6);
    c.gw = blockIdx.x * (NTHREADS / 64) + c.wave; c.NGW = gridDim.x * (NTHREADS / 64);
    c.gt = (long)blockIdx.x * NTHREADS + c.tid; c.GT = (long)gridDim.x * NTHREADS;
    unsigned char* ws = p.ws;
    float* ADA = (float*)(ws + WS_ADA); const float2* CS32 = (const float2*)(ws + WS_CS32); const float2* CS16 = (const float2*)(ws + WS_CS16);
    bf16_t* WinT = (bf16_t*)(ws + WS_WIN); bf16_t* WuqT = (bf16_t*)(ws + WS_WUQ); bf16_t* WukvT = (bf16_t*)(ws + WS_WUKV); bf16_t* WoutT = (bf16_t*)(ws + WS_WOUT);
    float* RSQ = (float*)(ws + WS_RSQ); float* RSKV = (float*)(ws + WS_RSKV); float* GG = (float*)(ws + WS_GG);
    bf16_t* H = (bf16_t*)(ws + WS_H); bf16_t* PROJ = (bf16_t*)(ws + WS_PROJ); bf16_t* Q = (bf16_t*)(ws + WS_Q); bf16_t* KV = (bf16_t*)(ws + WS_KV); bf16_t* MIX = (bf16_t*)(ws + WS_MIX);
    float* GC = (float*)(ws + WS_GCUM);
    PG8_LAS unsigned char* ldsp = (PG8_LAS unsigned char*)lds;

    ph_prep(p, fresh(c));
    grid.sync();
#pragma unroll 1
    for (int l = 0; l < DEPTH; ++l) {
        const float* xin = (l == 0) ? p.x : p.out;
        const float* ADA_l = ADA + (size_t)l * NB * 3072;
        ph_norm(fresh(c), xin, p.norm_w + l * D, ADA_l, H);
        grid.sync();
        run_gemm(ldsp, H, D, WinT + (size_t)l * NP * 1024, T, NP, 1024, EpiIn{PROJ, GG, CS32, CS16});
        grid.sync();
        ph_rstd(fresh(c), PROJ, RSQ, RSKV);
        grid.sync();
        run_gemm(ldsp, PROJ + P_MQ, NP, WuqT + (size_t)l * 768 * 256, T, 768, 256, EpiQ{Q, RSQ, CS16});
        run_gemm(ldsp, PROJ + P_MKV, NP, WukvT + (size_t)l * 1024 * 128, T, 1024, 128, EpiKV{KV, RSKV});
        grid.sync();
        att::attn_phase(Q, KV, PROJ, MIX, (char*)lds);
        chain::chain_phase(PROJ, GG, p.w_g2 + (size_t)l * 16 * 128, p.b_g2 + l * 128, p.gnw + l * 64, MIX, (LDS3 char*)lds);
        grid.sync();
        run_gemm(ldsp, MIX, 1024, WoutT + (size_t)l * 1024 * 1024, T, 1024, 1024, EpiOut{xin, p.out, ADA_l});
        grid.sync();
    }
    ph_final(fresh(c), p.out, p.fnw, p.out);
}

extern "C" void kernel_launch(void* const* d_in, const int* in_sizes, int n_in, void* d_out, int out_size, void* d_ws, size_t ws_size, hipStream_t stream) {
    static int grid_blocks = 0;
    if (grid_blocks == 0) {
        if (n_in != 16 || in_sizes[0] != T * D || out_size != T * D || ws_size < WS_END) {
            fprintf(stderr, "kernel_launch: shape/ws mismatch n_in %d in0 %d out %d ws %zu (need %zu)\n", n_in, n_in > 0 ? in_sizes[0] : -1, out_size, ws_size, (size_t)WS_END);
            grid_blocks = -1; return;
        }
        int dev = 0, cus = 0, per_cu = 0;
        hipGetDevice(&dev); hipDeviceGetAttribute(&cus, hipDeviceAttributeMultiprocessorCount, dev);
        if (hipFuncSetAttribute((const void*)mk_fwd, hipFuncAttributeMaxDynamicSharedMemorySize, LDS_BYTES) != hipSuccess) { fprintf(stderr, "kernel_launch: hipFuncSetAttribute failed\n"); grid_blocks = -1; return; }
        if (hipOccupancyMaxActiveBlocksPerMultiprocessor(&per_cu, (const void*)mk_fwd, NTHREADS, LDS_BYTES) != hipSuccess || per_cu < 1) { fprintf(stderr, "kernel_launch: occupancy query says %d blocks/CU\n", per_cu); grid_blocks = -1; return; }
        grid_blocks = cus;
        fprintf(stderr, "kernel_launch: cus %d per_cu %d grid %d\n", cus, per_cu, grid_blocks);
    }
    if (grid_blocks < 0) return;
    Params p{};
    p.x = (const float*)d_in[0]; p.c = (const float*)d_in[1]; p.pos = (const int*)d_in[2]; p.norm_w = (const float*)d_in[3]; p.ada_w = (const float*)d_in[4];
    p.ada_b = (const float*)d_in[5]; p.w_in = (const float*)d_in[6]; p.qnw = (const float*)d_in[7]; p.w_uq = (const float*)d_in[8]; p.kvnw = (const float*)d_in[9];
    p.w_ukv = (const float*)d_in[10]; p.w_g2 = (const float*)d_in[11]; p.b_g2 = (const float*)d_in[12]; p.gnw = (const float*)d_in[13]; p.w_out = (const float*)d_in[14];
    p.fnw = (const float*)d_in[15]; p.out = (float*)d_out; p.ws = (unsigned char*)d_ws;
    void* args[] = {&p};
    hipError_t e = hipLaunchCooperativeKernel((void*)mk_fwd, dim3(grid_blocks), dim3(NTHREADS), args, LDS_BYTES, stream);
    if (e != hipSuccess) fprintf(stderr, "cooperative launch failed: %s (grid %d)\n", hipGetErrorString(e), grid_blocks);
}
```

```cpp
#include <hip/hip_runtime.h>
#include <hip/hip_cooperative_groups.h>
namespace cg = cooperative_groups;
#include <cstdio>
#include <cstdint>
#include <cmath>

typedef unsigned short bf16_t;
typedef short bf16x8 __attribute__((ext_vector_type(8)));
typedef float f32x4 __attribute__((ext_vector_type(4)));
typedef unsigned u32x4 __attribute__((ext_vector_type(4)));
typedef unsigned u32x2 __attribute__((ext_vector_type(2)));

constexpr int D = 1024, NB = 32, S = 2048, T = NB * S, DEPTH = 2, CH = 64;
constexpr int NIN = 2736, NP = 2816;
constexpr float EPS = 1e-6f;
constexpr int P_RQ = 0, P_RK = 256, P_RV = 512, P_RZ = 768, P_MQ = 1024, P_MKV = 1280, P_KPE = 1408, P_GG = 1440, P_PAD = 1456,
              P_MZ = 1536, P_GQ = 2048, P_GK = 2176, P_GV = 2304, P_GZ = 2560;
constexpr float QSCALE = 0.10206207261596577f * 1.4426950408889634f;

constexpr size_t MiB = 1u << 20;
constexpr size_t WS_CTL = 0;
constexpr size_t WS_ADA = 1 * MiB;
constexpr size_t WS_CS32 = 2 * MiB;
constexpr size_t WS_CS16 = 18 * MiB;
constexpr size_t WS_WIN = 26 * MiB;
constexpr size_t WS_WUQ = 38 * MiB;
constexpr size_t WS_WUKV = 39 * MiB;
constexpr size_t WS_WOUT = 40 * MiB;
constexpr size_t WS_RSQ = 44 * MiB;
constexpr size_t WS_RSKV = 45 * MiB;
constexpr size_t WS_GG = 46 * MiB;
constexpr size_t WS_H = 50 * MiB;
constexpr size_t WS_PROJ = 178 * MiB;
constexpr size_t WS_Q = 530 * MiB;
constexpr size_t WS_KV = 626 * MiB;
constexpr size_t WS_MIX = 754 * MiB;
constexpr size_t WS_GCUM = 882 * MiB;
constexpr size_t WS_END = 914 * MiB;

__device__ __forceinline__ unsigned f2bf(float f) { unsigned u = __builtin_bit_cast(unsigned, f); return (u + 0x7fffu + ((u >> 16) & 1u)) >> 16; }
__device__ __forceinline__ unsigned pk2(float lo, float hi) { return f2bf(lo) | (f2bf(hi) << 16); }
__device__ __forceinline__ float bf2f(bf16_t v) { return __builtin_bit_cast(float, (unsigned)v << 16); }
__device__ __forceinline__ float silu_f(float x) { return x / (1.f + __expf(-x)); }

__host__ __device__ inline int in_logical(int p) {
    if (p < 512) { int c = p & 63; return (p & ~63) + (c >> 1) + 32 * (c & 1); }
    if (p < 1408) return p;
    if (p < 1440) { int c = p - 1408; return 1408 + (c >> 1) + 16 * (c & 1); }
    if (p < 1456) return 2464 + (p - 1440);
    if (p < 1536) return -1;
    if (p < 2048) return 1440 + (p - 1536);
    if (p < 2304) return 1952 + (p - 2048);
    if (p < 2560) return 2208 + (p - 2304);
    return 2480 + (p - 2560);
}
__host__ __device__ inline int uq_logical(int p) {
    int h = p / 96, c = p % 96;
    if (c < 64) return p;
    int cc = c - 64; return h * 96 + 64 + (cc >> 1) + 16 * (cc & 1);
}

struct Params {
    const float* x; const float* c; const int* pos; const float* norm_w; const float* ada_w; const float* ada_b; const float* w_in; const float* qnw;
    const float* w_uq; const float* kvnw; const float* w_ukv; const float* w_g2; const float* b_g2; const float* gnw; const float* w_out; const float* fnw;
    float* out; unsigned char* ws;
};
struct Ctx { int tid, lane, wave, gw, NGW; long gt, GT; };
__device__ __forceinline__ Ctx fresh(const Ctx& c) { Ctx r = c; asm volatile("" : "+v"(r.lane), "+v"(r.tid)); asm volatile("" : "+s"(r.gw)); r.gt = (long)blockIdx.x * 512 + r.tid; return r; }

__device__ __forceinline__ float wave_sum(float v) {
#pragma unroll
    for (int o = 1; o < 64; o <<= 1) v += __shfl_xor(v, o);
    return v;
}

template <class Map>
__device__ __forceinline__ void tr_item(const float* __restrict__ W, int K, int ldw, const float* __restrict__ rs, bf16_t* __restrict__ WT, int nblk, int item, int lane,
                                        __attribute__((address_space(3))) float* scr, const Map& lmap) {
    const int kb = item / nblk, nb = item % nblk, k0 = 64 * kb, n0 = 32 * nb;
    const int lc = lmap(n0 + (lane & 31));
#pragma unroll 8
    for (int i = 0; i < 32; ++i) { const int kk = 2 * i + (lane >> 5);
        float v = 0.f; if (lc >= 0) { v = W[(size_t)(k0 + kk) * ldw + lc]; if (rs) v *= rs[k0 + kk]; }
        scr[kk * 33 + (lane & 31)] = v; }
    asm volatile("s_waitcnt lgkmcnt(0)" ::: "memory");
    const int cc = lane & 7;
#pragma unroll
    for (int j = 0; j < 4; ++j) { const int n = (lane >> 3) + 8 * j; const __attribute__((address_space(3))) float* s = scr + (8 * cc) * 33 + n;
        u32x4 o; o.x = pk2(s[0 * 33], s[1 * 33]); o.y = pk2(s[2 * 33], s[3 * 33]); o.z = pk2(s[4 * 33], s[5 * 33]); o.w = pk2(s[6 * 33], s[7 * 33]);
        *(u32x4*)(WT + (size_t)(n0 + n) * K + k0 + 8 * cc) = o; }
    asm volatile("s_waitcnt lgkmcnt(0)" ::: "memory");
}
struct MapIn { __device__ __forceinline__ int operator()(int p) const { return in_logical(p); } };
struct MapUq { __device__ __forceinline__ int operator()(int p) const { return uq_logical(p); } };
struct MapId { __device__ __forceinline__ int operator()(int p) const { return p; } };
__device__ __forceinline__ void ph_prep(const Params& p, const Ctx& c, __attribute__((address_space(3))) unsigned char* lds) {
    typedef __attribute__((address_space(3))) float lfloat;
    unsigned char* ws = p.ws;
    bf16_t* WinT = (bf16_t*)(ws + WS_WIN); bf16_t* WuqT = (bf16_t*)(ws + WS_WUQ); bf16_t* WukvT = (bf16_t*)(ws + WS_WUKV); bf16_t* WoutT = (bf16_t*)(ws + WS_WOUT);
    float2* CS32 = (float2*)(ws + WS_CS32); float2* CS16 = (float2*)(ws + WS_CS16); float* ADA = (float*)(ws + WS_ADA);
    const int lane = c.lane, wave = c.wave, tid = c.tid;
    for (int item = blockIdx.x; item < DEPTH * 48; item += gridDim.x) {
        const int l = item / 48, cg = item % 48, n = cg * 64 + lane, k0 = wave * 128;
        lfloat* ca = (lfloat*)(lds + wave * 16384);
        for (int i = lane; i < 32 * 128; i += 64) { const int b = i >> 7, kk = i & 127; ca[i] = silu_f(p.c[b * 1024 + k0 + kk]); }
        asm volatile("s_waitcnt lgkmcnt(0)" ::: "memory");
        float acc[32];
#pragma unroll
        for (int b = 0; b < 32; ++b) acc[b] = 0.f;
        const float* wp = p.ada_w + ((size_t)l * 1024 + k0) * 3072 + n;
        for (int kk = 0; kk < 128; kk += 4) {
            const float w0 = wp[(size_t)(kk + 0) * 3072], w1 = wp[(size_t)(kk + 1) * 3072], w2 = wp[(size_t)(kk + 2) * 3072], w3 = wp[(size_t)(kk + 3) * 3072];
#pragma unroll
            for (int b = 0; b < 32; ++b) { const f32x4 c4 = *(const __attribute__((address_space(3))) f32x4*)(ca + b * 128 + kk); acc[b] += c4.x * w0 + c4.y * w1 + c4.z * w2 + c4.w * w3; }
        }
        __syncthreads();
        lfloat* red = (lfloat*)lds;
#pragma unroll
        for (int b = 0; b < 32; ++b) red[(wave * 32 + b) * 64 + lane] = acc[b];
        __syncthreads();
        for (int o = tid; o < 2048; o += 512) { const int b = o >> 6, nn = o & 63; float s = 0.f;
#pragma unroll
            for (int w = 0; w < 8; ++w) s += red[(w * 32 + b) * 64 + nn];
            ADA[((size_t)l * NB + b) * 3072 + cg * 64 + nn] = s + p.ada_b[l * 3072 + cg * 64 + nn]; }
        __syncthreads();
    }
    lfloat* scr = (lfloat*)(lds + wave * 16384);
    constexpr int I_IN = 16 * (NP / 32), I_UQ = 4 * 24, I_UKV = 2 * 32, I_OUT = 16 * 32, I_L = I_IN + I_UQ + I_UKV + I_OUT;
    for (int it = c.gw; it < DEPTH * I_L; it += c.NGW) {
        const int l = it / I_L; int r = it % I_L;
        if (r < I_IN) { tr_item(p.w_in + (size_t)l * 1024 * NIN, 1024, NIN, nullptr, WinT + (size_t)l * NP * 1024, NP / 32, r, lane, scr, MapIn{}); continue; } r -= I_IN;
        if (r < I_UQ) { tr_item(p.w_uq + (size_t)l * 256 * 768, 256, 768, p.qnw + l * 256, WuqT + (size_t)l * 768 * 256, 24, r, lane, scr, MapUq{}); continue; } r -= I_UQ;
        if (r < I_UKV) { tr_item(p.w_ukv + (size_t)l * 128 * 1024, 128, 1024, p.kvnw + l * 128, WukvT + (size_t)l * 1024 * 128, 32, r, lane, scr, MapId{}); continue; } r -= I_UKV;
        tr_item(p.w_out + (size_t)l * 1024 * 1024, 1024, 1024, nullptr, WoutT + (size_t)l * 1024 * 1024, 32, r, lane, scr, MapId{});
    }
    { const int j = (int)(c.gt & 31); const double inv = pow(10000.0, -(double)j / 32.0);
      for (long i = c.gt; i < (long)T * 32; i += c.GT) { const int t = (int)(i >> 5); double s, cc; sincos((double)p.pos[t] * inv, &s, &cc); CS32[i] = make_float2((float)cc, (float)s); } }
    { const int j = (int)(c.gt & 15); const double inv = pow(10000.0, -(double)j / 16.0);
      for (long i = c.gt; i < (long)T * 16; i += c.GT) { const int t = (int)(i >> 4); double s, cc; sincos((double)p.pos[t] * inv, &s, &cc); CS16[i] = make_float2((float)cc, (float)s); } }
}

__device__ __forceinline__ void ph_norm(const Ctx& c, const float* x, const float* nw, const float* ADA_l, bf16_t* H) {
    const int lane = c.lane;
    for (int row = c.gw; row < T; row += c.NGW) {
        const int b = row / S;
        const f32x4* xr = (const f32x4*)(x + (size_t)row * D) + lane;
        f32x4 v[4]; float s = 0.f;
#pragma unroll
        for (int j = 0; j < 4; ++j) { v[j] = xr[64 * j]; s += v[j].x * v[j].x + v[j].y * v[j].y + v[j].z * v[j].z + v[j].w * v[j].w; }
        const float rstd = rsqrtf(wave_sum(s) * (1.f / D) + EPS);
        const float* shift = ADA_l + (size_t)b * 3072; const float* scale = shift + 1024;
        u32x2* o = (u32x2*)(H + (size_t)row * D) + lane;
#pragma unroll
        for (int j = 0; j < 4; ++j) {
            const int c0 = 4 * lane + 256 * j; const f32x4 w = *(const f32x4*)(nw + c0), sc = *(const f32x4*)(scale + c0), sh = *(const f32x4*)(shift + c0);
            f32x4 y;
            y.x = v[j].x * rstd * w.x * (1.f + sc.x) + sh.x; y.y = v[j].y * rstd * w.y * (1.f + sc.y) + sh.y;
            y.z = v[j].z * rstd * w.z * (1.f + sc.z) + sh.z; y.w = v[j].w * rstd * w.w * (1.f + sc.w) + sh.w;
            u32x2 pk; pk.x = pk2(y.x, y.y); pk.y = pk2(y.z, y.w); o[64 * j] = pk;
        }
    }
}

__device__ __forceinline__ void ph_final(const Ctx& c, const float* x, const float* w, float* out) {
    const int lane = c.lane;
    for (int row = c.gw; row < T; row += c.NGW) {
        const f32x4* xr = (const f32x4*)(x + (size_t)row * D) + lane;
        f32x4 v[4]; float s = 0.f;
#pragma unroll
        for (int j = 0; j < 4; ++j) { v[j] = xr[64 * j]; s += v[j].x * v[j].x + v[j].y * v[j].y + v[j].z * v[j].z + v[j].w * v[j].w; }
        const float rstd = rsqrtf(wave_sum(s) * (1.f / D) + EPS);
        f32x4* o = (f32x4*)(out + (size_t)row * D) + lane;
#pragma unroll
        for (int j = 0; j < 4; ++j) { const f32x4 ww = *(const f32x4*)(w + 4 * lane + 256 * j); o[64 * j] = v[j] * rstd * ww; }
    }
}

__device__ __forceinline__ unsigned cvt_pk_bf16(float lo, float hi) { unsigned r; asm volatile("v_cvt_pk_bf16_f32 %0, %1, %2" : "=v"(r) : "v"(lo), "v"(hi)); return r; }
__device__ __forceinline__ u32x4 pack8bf(f32x4 a, f32x4 b) { u32x4 w; w.x = cvt_pk_bf16(a.x, a.y); w.y = cvt_pk_bf16(a.z, a.w); w.z = cvt_pk_bf16(b.x, b.y); w.w = cvt_pk_bf16(b.z, b.w); return w; }
__device__ __forceinline__ float silu_fast(float x) { return x * __builtin_amdgcn_rcpf(1.f + __builtin_amdgcn_exp2f(-1.4426950408889634f * x)); }
__device__ __forceinline__ f32x4 rope4(f32x4 v, f32x4 cs) { f32x4 o; o.x = v.x * cs.x - v.y * cs.y; o.y = v.y * cs.x + v.x * cs.y; o.z = v.z * cs.z - v.w * cs.w; o.w = v.w * cs.z + v.z * cs.w; return o; }
__device__ __forceinline__ f32x4 silu4(f32x4 v) { v.x = silu_fast(v.x); v.y = silu_fast(v.y); v.z = silu_fast(v.z); v.w = silu_fast(v.w); return v; }
struct EpiIn {
    bf16_t* PROJ; float* GG; const float2* CS32; const float2* CS16;
    __device__ __forceinline__ void operator()(int row, int col, f32x4 a, f32x4 b) const {
        if (col < 512) {
            const f32x4* cs = (const f32x4*)(CS32 + (size_t)row * 32 + ((col & 63) >> 1));
            a = rope4(a, cs[0]); b = rope4(b, cs[1]);
            if (col >= 256) { a = a * 0.125f; b = b * 0.125f; }
        } else if (col < 768) {
        } else if (col < 1024) { a = silu4(a); b = silu4(b);
        } else if (col < 1408) {
        } else if (col < 1440) {
            const f32x4* cs = (const f32x4*)(CS16 + (size_t)row * 16 + ((col - 1408) >> 1));
            a = rope4(a, cs[0]); b = rope4(b, cs[1]);
        } else if (col < 1456) { f32x4* g = (f32x4*)(GG + (size_t)row * 16 + (col - 1440)); g[0] = a; g[1] = b; return;
        } else if (col < 1536) { return;
        } else if (col < 2048) { a = silu4(a); b = silu4(b);
        } else if (col < 2176) {
        } else if (col < 2304) { a = a * 0.17677669529663687f; b = b * 0.17677669529663687f;
        } else if (col < 2560) {
        } else { a = silu4(a); b = silu4(b); }
        *(u32x4*)(PROJ + (size_t)row * NP + col) = pack8bf(a, b);
    }
};
struct EpiQ {
    bf16_t* Q; const float* RSQ; const float2* CS16;
    __device__ __forceinline__ void operator()(int row, int col, f32x4 a, f32x4 b) const {
        const float rs = RSQ[row]; a = a * rs; b = b * rs; const int cc = col % 96;
        if (cc >= 64) { const f32x4* cs = (const f32x4*)(CS16 + (size_t)row * 16 + ((cc - 64) >> 1)); a = rope4(a, cs[0]); b = rope4(b, cs[1]); }
        a = a * QSCALE; b = b * QSCALE;
        *(u32x4*)(Q + (size_t)row * 768 + col) = pack8bf(a, b);
    }
};
struct EpiKV {
    bf16_t* KV; const float* RSKV;
    __device__ __forceinline__ void operator()(int row, int col, f32x4 a, f32x4 b) const {
        const float rs = RSKV[row]; a = a * rs; b = b * rs;
        *(u32x4*)(KV + (size_t)row * 1024 + col) = pack8bf(a, b);
    }
};
struct EpiOut {
    const float* xi; float* xo; const float* ADA_l;
    __device__ __forceinline__ void operator()(int row, int col, f32x4 a, f32x4 b) const {
        const int bb = row / S; const f32x4* g = (const f32x4*)(ADA_l + (size_t)bb * 3072 + 2048 + col);
        const f32x4* xv = (const f32x4*)(xi + (size_t)row * D + col); f32x4* o = (f32x4*)(xo + (size_t)row * D + col);
        const f32x4 x0 = xv[0], x1 = xv[1];
        o[0] = x0 + g[0] * a; o[1] = x1 + g[1] * b;
    }
};

namespace pg8 {
#define PG8_LAS __attribute__((address_space(3)))
constexpr int BM = 256, BK = 64, HALF = 128, HTB = HALF * BK * 2  , STAGE_BYTES = 8 * HTB, NXCD = 8, WGM = 8;

__host__ __device__ __forceinline__ int lds_byte(int r, int c) { const int st = (r >> 4) * 2 + (c >> 5), rr = r & 15, cc = c & 31, ob = rr * 64 + cc * 2; return st * 1024 + (ob ^ (((ob >> 9) & 1) << 5)); }
__host__ __device__ __forceinline__ void stage_rc(int b, int& R, int& C) { const int st = b / 1024, sb = b % 1024, swz = sb ^ (((sb >> 9) & 1) << 5); R = (st >> 1) * 16 + swz / 64; C = (st & 1) * 32 + (swz % 64) / 2; }
__host__ __device__ __forceinline__ int perm32(int rho) { const int n = rho >> 4, i = rho & 15; return 8 * (i >> 2) + 4 * n + (i & 3); }

struct Unit { int pm, pn; };
struct Gemm { const bf16_t* A; const bf16_t* Bt; int M, N, K, lda; };

struct StaticOrder {
    int nM, nN, nwg, G, c;
    __host__ __device__ void init(int M, int N, int G_, int c_) { nM = M / BM; nN = N / BM; nwg = nM * nN; G = G_; c = c_; }
    __host__ __device__ bool next(int i, Unit& u) const {
        const long L = (long)i * G + c; if (L >= nwg) return false;
        int wgid = (int)L; { const int q = nwg / NXCD, r = nwg % NXCD, xcd = wgid % NXCD, off = wgid / NXCD; wgid = (xcd < r ? xcd * (q + 1) : r * (q + 1) + (xcd - r) * q) + off; }
        const int nig = WGM * nN, gid = wgid / nig, fm = gid * WGM, gsz = (nM - fm) < WGM ? (nM - fm) : WGM;
        u.pm = fm + ((wgid % nig) % gsz); u.pn = (wgid % nig) / gsz; return true;
    }
    __device__ __forceinline__ void a_ready(const Unit&) const {}
    __device__ __forceinline__ void done(const Unit&) const {}
};

template <class Epi, class Sched, bool ALIGN_EPI = false, bool SP2 = false>
__device__ __forceinline__ void gemm_phase(PG8_LAS unsigned char* lds, const Gemm g, const Sched& S, const Epi& E) {
    int tid_ = threadIdx.x; asm volatile("" : "+v"(tid_));
    const int tid = tid_, wid = __builtin_amdgcn_readfirstlane(tid >> 6), lane = tid & 63, wr = wid >> 2, wc = wid & 3, fr = lane & 15, fq = lane >> 4;
    const int K = g.K, nt = K / BK;
    unsigned voffA[2], voffB[2];
#pragma unroll
    for (int i = 0; i < 2; ++i) { int R, C; stage_rc(tid * 16 + i * 8192, R, C); const int Rb = Epi::PERM ? ((R & ~31) + perm32(R & 31)) : R;
        voffA[i] = (unsigned)(R * g.lda + C) * 2u; voffB[i] = (unsigned)(Rb * K + C) * 2u; }
    const size_t kstep = (size_t)(BK * 2);
    const size_t hstep = (size_t)HALF * K * 2;
    const size_t tstep = 2 * hstep; const size_t hstepA = (size_t)HALF * g.lda * 2, tstepA = 2 * hstepA;
    const unsigned ldsw = (unsigned)wid * 1024u;
    const int aoff = lds_byte(wr * 64 + fr, fq * 8), boff = lds_byte(wc * 32 + fr, fq * 8);
#define PG8_SA(b, h) (((b) * 2 + (h)) * HTB)
#define PG8_SB(b, h) ((4 + (b) * 2 + (h)) * HTB)
#define PG8_STAGE(bufoff, gbase, voff) do { _Pragma("unroll") for (int _i = 0; _i < 2; ++_i) \
        __builtin_amdgcn_global_load_lds((const unsigned*)((const char*)(gbase) + (voff)[_i]), (PG8_LAS unsigned*)(lds + (bufoff) + ldsw + _i * 8192), 16, 0, 0); } while (0)
#define PG8_LDA(dst, b, h) do { _Pragma("unroll") for (int m = 0; m < 4; ++m) _Pragma("unroll") for (int k = 0; k < 2; ++k) dst[m][k] = *(const PG8_LAS bf16x8*)(lds + PG8_SA(b, h) + aoff + m * 2048 + k * 1024); } while (0)
#define PG8_LDB(dst, b, h) do { _Pragma("unroll") for (int n = 0; n < 2; ++n) _Pragma("unroll") for (int k = 0; k < 2; ++k) dst[n][k] = *(const PG8_LAS bf16x8*)(lds + PG8_SB(b, h) + boff + n * 2048 + k * 1024); } while (0)
#define PG8_MMA(ai, bj, At, Bt) do { __builtin_amdgcn_s_setprio(1); _Pragma("unroll") for (int m = 0; m < 4; ++m) _Pragma("unroll") for (int n = 0; n < 2; ++n) _Pragma("unroll") for (int k = 0; k < 2; ++k) \
        acc[ai][bj][m][n] = __builtin_amdgcn_mfma_f32_16x16x32_bf16(Bt[n][k], At[m][k], acc[ai][bj][m][n], 0, 0, 0); __builtin_amdgcn_s_setprio(0); } while (0)
#define PG8_WAIT_V(n) asm volatile("s_waitcnt vmcnt(" #n ")" ::: "memory")
#define PG8_WAIT_L(n) asm volatile("s_waitcnt lgkmcnt(" #n ")" ::: "memory")
#define PG8_BAR __builtin_amdgcn_s_barrier()
#define PG8_SCHED __builtin_amdgcn_sched_barrier(0)
    Unit cur, nxt; int ui = 0;
    if (!S.next(0, cur)) return;
    f32x4 acc[2][2][4][2];
#pragma unroll
    for (int a = 0; a < 2; ++a)
#pragma unroll
        for (int b = 0; b < 2; ++b)
#pragma unroll
            for (int m = 0; m < 4; ++m)
#pragma unroll
                for (int n = 0; n < 2; ++n) acc[a][b][m][n] = (f32x4){0.f, 0.f, 0.f, 0.f};
    bf16x8 At[4][2], B0[2][2], B1[2][2];
    const char* cA = (const char*)g.A + (size_t)cur.pm * tstepA; const char* cB = (const char*)g.Bt + (size_t)cur.pn * tstep;
    S.a_ready(cur);
    if constexpr (SP2) {
        PG8_STAGE(PG8_SB(0, 0), cB, voffB); PG8_STAGE(PG8_SB(0, 1), cB + hstep, voffB); PG8_STAGE(PG8_SA(0, 0), cA, voffA); PG8_STAGE(PG8_SA(0, 1), cA + hstepA, voffA);
        if (wr == 1) PG8_BAR;
        PG8_WAIT_V(2); PG8_BAR;
        PG8_STAGE(PG8_SB(1, 0), cB + kstep, voffB); PG8_STAGE(PG8_SA(1, 0), cA + kstep, voffA); PG8_STAGE(PG8_SB(1, 1), cB + hstep + kstep, voffB);
        PG8_WAIT_V(6); PG8_BAR;
    } else {
        PG8_STAGE(PG8_SB(0, 0), cB, voffB); PG8_STAGE(PG8_SA(0, 0), cA, voffA); PG8_STAGE(PG8_SB(0, 1), cB + hstep, voffB); PG8_STAGE(PG8_SA(0, 1), cA + hstepA, voffA);
        if (wr == 1) PG8_BAR;
        PG8_WAIT_V(4); PG8_BAR;
        PG8_STAGE(PG8_SB(1, 0), cB + kstep, voffB); PG8_STAGE(PG8_SA(1, 0), cA + kstep, voffA); PG8_STAGE(PG8_SB(1, 1), cB + hstep + kstep, voffB);
        PG8_WAIT_V(6); PG8_BAR;
    }
    for (;;) {
        const bool has_next = S.next(ui + 1, nxt);
        const char* nA = has_next ? (const char*)g.A + (size_t)nxt.pm * tstepA : cA; const char* nB = has_next ? (const char*)g.Bt + (size_t)nxt.pn * tstep : cB;
        for (int t = 0; t < nt; t += 2) {
            const bool last = (t == nt - 2);
            const char* a1 = cA + (size_t)(t + 1) * kstep;
            const char* a2 = last ? nA : cA + (size_t)(t + 2) * kstep; const char* b2 = last ? nB : cB + (size_t)(t + 2) * kstep;
            const char* a3 = a2 + kstep; const char* b3 = b2 + kstep;
            if (last && has_next) S.a_ready(nxt);
            if constexpr (SP2) {
            PG8_LDB(B0, 0, 0); PG8_LDB(B1, 0, 1); PG8_SCHED; PG8_LDA(At, 0, 0); PG8_STAGE(PG8_SA(1, 1), a1 + hstepA, voffA);
            PG8_WAIT_V(8); PG8_WAIT_L(0); PG8_BAR; PG8_MMA(0, 0, At, B0); PG8_MMA(0, 1, At, B1); PG8_BAR; PG8_SCHED;
            PG8_LDA(At, 0, 1); PG8_STAGE(PG8_SB(0, 0), b2, voffB); PG8_STAGE(PG8_SB(0, 1), b2 + hstep, voffB); PG8_STAGE(PG8_SA(0, 0), a2, voffA);
            PG8_WAIT_V(8); PG8_WAIT_L(0); PG8_BAR; PG8_MMA(1, 0, At, B0); PG8_MMA(1, 1, At, B1); PG8_BAR; PG8_SCHED;
            PG8_LDB(B0, 1, 0); PG8_LDB(B1, 1, 1); PG8_SCHED; PG8_LDA(At, 1, 0); PG8_STAGE(PG8_SA(0, 1), a2 + hstepA, voffA);
            PG8_WAIT_V(8); PG8_WAIT_L(0); PG8_BAR; PG8_MMA(0, 0, At, B0); PG8_MMA(0, 1, At, B1); PG8_BAR; PG8_SCHED;
            PG8_LDA(At, 1, 1); PG8_STAGE(PG8_SB(1, 0), b3, voffB); PG8_STAGE(PG8_SB(1, 1), b3 + hstep, voffB); PG8_STAGE(PG8_SA(1, 0), a3, voffA);
            PG8_WAIT_V(8); PG8_WAIT_L(0); PG8_BAR; PG8_MMA(1, 0, At, B0); PG8_MMA(1, 1, At, B1); PG8_BAR; PG8_SCHED;
            } else {
            PG8_LDB(B0, 0, 0); PG8_SCHED; PG8_LDA(At, 0, 0); PG8_STAGE(PG8_SA(1, 1), a1 + hstepA, voffA);
            PG8_WAIT_L(8); PG8_BAR; PG8_WAIT_L(0); PG8_MMA(0, 0, At, B0); PG8_BAR; PG8_SCHED;
            PG8_LDB(B1, 0, 1); PG8_STAGE(PG8_SB(0, 0), b2, voffB);
            PG8_BAR; PG8_WAIT_L(0); PG8_MMA(0, 1, At, B1); PG8_BAR;
            PG8_LDA(At, 0, 1); PG8_STAGE(PG8_SA(0, 0), a2, voffA);
            PG8_BAR; PG8_WAIT_L(0); PG8_MMA(1, 0, At, B0); PG8_BAR; PG8_SCHED;
            PG8_STAGE(PG8_SB(0, 1), b2 + hstep, voffB);
            PG8_WAIT_V(6); PG8_BAR; PG8_MMA(1, 1, At, B1); PG8_BAR;
            PG8_LDB(B0, 1, 0); PG8_SCHED; PG8_LDA(At, 1, 0); PG8_STAGE(PG8_SA(0, 1), a2 + hstepA, voffA);
            PG8_WAIT_L(8); PG8_BAR; PG8_WAIT_L(0); PG8_MMA(0, 0, At, B0); PG8_BAR; PG8_SCHED;
            PG8_LDB(B1, 1, 1); PG8_STAGE(PG8_SB(1, 0), b3, voffB);
            PG8_BAR; PG8_WAIT_L(0); PG8_MMA(0, 1, At, B1); PG8_BAR;
            PG8_LDA(At, 1, 1); PG8_STAGE(PG8_SA(1, 0), a3, voffA);
            PG8_BAR; PG8_WAIT_L(0); PG8_MMA(1, 0, At, B0); PG8_BAR; PG8_SCHED;
            PG8_STAGE(PG8_SB(1, 1), b3 + hstep, voffB);
            PG8_WAIT_V(6); PG8_BAR; PG8_MMA(1, 1, At, B1); PG8_BAR;
            }
        }
        if constexpr (ALIGN_EPI) { if (wr == 0) PG8_BAR; }
        if constexpr (!Epi::AFTER_DRAIN) { E(acc, cur, wr, wc, fr, fq); S.done(cur); }
        if (!has_next) break;
#pragma unroll
        for (int a = 0; a < 2; ++a)
#pragma unroll
            for (int b = 0; b < 2; ++b)
#pragma unroll
                for (int m = 0; m < 4; ++m)
#pragma unroll
                    for (int n = 0; n < 2; ++n) acc[a][b][m][n] = (f32x4){0.f, 0.f, 0.f, 0.f};
        cur = nxt; cA = nA; cB = nB; ++ui;
        if constexpr (ALIGN_EPI) { if (wr == 1) PG8_BAR; }
    }
    PG8_WAIT_V(0);
    if constexpr (!ALIGN_EPI) { if (wr == 0) PG8_BAR; }
    PG8_BAR;
    if constexpr (Epi::AFTER_DRAIN) { E.fused(acc, cur, wr, wc, fr, fq, lds, wid, lane); S.done(cur); }
#undef PG8_SA
#undef PG8_SB
#undef PG8_STAGE
#undef PG8_LDA
#undef PG8_LDB
#undef PG8_MMA
#undef PG8_WAIT_V
#undef PG8_WAIT_L
#undef PG8_BAR
#undef PG8_SCHED
}
}

template <class E> struct EpiAd {
    static constexpr bool PERM = true, AFTER_DRAIN = false;
    E e;
    __device__ __forceinline__ void operator()(const f32x4 (&acc)[2][2][4][2], const pg8::Unit& u, int wr, int wc, int fr, int fq) const {
#pragma unroll
        for (int ai = 0; ai < 2; ++ai)
#pragma unroll
            for (int m = 0; m < 4; ++m) {
                const int row = u.pm * 256 + ai * 128 + wr * 64 + m * 16 + fr;
#pragma unroll
                for (int bj = 0; bj < 2; ++bj) e(row, u.pn * 256 + bj * 128 + wc * 32 + 8 * fq, acc[ai][bj][m][0], acc[ai][bj][m][1]);
            }
    }
};
template <class E> __device__ __forceinline__ void run_gemm(PG8_LAS unsigned char* lds, const bf16_t* A, int lda, const bf16_t* Bt, int M, int N, int K, const E& e) {
    int Ko = K; asm volatile("" : "+s"(Ko));
    pg8::Gemm g{A, Bt, M, N, Ko, lda}; pg8::StaticOrder S; S.init(M, N, (int)gridDim.x, (int)blockIdx.x);
    EpiAd<E> ad{e};
    pg8::gemm_phase<EpiAd<E>, pg8::StaticOrder, true, true>(lds, g, S, ad);
}

template <class Epi>
__device__ __forceinline__ void gemm_wave(const Ctx& c, const bf16_t* A, int lda, const bf16_t* Bt, int M, int N, int K, const Epi& epi) {
    const int fr = c.lane & 15, fq = c.lane >> 4; const int ntn = N / 64, nt = (M / 32) * ntn;
    for (int tile = c.gw; tile < nt; tile += c.NGW) {
        const int m0 = (tile / ntn) * 32, n0 = (tile % ntn) * 64;
        f32x4 acc[2][4];
#pragma unroll
        for (int i = 0; i < 2; ++i)
#pragma unroll
            for (int j = 0; j < 4; ++j) acc[i][j] = (f32x4){0.f, 0.f, 0.f, 0.f};
        const bf16_t* ap = A + (size_t)(m0 + fr) * lda + fq * 8; const bf16_t* bp = Bt + (size_t)(n0 + fr) * K + fq * 8;
        for (int k0 = 0; k0 < K; k0 += 32) {
            bf16x8 a[2], b[4];
#pragma unroll
            for (int i = 0; i < 2; ++i) a[i] = *(const bf16x8*)(ap + (size_t)(16 * i) * lda + k0);
#pragma unroll
            for (int j = 0; j < 4; ++j) b[j] = *(const bf16x8*)(bp + (size_t)(16 * j) * K + k0);
#pragma unroll
            for (int i = 0; i < 2; ++i)
#pragma unroll
                for (int j = 0; j < 4; ++j) acc[i][j] = __builtin_amdgcn_mfma_f32_16x16x32_bf16(b[j], a[i], acc[i][j], 0, 0, 0);
        }
#pragma unroll
        for (int i = 0; i < 2; ++i)
#pragma unroll
            for (int j = 0; j < 4; ++j) epi(m0 + 16 * i + fr, n0 + 16 * j + 4 * fq, acc[i][j]);
    }
}

__device__ __forceinline__ void ph_rstd(const Ctx& c, const bf16_t* PROJ, float* RSQ, float* RSKV) {
    const int lane = c.lane;
    for (int row = c.gw; row < T; row += c.NGW) {
        const bf16_t* p = PROJ + (size_t)row * NP;
        float s = 0.f;
#pragma unroll
        for (int j = 0; j < 4; ++j) { const float v = bf2f(p[P_MQ + lane + 64 * j]); s += v * v; }
        s = wave_sum(s);
        float s2 = 0.f;
#pragma unroll
        for (int j = 0; j < 2; ++j) { const float v = bf2f(p[P_MKV + lane + 64 * j]); s2 += v * v; }
        s2 = wave_sum(s2);
        if (lane == 0) { RSQ[row] = rsqrtf(s * (1.f / 256.f) + EPS); RSKV[row] = rsqrtf(s2 * (1.f / 128.f) + EPS); }
    }
}

__device__ __forceinline__ void ph_attn_naive(const Ctx& c, const bf16_t* Q, const bf16_t* KV, const bf16_t* PROJ, bf16_t* MIX) {
    const int lane = c.lane;
    for (int W = c.gw; W < (T / 64) * 16; W += c.NGW) {
        const int cgk = W >> 4, h = (W >> 1) & 7, vh = W & 1; const int t = cgk * 64 + lane; const int b = (cgk * 64) / S; const int nk = ((cgk * 64) % S) + 64; const int kb = b * S;
        float q[96];
        const bf16_t* qp = Q + (size_t)t * 768 + h * 96;
#pragma unroll
        for (int d = 0; d < 96; ++d) q[d] = bf2f(qp[d]);
        float o[32];
#pragma unroll
        for (int e = 0; e < 32; ++e) o[e] = 0.f;
        float m = -1e30f, l = 0.f;
        for (int j = 0; j < nk; ++j) {
            const bf16_t* kn = KV + (size_t)(kb + j) * 1024 + h * 128; const bf16_t* kp = PROJ + (size_t)(kb + j) * NP + P_KPE;
            float s = 0.f;
#pragma unroll
            for (int d = 0; d < 64; ++d) s = fmaf(q[d], bf2f(kn[d]), s);
#pragma unroll
            for (int d = 0; d < 32; ++d) s = fmaf(q[64 + d], bf2f(kp[d]), s);
            const float mn = fmaxf(m, s); const float sc = exp2f(m - mn), pp = exp2f(s - mn); m = mn; l = l * sc + pp;
#pragma unroll
            for (int e = 0; e < 32; ++e) o[e] = o[e] * sc + pp * bf2f(kn[64 + vh * 32 + e]);
        }
        const float rl = 1.f / l;
        const bf16_t* z = PROJ + (size_t)t * NP + P_MZ + h * 64 + vh * 32; bf16_t* mo = MIX + (size_t)t * 1024 + 256 + h * 64 + vh * 32;
#pragma unroll
        for (int e = 0; e < 32; ++e) mo[e] = (bf16_t)f2bf(o[e] * rl * bf2f(z[e]));
    }
}

__device__ __forceinline__ void ph_ret_naive(const Ctx& c, const bf16_t* PROJ, bf16_t* MIX) {
    const int lane = c.lane;
    for (int W = c.gw; W < (T / 64) * 4; W += c.NGW) {
        const int cgk = W >> 2, h = W & 3; const int t = cgk * 64 + lane; const int b = (cgk * 64) / S; const int nk = ((cgk * 64) % S) + 64; const int kb = b * S;
        const float lg = log1pf(-exp2f(-5.f - (float)h));
        float q[64];
        const bf16_t* qp = PROJ + (size_t)t * NP + P_RQ + h * 64;
#pragma unroll
        for (int d = 0; d < 64; ++d) q[d] = bf2f(qp[d]);
        float o[64];
#pragma unroll
        for (int e = 0; e < 64; ++e) o[e] = 0.f;
        const int ti = t - kb;
        for (int j = 0; j < nk; ++j) {
            const bf16_t* kr = PROJ + (size_t)(kb + j) * NP + P_RK + h * 64; const bf16_t* vr = PROJ + (size_t)(kb + j) * NP + P_RV + h * 64;
            float s = 0.f;
#pragma unroll
            for (int d = 0; d < 64; ++d) s = fmaf(q[d], bf2f(kr[d]), s);
            const int dd = ti - j; s *= __expf(lg * (float)(dd < 0 ? -dd : dd));
#pragma unroll
            for (int e = 0; e < 64; ++e) o[e] = fmaf(s, bf2f(vr[e]), o[e]);
        }
        float ss = 0.f;
#pragma unroll
        for (int e = 0; e < 64; ++e) ss += o[e] * o[e];
        const float rstd = rsqrtf(ss * (1.f / 64.f) + EPS);
        const bf16_t* z = PROJ + (size_t)t * NP + P_RZ + h * 64; bf16_t* mo = MIX + (size_t)t * 1024 + h * 64;
#pragma unroll
        for (int e = 0; e < 64; ++e) mo[e] = (bf16_t)f2bf(o[e] * rstd * bf2f(z[e]));
    }
}

__device__ __forceinline__ void ph_gla_la(const Ctx& c, const float* GG, const float* w_g2, const float* b_g2, float* G) {
    for (long i = c.gt; i < (long)T * 128; i += c.GT) {
        const int n = (int)(i & 127); const long t = i >> 7;
        float z = b_g2[n];
#pragma unroll
        for (int r = 0; r < 16; ++r) z = fmaf(GG[t * 16 + r], w_g2[r * 128 + n], z);
        const float ls = fminf(z, 0.f) - log1pf(__expf(-fabsf(z)));
        G[i] = ls * (1.f / 16.f);
    }
}
__device__ __forceinline__ void ph_gla_cum(const Ctx& c, float* G) {
    if (c.gt < NB * 128) {
        const int b = (int)(c.gt >> 7), n = (int)(c.gt & 127); float acc = 0.f;
        for (int s = 0; s < S; ++s) { const size_t i = ((size_t)b * S + s) * 128 + n; acc += G[i]; G[i] = acc; }
    }
}
__device__ __forceinline__ void ph_gla_naive(const Ctx& c, const bf16_t* PROJ, const float* G, const float* gnw, bf16_t* MIX, float* ldsf) {
    const int lane = c.lane;
    for (int W = c.gw; W < (T / 64) * 4; W += c.NGW) {
        const int cgk = W >> 2, h = W & 3; const int t = cgk * 64 + lane; const int b = (cgk * 64) / S; const int nk = ((cgk * 64) % S) + 64; const int kb = b * S;
        float q[32], gi[32];
        const bf16_t* qp = PROJ + (size_t)t * NP + P_GQ + h * 32;
#pragma unroll
        for (int d = 0; d < 32; ++d) { q[d] = bf2f(qp[d]); gi[d] = G[(size_t)t * 128 + h * 32 + d]; }
        float ss = 0.f; float o[32];
        float* o0 = ldsf + c.wave * 2048 + lane;
#pragma unroll 1
        for (int vh = 0; vh < 2; ++vh) {
#pragma unroll
            for (int e = 0; e < 32; ++e) o[e] = 0.f;
            for (int j = 0; j < nk; ++j) {
                const bf16_t* kr = PROJ + (size_t)(kb + j) * NP + P_GK + h * 32; const bf16_t* vr = PROJ + (size_t)(kb + j) * NP + P_GV + h * 64 + vh * 32;
                const float* gj = G + (size_t)(kb + j) * 128 + h * 32;
                float s = 0.f;
#pragma unroll
                for (int d = 0; d < 32; ++d) s = fmaf(q[d] * bf2f(kr[d]), __expf(-fabsf(gi[d] - gj[d])), s);
#pragma unroll
                for (int e = 0; e < 32; ++e) o[e] = fmaf(s, bf2f(vr[e]), o[e]);
            }
#pragma unroll
            for (int e = 0; e < 32; ++e) ss += o[e] * o[e];
            if (vh == 0) {
#pragma unroll
                for (int e = 0; e < 32; ++e) o0[e * 64] = o[e];
            }
        }
        const float rstd = rsqrtf(ss * (1.f / 64.f) + EPS);
        const bf16_t* z = PROJ + (size_t)t * NP + P_GZ + h * 64; bf16_t* mo = MIX + (size_t)t * 1024 + 768 + h * 64;
#pragma unroll
        for (int e = 0; e < 32; ++e) mo[e] = (bf16_t)f2bf(o0[e * 64] * rstd * gnw[e] * bf2f(z[e]));
#pragma unroll
        for (int e = 0; e < 32; ++e) mo[32 + e] = (bf16_t)f2bf(o[e] * rstd * gnw[32 + e] * bf2f(z[32 + e]));
    }
}

namespace att {
typedef short s16x4 __attribute__((ext_vector_type(4)));
typedef float f32x16 __attribute__((ext_vector_type(16)));
constexpr int KROW = 208, SHM_K = 64 * KROW, SHM_V = 64 * 64 * 2;
constexpr int L_K = 0, L_V = 2 * SHM_K, L_WS = L_V + 2 * SHM_V, L_END = L_WS + 8 * 64 * 4;
constexpr float THR = 4.f;
#define ASBAR() __builtin_amdgcn_sched_barrier(0)
__device__ __forceinline__ int crow(int r, int hi) { return (r & 3) + 8 * (r >> 2) + 4 * hi; }
__device__ __forceinline__ unsigned cvtpk(float lo, float hi) { unsigned r; asm volatile("v_cvt_pk_bf16_f32 %0, %1, %2" : "=v"(r) : "v"(lo), "v"(hi)); return r; }

__device__ __forceinline__ void partialSM(f32x16& p0, f32x16& p1, float& m_reg, float& mn, float& alpha) {
  float pmax = p0[0];
#pragma unroll
  for (int r = 1; r < 16; ++r) pmax = fmaxf(pmax, p0[r]);
#pragma unroll
  for (int r = 0; r < 16; ++r) pmax = fmaxf(pmax, p1[r]);
  { auto rr = __builtin_amdgcn_permlane32_swap(__float_as_uint(pmax), __float_as_uint(pmax), false, false);
    pmax = fmaxf(__uint_as_float(rr[0]), __uint_as_float(rr[1])); }
  if (__builtin_expect(__all(pmax - m_reg <= THR), 1)) { mn = m_reg; alpha = 1.f; }
  else { mn = fmaxf(m_reg, pmax); alpha = __builtin_amdgcn_exp2f(m_reg - mn); m_reg = mn; }
#pragma unroll
  for (int r = 0; r < 16; ++r) p0[r] = p0[r] - mn;
#pragma unroll
  for (int r = 0; r < 16; ++r) p1[r] = p1[r] - mn;
#pragma unroll
  for (int r = 0; r < 16; ++r) p0[r] = __builtin_amdgcn_exp2f(p0[r]);
}
__device__ __forceinline__ void finishSM(f32x16& p0, f32x16& p1, float alpha, float& l_reg, bf16x8& pa0, bf16x8& pa1, bf16x8& pa2, bf16x8& pa3) {
#pragma unroll
  for (int r = 0; r < 16; ++r) p1[r] = __builtin_amdgcn_exp2f(p1[r]);
  float ps = 0;
#pragma unroll
  for (int r = 0; r < 16; ++r) ps += p0[r];
#pragma unroll
  for (int r = 0; r < 16; ++r) ps += p1[r];
  { auto rr = __builtin_amdgcn_permlane32_swap(__float_as_uint(ps), __float_as_uint(ps), false, false);
    ps = __uint_as_float(rr[0]) + __uint_as_float(rr[1]); }
  l_reg = l_reg * alpha + ps;
#define PK4(P, BASE, OUT) do { unsigned a0 = cvtpk(P[BASE + 0], P[BASE + 1]), a1 = cvtpk(P[BASE + 2], P[BASE + 3]);   \
    unsigned b0 = cvtpk(P[BASE + 4], P[BASE + 5]), b1 = cvtpk(P[BASE + 6], P[BASE + 7]);                              \
    auto r0 = __builtin_amdgcn_permlane32_swap(a0, b0, false, false); auto r1 = __builtin_amdgcn_permlane32_swap(a1, b1, false, false); \
    u32x4 w = {r0[0], r1[0], r0[1], r1[1]}; OUT = *reinterpret_cast<bf16x8*>(&w); } while (0)
  PK4(p0, 0, pa0); PK4(p0, 8, pa1); PK4(p1, 0, pa2); PK4(p1, 8, pa3);
#undef PK4
}
__device__ __forceinline__ void qkt(f32x16& p0, f32x16& p1, const char* Ks, const bf16x8* qr, int r32, int hi) {
  p0 = f32x16{}; p1 = f32x16{};
  const char* kb = Ks + r32 * KROW + hi * 16;
#pragma unroll
  for (int d0 = 0; d0 < 6; ++d0) {
    bf16x8 b0 = *reinterpret_cast<const bf16x8*>(kb + d0 * 32);
    bf16x8 b1 = *reinterpret_cast<const bf16x8*>(kb + 32 * KROW + d0 * 32);
    p0 = __builtin_amdgcn_mfma_f32_32x32x16_bf16(b0, qr[d0], p0, 0, 0, 0);
    p1 = __builtin_amdgcn_mfma_f32_32x32x16_bf16(b1, qr[d0], p1, 0, 0, 0); }
}
__device__ __forceinline__ int v_st(int k, int c) { const int kk = (k & ~0xC) | ((k & 4) << 1) | ((k & 8) >> 1); return ((kk >> 3) * 2 + (c >> 5)) * 512 + ((kk & 7) * 32 + (c & 31)) * 2; }
__device__ __forceinline__ int v_rd_base(int lane) { return ((lane & 3) << 3) | (((lane >> 2) & 3) << 6) | (((lane >> 4) & 1) << 5) | (((lane >> 5) & 1) << 8); }
constexpr int v_rd_off(int d0, int ks, int half) { return d0 * 512 + ks * 2048 + half * 1024; }
template <int OFF> __device__ __forceinline__ s16x4 tr_read(int vb) {
  s16x4 r; asm volatile("ds_read_b64_tr_b16 %0, %1 offset:%2" : "=&v"(r) : "v"(vb), "i"(OFF) : "memory"); return r;
}
template <int D0> __device__ __forceinline__ void pv_one(f32x16& od, int vb, bf16x8 pa0, bf16x8 pa1, bf16x8 pa2, bf16x8 pa3) {
  const s16x4 l0 = tr_read<v_rd_off(D0, 0, 0)>(vb), h0 = tr_read<v_rd_off(D0, 0, 1)>(vb), l1 = tr_read<v_rd_off(D0, 1, 0)>(vb), h1 = tr_read<v_rd_off(D0, 1, 1)>(vb);
  const s16x4 l2 = tr_read<v_rd_off(D0, 2, 0)>(vb), h2 = tr_read<v_rd_off(D0, 2, 1)>(vb), l3 = tr_read<v_rd_off(D0, 3, 0)>(vb), h3 = tr_read<v_rd_off(D0, 3, 1)>(vb);
  asm volatile("s_waitcnt lgkmcnt(0)" ::: "memory"); ASBAR();
#define PK(L, H) (bf16x8){L[0], L[1], L[2], L[3], H[0], H[1], H[2], H[3]}
  od = __builtin_amdgcn_mfma_f32_32x32x16_bf16(pa0, PK(l0, h0), od, 0, 0, 0);
  od = __builtin_amdgcn_mfma_f32_32x32x16_bf16(pa1, PK(l1, h1), od, 0, 0, 0);
  od = __builtin_amdgcn_mfma_f32_32x32x16_bf16(pa2, PK(l2, h2), od, 0, 0, 0);
  od = __builtin_amdgcn_mfma_f32_32x32x16_bf16(pa3, PK(l3, h3), od, 0, 0, 0);
#undef PK
}
__device__ __forceinline__ void pv_d0(f32x16* o, int vb, bf16x8 pa0, bf16x8 pa1, bf16x8 pa2, bf16x8 pa3) {
  pv_one<0>(o[0], vb, pa0, pa1, pa2, pa3); pv_one<1>(o[1], vb, pa0, pa1, pa2, pa3);
}

__device__ __forceinline__ void attn_unit(const bf16_t* __restrict__ Q, const bf16_t* __restrict__ KV, const bf16_t* __restrict__ PROJ, bf16_t* __restrict__ MIX,
                                          int h, int tq0, int kb0, int NT, char* lds) {
  int tid_ = threadIdx.x; asm volatile("" : "+v"(tid_));
  const int tid = tid_, wid = __builtin_amdgcn_readfirstlane(tid >> 6), lane = tid & 63, r32 = lane & 31, hi = lane >> 5;
  char* V_lds = lds + L_V; char* K_lds = lds + L_K;
  float* ws = (float*)(lds + L_WS) + wid * 64; float* li_l = ws; float* al_l = ws + 32;
  const int tmax = NT - 4 + (wid >> 1);
  float m_reg = -1e30f, l_reg = 0; f32x16 o[2] = {}; bf16x8 qr[6];
  const bf16_t* Qw = Q + (size_t)(tq0 + wid * 32 + r32) * 768 + h * 96 + hi * 8;
#pragma unroll
  for (int d0 = 0; d0 < 6; ++d0) qr[d0] = *reinterpret_cast<const bf16x8*>(Qw + d0 * 16);
  const int srow = tid >> 3, sch = tid & 7, prow = (tid & 255) >> 2, pch = tid & 3;
  const bf16_t* Kn = KV + (size_t)(kb0 + srow) * 1024 + h * 128 + sch * 8;
  const bf16_t* Kp = PROJ + (size_t)(kb0 + prow) * NP + P_KPE + pch * 8;
  const int kst = srow * KROW + sch * 16, pst = prow * KROW + 128 + pch * 16, vst = v_st(srow, sch * 8);
  const int vb0 = (int)(uintptr_t)V_lds + v_rd_base(lane);
  struct { bf16x8 kn, vv, kp; } sr_[2];
#define SLOAD(i, k0) do { sr_[i].kn = *reinterpret_cast<const bf16x8*>(Kn + (size_t)(k0) * 1024); sr_[i].vv = *reinterpret_cast<const bf16x8*>(Kn + (size_t)(k0) * 1024 + 64); \
    sr_[i].kp = *reinterpret_cast<const bf16x8*>(Kp + (size_t)(k0) * NP); } while (0)
#define SWRITE(b, i) do { *(bf16x8*)(K_lds + (b) * SHM_K + kst) = sr_[i].kn; *(bf16x8*)(K_lds + (b) * SHM_K + pst) = sr_[i].kp; *(bf16x8*)(V_lds + (b) * SHM_V + vst) = sr_[i].vv; } while (0)
#define SWAIT() asm volatile("s_waitcnt vmcnt(3)" ::: "memory")
#define RESC(a) do { if (__any((a) < 1.f)) { if (hi == 0) al_l[r32] = (a); asm volatile("s_waitcnt lgkmcnt(0)" ::: "memory"); \
    _Pragma("unroll") for (int d = 0; d < 2; ++d) _Pragma("unroll") for (int r = 0; r < 16; ++r) o[d][r] *= al_l[crow(r, hi)]; } } while (0)
#define MASKT(P0, P1, tt) do { if ((tt) > tmax) { _Pragma("unroll") for (int r = 0; r < 16; ++r) { P0[r] = -1e30f; P1[r] = -1e30f; } } } while (0)
  f32x16 pA0, pA1, pB0, pB1; float mnA, mnB, alA, alB; bf16x8 pa0, pa1, pa2, pa3;
  constexpr int SE = 0, SO = 1;
  SLOAD(SE, 0); asm volatile("s_waitcnt vmcnt(0)" ::: "memory"); SWRITE(0, SE); __syncthreads();
  qkt(pA0, pA1, K_lds, qr, r32, hi); partialSM(pA0, pA1, m_reg, mnA, alA);
  SLOAD(SO, 64); if (2 < NT) SLOAD(SE, 2 * 64);
  SWAIT(); SWRITE(1, SO); __syncthreads();
  for (int j = 1; j + 1 < NT; j += 2) {
    ASBAR(); qkt(pB0, pB1, K_lds + SHM_K, qr, r32, hi); MASKT(pB0, pB1, j);
    finishSM(pA0, pA1, alA, l_reg, pa0, pa1, pa2, pa3); ASBAR();
    SLOAD(SO, (j + 2) * 64); ASBAR();
    pv_d0(o, vb0, pa0, pa1, pa2, pa3); partialSM(pB0, pB1, m_reg, mnB, alB);
    __syncthreads(); SWAIT(); SWRITE(0, SE);
    RESC(alB); __syncthreads();
    ASBAR(); qkt(pA0, pA1, K_lds, qr, r32, hi); MASKT(pA0, pA1, j + 1);
    finishSM(pB0, pB1, alB, l_reg, pa0, pa1, pa2, pa3); ASBAR();
    if (j + 3 < NT) SLOAD(SE, (j + 3) * 64); ASBAR();
    pv_d0(o, vb0 + SHM_V, pa0, pa1, pa2, pa3); partialSM(pA0, pA1, m_reg, mnA, alA);
    __syncthreads(); SWAIT(); SWRITE(1, SO);
    RESC(alA); __syncthreads();
  }
  ASBAR(); qkt(pB0, pB1, K_lds + SHM_K, qr, r32, hi); MASKT(pB0, pB1, NT - 1);
  finishSM(pA0, pA1, alA, l_reg, pa0, pa1, pa2, pa3); ASBAR();
  pv_d0(o, vb0, pa0, pa1, pa2, pa3); partialSM(pB0, pB1, m_reg, mnB, alB);
  __syncthreads(); RESC(alB);
  finishSM(pB0, pB1, alB, l_reg, pa0, pa1, pa2, pa3); ASBAR();
  pv_d0(o, vb0 + SHM_V, pa0, pa1, pa2, pa3);
  if (hi == 0) li_l[r32] = l_reg; asm volatile("s_waitcnt lgkmcnt(0)" ::: "memory");
  float rli[16];
#pragma unroll
  for (int r = 0; r < 16; ++r) rli[r] = __builtin_amdgcn_rcpf(li_l[crow(r, hi)]);
#pragma unroll
  for (int r = 0; r < 16; ++r) { const size_t t = (size_t)(tq0 + wid * 32 + crow(r, hi));
#pragma unroll
    for (int d0 = 0; d0 < 2; ++d0) { const int col = h * 64 + d0 * 32 + r32;
      MIX[t * 1024 + 256 + col] = (bf16_t)f2bf(o[d0][r] * rli[r] * bf2f(PROJ[t * NP + P_MZ + col])); } }
#undef SLOAD
#undef SWRITE
#undef SWAIT
#undef RESC
#undef MASKT
}
__device__ __forceinline__ void attn_phase(const bf16_t* Q, const bf16_t* KV, const bf16_t* PROJ, bf16_t* MIX, char* lds) {
  const int G = gridDim.x, bx = blockIdx.x; const int v = (G % 8 == 0) ? (bx % 8) * (G / 8) + bx / 8 : bx;
  for (int bh = v; bh < NB * 8; bh += G) {
    const int b = bh >> 3, h = bh & 7;
    for (int qb = 0; qb < S / 256; ++qb) attn_unit(Q, KV, PROJ, MIX, h, b * S + qb * 256, b * S, 4 * (qb + 1), lds);
  }
}
#undef ASBAR
}

namespace chain {
#define LDS3 __attribute__((address_space(3)))
typedef short v4i16_t __attribute__((ext_vector_type(4)));
__device__ __forceinline__ bf16x8 tr2(const LDS3 char* p0, const LDS3 char* p1) {
  const v4i16_t a = __builtin_amdgcn_ds_read_tr16_b64_v4i16((LDS3 v4i16_t*)p0), b = __builtin_amdgcn_ds_read_tr16_b64_v4i16((LDS3 v4i16_t*)p1);
  return (bf16x8){a[0], a[1], a[2], a[3], b[0], b[1], b[2], b[3]};
}
__device__ __forceinline__ bf16x8 ld16(const LDS3 char* p) { return *(const LDS3 bf16x8*)p; }
__device__ __forceinline__ bf16x8 pack8(f32x4 a, f32x4 b) { u32x4 w = {pk2(a[0], a[1]), pk2(a[2], a[3]), pk2(b[0], b[1]), pk2(b[2], b[3])}; return __builtin_bit_cast(bf16x8, w); }
__device__ __forceinline__ float grp16_sum(float v) { v += __shfl_xor(v, 1); v += __shfl_xor(v, 2); v += __shfl_xor(v, 4); v += __shfl_xor(v, 8); return v; }
#define MFMA16(a, b, c) __builtin_amdgcn_mfma_f32_16x16x32_bf16((a), (b), (c), 0, 0, 0)
constexpr int RS = 144, TSZ = 64 * RS;
constexpr int RS2 = 80, TSZ2 = 64 * RS2;

__device__ __forceinline__ void ret_chain(const bf16_t* __restrict__ PROJ, bf16_t* __restrict__ MIX, int b, int h, LDS3 char* L) {
  int tid_ = threadIdx.x; asm volatile("" : "+v"(tid_));
  const int tid = tid_, wid = __builtin_amdgcn_readfirstlane(tid >> 6), lane = tid & 63, fr = lane & 15, g = lane >> 4, q4 = fr >> 2, p4 = fr & 3;
  constexpr int O_K = 0, O_V = 2 * TSZ, O_VS = 4 * TSZ, O_ST = 6 * TSZ;
  const float lg = log1pf(-exp2f(-5.f - (float)h));
  const int t00 = b * S;
  const int srow = tid >> 3, spc = tid & 7, sOff = srow * RS + spc * 16;
  const bf16_t* gk = PROJ + (size_t)(t00 + srow) * NP + P_RK + h * 64 + spc * 8;
  const float kwj = __expf(lg * (float)(63 - srow));
  const bool outw = wid < 4; const int rb = wid & 3;
  const bf16_t* gq = PROJ + (size_t)(t00 + 16 * rb + fr) * NP + P_RQ + h * 64 + 8 * g;
  float decay[4][4], qw[4];
#pragma unroll
  for (int jt = 0; jt < 4; ++jt)
#pragma unroll
    for (int r = 0; r < 4; ++r) { const int d = (16 * rb + fr) - (16 * jt + 4 * g + r); decay[jt][r] = __expf(lg * (float)(d < 0 ? -d : d)); }
#pragma unroll
  for (int r = 0; r < 4; ++r) qw[r] = __expf(lg * (float)(16 * rb + 4 * g + r + 1));
  const float a64 = __expf(lg * 64.f);
  f32x4 Sacc[4];
#pragma unroll
  for (int e = 0; e < 4; ++e) Sacc[e] = (f32x4){0.f, 0.f, 0.f, 0.f};
  __syncthreads();
  for (int i = tid; i < TSZ / 4; i += 512) ((LDS3 unsigned*)(L + O_ST))[i] = 0u;
  bf16x8 rk = *(const bf16x8*)gk, rv = *(const bf16x8*)(gk + 256), qf0 = *(const bf16x8*)gq, qf1 = *(const bf16x8*)(gq + 32);
  for (int n = 0; n < S / 64; ++n) {
    const int buf = n & 1;
    *(LDS3 bf16x8*)(L + O_K + buf * TSZ + sOff) = rk; *(LDS3 bf16x8*)(L + O_V + buf * TSZ + sOff) = rv;
    { f32x4 lo, hi2;
#pragma unroll
      for (int e = 0; e < 4; ++e) { lo[e] = bf2f((bf16_t)rv[e]) * kwj; hi2[e] = bf2f((bf16_t)rv[4 + e]) * kwj; }
      *(LDS3 bf16x8*)(L + O_VS + buf * TSZ + sOff) = pack8(lo, hi2); }
    const bf16x8 q0 = qf0, q1 = qf1;
    { const int nn = (n + 1 < S / 64) ? n + 1 : n; const size_t go = (size_t)nn * 64 * NP;
      rk = *(const bf16x8*)(gk + go); rv = *(const bf16x8*)(gk + go + 256); qf0 = *(const bf16x8*)(gq + go); qf1 = *(const bf16x8*)(gq + go + 32); }
    __syncthreads();
    const LDS3 char* KT = L + O_K + buf * TSZ; const LDS3 char* VT = L + O_V + buf * TSZ; const LDS3 char* VS = L + O_VS + buf * TSZ;
    if (outw) {
      const LDS3 char* STc = L + O_ST + buf * TSZ;
      f32x4 sT[4];
#pragma unroll
      for (int jt = 0; jt < 4; ++jt) {
        f32x4 a = (f32x4){0.f, 0.f, 0.f, 0.f};
        a = MFMA16(ld16(KT + (16 * jt + fr) * RS + 16 * g), q0, a);
        a = MFMA16(ld16(KT + (16 * jt + fr) * RS + 64 + 16 * g), q1, a);
#pragma unroll
        for (int r = 0; r < 4; ++r) a[r] *= decay[jt][r];
        sT[jt] = a;
      }
      const bf16x8 af0 = pack8(sT[0], sT[1]), af1 = pack8(sT[2], sT[3]);
      f32x4 o[4]; float ss[4] = {0.f, 0.f, 0.f, 0.f};
#pragma unroll
      for (int et = 0; et < 4; ++et) {
        f32x4 a = (f32x4){0.f, 0.f, 0.f, 0.f};
        a = MFMA16(q0, ld16(STc + (16 * et + fr) * RS + 16 * g), a);
        a = MFMA16(q1, ld16(STc + (16 * et + fr) * RS + 64 + 16 * g), a);
#pragma unroll
        for (int r = 0; r < 4; ++r) a[r] *= qw[r];
        a = MFMA16(af0, tr2(VT + (4 * g + q4) * RS + (16 * et + 4 * p4) * 2, VT + (16 + 4 * g + q4) * RS + (16 * et + 4 * p4) * 2), a);
        a = MFMA16(af1, tr2(VT + (32 + 4 * g + q4) * RS + (16 * et + 4 * p4) * 2, VT + (48 + 4 * g + q4) * RS + (16 * et + 4 * p4) * 2), a);
        o[et] = a;
#pragma unroll
        for (int r = 0; r < 4; ++r) ss[r] += a[r] * a[r];
      }
#pragma unroll
      for (int r = 0; r < 4; ++r) ss[r] = rsqrtf(grp16_sum(ss[r]) * (1.f / 64.f) + EPS);
#pragma unroll
      for (int r = 0; r < 4; ++r) { const size_t t = (size_t)(t00 + n * 64 + 16 * rb + 4 * g + r);
#pragma unroll
        for (int et = 0; et < 4; ++et) { const int e = h * 64 + 16 * et + fr;
          MIX[t * 1024 + e] = (bf16_t)f2bf(o[et][r] * ss[r] * bf2f(PROJ[t * NP + P_RZ + e])); } }
    } else {
      const int s = wid - 4; LDS3 char* STn = L + O_ST + (buf ^ 1) * TSZ;
      const bf16x8 kt0 = tr2(KT + (8 * g + q4) * RS + (16 * s + 4 * p4) * 2, KT + (8 * g + 4 + q4) * RS + (16 * s + 4 * p4) * 2);
      const bf16x8 kt1 = tr2(KT + (32 + 8 * g + q4) * RS + (16 * s + 4 * p4) * 2, KT + (32 + 8 * g + 4 + q4) * RS + (16 * s + 4 * p4) * 2);
#pragma unroll
      for (int et = 0; et < 4; ++et) {
        f32x4 a = Sacc[et] * a64;
        a = MFMA16(kt0, tr2(VS + (8 * g + q4) * RS + (16 * et + 4 * p4) * 2, VS + (8 * g + 4 + q4) * RS + (16 * et + 4 * p4) * 2), a);
        a = MFMA16(kt1, tr2(VS + (32 + 8 * g + q4) * RS + (16 * et + 4 * p4) * 2, VS + (32 + 8 * g + 4 + q4) * RS + (16 * et + 4 * p4) * 2), a);
        Sacc[et] = a;
        u32x2 w; w.x = pk2(a[0], a[1]); w.y = pk2(a[2], a[3]);
        *(LDS3 u32x2*)(STn + (16 * et + fr) * RS + (16 * s + 4 * g) * 2) = w;
      }
    }
  }
  __syncthreads();
}

__device__ __forceinline__ void gla_chain(const bf16_t* __restrict__ PROJ, const float* __restrict__ GG, const float* __restrict__ w_g2, const float* __restrict__ b_g2,
                                          const float* __restrict__ gnw, bf16_t* __restrict__ MIX, int b, int h, LDS3 char* L) {
  int tid_ = threadIdx.x; asm volatile("" : "+v"(tid_));
  const int tid = tid_, wid = __builtin_amdgcn_readfirstlane(tid >> 6), lane = tid & 63, fr = lane & 15, g = lane >> 4, q4 = fr >> 2, p4 = fr & 3;
  constexpr int O_QP = 0, O_QN = 2 * TSZ2, O_KN = 4 * TSZ2, O_KP = 6 * TSZ2, O_KD = 8 * TSZ2, O_V = 10 * TSZ2, O_ST = O_V + 2 * TSZ, O_AL = O_ST + 2 * TSZ2;
  const int t00 = b * S;
  const int srow = tid >> 3, spc = tid & 7, sOff = srow * RS + spc * 16;
  const bf16_t* gv = PROJ + (size_t)(t00 + srow) * NP + P_GV + h * 64 + spc * 8;
  const bf16_t* gqk = PROJ + (size_t)(t00 + lane) * NP + P_GQ + h * 32 + 4 * wid;
  const float* ggp = GG + (size_t)(t00 + lane) * 16;
  float wg[16][4], bg[4];
#pragma unroll
  for (int r = 0; r < 16; ++r)
#pragma unroll
    for (int d = 0; d < 4; ++d) wg[r][d] = w_g2[r * 128 + h * 32 + 4 * wid + d];
#pragma unroll
  for (int d = 0; d < 4; ++d) bg[d] = b_g2[h * 32 + 4 * wid + d];
  const bool outw = wid < 4; const int rb = wid & 3;
  const int sdt = wid & 1, set0 = ((wid >> 1) & 1) * 2;
  f32x4 Sacc[2];
  Sacc[0] = (f32x4){0.f, 0.f, 0.f, 0.f}; Sacc[1] = (f32x4){0.f, 0.f, 0.f, 0.f};
  __syncthreads();
  for (int i = tid; i < TSZ2 / 4; i += 512) ((LDS3 unsigned*)(L + O_ST))[i] = 0u;
  bf16x8 rv = *(const bf16x8*)gv; u32x2 rq = *(const u32x2*)gqk, rkk = *(const u32x2*)(gqk + 128);
  f32x4 rg0 = *(const f32x4*)ggp, rg1 = *(const f32x4*)(ggp + 4), rg2 = *(const f32x4*)(ggp + 8), rg3 = *(const f32x4*)(ggp + 12);
  for (int n = 0; n < S / 64; ++n) {
    const int buf = n & 1;
    *(LDS3 bf16x8*)(L + O_V + buf * TSZ + sOff) = rv;
    {
      const float gg[16] = {rg0[0], rg0[1], rg0[2], rg0[3], rg1[0], rg1[1], rg1[2], rg1[3], rg2[0], rg2[1], rg2[2], rg2[3], rg3[0], rg3[1], rg3[2], rg3[3]};
      float cum[4];
#pragma unroll
      for (int d = 0; d < 4; ++d) { float z = bg[d];
#pragma unroll
        for (int r = 0; r < 16; ++r) z = fmaf(gg[r], wg[r][d], z);
        cum[d] = (fminf(z, 0.f) - log1pf(__expf(-fabsf(z)))) * (1.f / 16.f); }
#pragma unroll
      for (int off = 1; off < 64; off <<= 1)
#pragma unroll
        for (int d = 0; d < 4; ++d) { const float t = __shfl_up(cum[d], off); if (lane >= off) cum[d] += t; }
      const float qv[4] = {bf2f((bf16_t)(rq.x & 0xffff)), bf2f((bf16_t)(rq.x >> 16)), bf2f((bf16_t)(rq.y & 0xffff)), bf2f((bf16_t)(rq.y >> 16))};
      const float kv[4] = {bf2f((bf16_t)(rkk.x & 0xffff)), bf2f((bf16_t)(rkk.x >> 16)), bf2f((bf16_t)(rkk.y & 0xffff)), bf2f((bf16_t)(rkk.y >> 16))};
      float qp[4], qn[4], kn[4], kp[4], kd[4];
#pragma unroll
      for (int d = 0; d < 4; ++d) { const float last = __shfl(cum[d], 63); const float ep = __expf(cum[d]), en = __expf(-cum[d]), ed = __expf(last - cum[d]);
        qp[d] = qv[d] * ep; qn[d] = qv[d] * en; kn[d] = kv[d] * en; kp[d] = kv[d] * ep; kd[d] = kv[d] * ed;
        if (lane == 0) ((LDS3 float*)(L + O_AL))[buf * 32 + 4 * wid + d] = __expf(last); }
      const int o2 = buf * TSZ2 + lane * RS2 + 8 * wid;
      u32x2 w;
      w.x = pk2(qp[0], qp[1]); w.y = pk2(qp[2], qp[3]); *(LDS3 u32x2*)(L + O_QP + o2) = w;
      w.x = pk2(qn[0], qn[1]); w.y = pk2(qn[2], qn[3]); *(LDS3 u32x2*)(L + O_QN + o2) = w;
      w.x = pk2(kn[0], kn[1]); w.y = pk2(kn[2], kn[3]); *(LDS3 u32x2*)(L + O_KN + o2) = w;
      w.x = pk2(kp[0], kp[1]); w.y = pk2(kp[2], kp[3]); *(LDS3 u32x2*)(L + O_KP + o2) = w;
      w.x = pk2(kd[0], kd[1]); w.y = pk2(kd[2], kd[3]); *(LDS3 u32x2*)(L + O_KD + o2) = w;
    }
    { const int nn = (n + 1 < S / 64) ? n + 1 : n; const size_t go = (size_t)nn * 64 * NP; const size_t gg2 = (size_t)nn * 64 * 16;
      rv = *(const bf16x8*)(gv + go); rq = *(const u32x2*)(gqk + go); rkk = *(const u32x2*)(gqk + go + 128);
      rg0 = *(const f32x4*)(ggp + gg2); rg1 = *(const f32x4*)(ggp + gg2 + 4); rg2 = *(const f32x4*)(ggp + gg2 + 8); rg3 = *(const f32x4*)(ggp + gg2 + 12); }
    __syncthreads();
    const LDS3 char* VT = L + O_V + buf * TSZ;
    if (outw) {
      const LDS3 char* QP = L + O_QP + buf * TSZ2; const LDS3 char* QN = L + O_QN + buf * TSZ2; const LDS3 char* KN = L + O_KN + buf * TSZ2; const LDS3 char* KP = L + O_KP + buf * TSZ2;
      const LDS3 char* STc = L + O_ST + buf * TSZ2;
      const bf16x8 qpf = ld16(QP + (16 * rb + fr) * RS2 + 16 * g), qnf = ld16(QN + (16 * rb + fr) * RS2 + 16 * g);
      f32x4 sT[4];
#pragma unroll
      for (int jt = 0; jt < 4; ++jt) {
        const f32x4 z4 = (f32x4){0.f, 0.f, 0.f, 0.f};
        const f32x4 past = MFMA16(ld16(KN + (16 * jt + fr) * RS2 + 16 * g), qpf, z4);
        const f32x4 fut = MFMA16(ld16(KP + (16 * jt + fr) * RS2 + 16 * g), qnf, z4);
#pragma unroll
        for (int r = 0; r < 4; ++r) sT[jt][r] = ((16 * rb + fr) >= (16 * jt + 4 * g + r)) ? past[r] : fut[r];
      }
      const bf16x8 af0 = pack8(sT[0], sT[1]), af1 = pack8(sT[2], sT[3]);
      f32x4 o[4]; float ss[4] = {0.f, 0.f, 0.f, 0.f};
#pragma unroll
      for (int et = 0; et < 4; ++et) {
        f32x4 a = (f32x4){0.f, 0.f, 0.f, 0.f};
        a = MFMA16(qpf, ld16(STc + (16 * et + fr) * RS2 + 16 * g), a);
        a = MFMA16(af0, tr2(VT + (4 * g + q4) * RS + (16 * et + 4 * p4) * 2, VT + (16 + 4 * g + q4) * RS + (16 * et + 4 * p4) * 2), a);
        a = MFMA16(af1, tr2(VT + (32 + 4 * g + q4) * RS + (16 * et + 4 * p4) * 2, VT + (48 + 4 * g + q4) * RS + (16 * et + 4 * p4) * 2), a);
        o[et] = a;
#pragma unroll
        for (int r = 0; r < 4; ++r) ss[r] += a[r] * a[r];
      }
#pragma unroll
      for (int r = 0; r < 4; ++r) ss[r] = rsqrtf(grp16_sum(ss[r]) * (1.f / 64.f) + EPS);
#pragma unroll
      for (int r = 0; r < 4; ++r) { const size_t t = (size_t)(t00 + n * 64 + 16 * rb + 4 * g + r);
#pragma unroll
        for (int et = 0; et < 4; ++et) { const int e = 16 * et + fr;
          MIX[t * 1024 + 768 + h * 64 + e] = (bf16_t)f2bf(o[et][r] * ss[r] * gnw[e] * bf2f(PROJ[t * NP + P_GZ + h * 64 + e])); } }
    } else {
      const LDS3 char* KD = L + O_KD + buf * TSZ2; LDS3 char* STn = L + O_ST + (buf ^ 1) * TSZ2; const LDS3 float* AL = (const LDS3 float*)(L + O_AL) + buf * 32;
      const bf16x8 kt0 = tr2(KD + (8 * g + q4) * RS2 + (16 * sdt + 4 * p4) * 2, KD + (8 * g + 4 + q4) * RS2 + (16 * sdt + 4 * p4) * 2);
      const bf16x8 kt1 = tr2(KD + (32 + 8 * g + q4) * RS2 + (16 * sdt + 4 * p4) * 2, KD + (32 + 8 * g + 4 + q4) * RS2 + (16 * sdt + 4 * p4) * 2);
      const f32x4 al = *(const LDS3 f32x4*)(AL + 16 * sdt + 4 * g);
#pragma unroll
      for (int e2 = 0; e2 < 2; ++e2) { const int et = set0 + e2;
        f32x4 a = Sacc[e2] * al;
        a = MFMA16(kt0, tr2(VT + (8 * g + q4) * RS + (16 * et + 4 * p4) * 2, VT + (8 * g + 4 + q4) * RS + (16 * et + 4 * p4) * 2), a);
        a = MFMA16(kt1, tr2(VT + (32 + 8 * g + q4) * RS + (16 * et + 4 * p4) * 2, VT + (32 + 8 * g + 4 + q4) * RS + (16 * et + 4 * p4) * 2), a);
        Sacc[e2] = a;
        u32x2 w; w.x = pk2(a[0], a[1]); w.y = pk2(a[2], a[3]);
        *(LDS3 u32x2*)(STn + (16 * et + fr) * RS2 + (16 * sdt + 4 * g) * 2) = w;
      }
    }
  }
  __syncthreads();
}
__device__ __forceinline__ void chain_phase(const bf16_t* PROJ, const float* GG, const float* w_g2, const float* b_g2, const float* gnw, bf16_t* MIX, LDS3 char* L) {
  const int G = gridDim.x, bx = blockIdx.x; const int v = (G % 8 == 0) ? (bx % 8) * (G / 8) + bx / 8 : bx;
  for (int c = v; c < NB * 8; c += G) {
    const int b = c >> 3, h = c & 3;
    if ((c >> 2) & 1) gla_chain(PROJ, GG, w_g2, b_g2, gnw, MIX, b, h, L); else ret_chain(PROJ, MIX, b, h, L);
  }
}
#undef MFMA16
}

#define GAS __attribute__((address_space(1)))
#define LAS __attribute__((address_space(3)))
typedef GAS unsigned gu32;
#define RLX_AGENT __ATOMIC_RELAXED, __HIP_MEMORY_SCOPE_AGENT
#define XB_TMO      128
#define XB_XCNT(j)  (256  + 64 * (j))
#define XB_XSUB(j)  (1280 + 64 * (j))
#define XB_XGEN(j)  (2304 + 64 * (j))
#define XB_TOP      3328
#define XB_TOPGEN   3392
#define XCD_BAR_WORDS 3456
#define XB_SPIN_CAP (1u << 18)

__device__ __forceinline__ unsigned xb_ld(unsigned* p)              { return __hip_atomic_load(p, __ATOMIC_RELAXED, __HIP_MEMORY_SCOPE_AGENT); }
__device__ __forceinline__ unsigned xb_add(unsigned* p, unsigned v) { return __hip_atomic_fetch_add(p, v, __ATOMIC_RELAXED, __HIP_MEMORY_SCOPE_AGENT); }
__device__ __forceinline__ unsigned xb_xcc_id() { return (unsigned)__builtin_amdgcn_s_getreg((3 << 11) | 20) & 0xFu; }
#define XB_SPIN(cond, bar) do { unsigned _sp = 0; while (cond) { __builtin_amdgcn_s_sleep(1); \
    if ((++_sp & 255u) == 0u) { if (xb_ld(&(bar)[XB_TMO])) break; if (_sp > XB_SPIN_CAP) { atomicAdd(&(bar)[XB_TMO], 1u); break; } } } } while (0)

struct XcdBarrier {
    unsigned* bar; unsigned x;
    volatile LAS unsigned* st;
};

__device__ __forceinline__ XcdBarrier xcd_barrier_post(unsigned* bar, volatile LAS unsigned* st) {
    XcdBarrier b; b.bar = bar; b.x = xb_xcc_id(); b.st = st;
    if (threadIdx.x == 0) (void)xb_add(&bar[XB_XCNT(b.x)], 1u);
    return b;
}
__device__ __forceinline__ void xcd_barrier_complete(unsigned* bar, unsigned x, unsigned& nloc, unsigned& nx) {
    const unsigned G = gridDim.x * gridDim.y * gridDim.z;
    unsigned sum, cnt, mine, sp = 0u;
    for (;;) {
        sum = 0u; cnt = 0u; mine = 0u;
#pragma unroll
        for (unsigned j = 0; j < 16; ++j) { const unsigned c = xb_ld(&bar[XB_XCNT(j)]); sum += c; cnt += (c > 0u) ? 1u : 0u; mine = (j == x) ? c : mine; }
        if (sum == G) break;
        __builtin_amdgcn_s_sleep(1);
        if ((++sp & 255u) == 0u) { if (xb_ld(&bar[XB_TMO])) break; if (sp > XB_SPIN_CAP) { atomicAdd(&bar[XB_TMO], 1u); break; } }
    }
    nloc = mine > 0u ? mine : 1u; nx = cnt > 0u ? cnt : 1u;
}

__device__ __forceinline__ void xcd_barrier(const XcdBarrier& b) {
    asm volatile("s_waitcnt vmcnt(0)" ::: "memory");
    __syncthreads();
    if (threadIdx.x == 0) {
        unsigned* bar = b.bar;
        __builtin_amdgcn_s_waitcnt(0);
        unsigned nloc = b.st[0], nx = b.st[1];
        if (nloc == 0u) { xcd_barrier_complete(bar, b.x, nloc, nx); b.st[0] = nloc; b.st[1] = nx; }
        const unsigned old = xb_add(&bar[XB_XSUB(b.x)], 1u);
        const unsigned gen = old / nloc;
        if (old + 1u == (gen + 1u) * nloc) {
            __builtin_amdgcn_fence(__ATOMIC_RELEASE, "agent");
            asm volatile("s_waitcnt vmcnt(0)" ::: "memory");
            const unsigned og = xb_add(&bar[XB_TOP], 1u);
            const unsigned tg = og / nx;
            if (og + 1u == (tg + 1u) * nx) xb_add(&bar[XB_TOPGEN], 1u);
            else XB_SPIN(xb_ld(&bar[XB_TOPGEN]) == tg, bar);
            __builtin_amdgcn_fence(__ATOMIC_ACQUIRE, "agent");
            xb_add(&bar[XB_XGEN(b.x)], 1u);
            asm volatile("s_waitcnt vmcnt(0)" ::: "memory");
        } else {
            XB_SPIN(xb_ld(&bar[XB_XGEN(b.x)]) == gen, bar);
            __builtin_amdgcn_fence(__ATOMIC_ACQUIRE, "agent");
            asm volatile("s_waitcnt vmcnt(0)" ::: "memory");
        }
    }
    __syncthreads();
}

#ifndef PROBE_DUP
#define PROBE_DUP 0
#endif
constexpr int NTHREADS = 512;
constexpr int LDS_BYTES = 147456;
__global__ void __launch_bounds__(NTHREADS, 2) mk_fwd(Params p) {
    extern __shared__ __attribute__((aligned(16))) unsigned char lds[];
    cg::grid_group grid = cg::this_grid();
    Ctx c; c.tid = threadIdx.x; c.lane = c.tid & 63; c.wave = __builtin_amdgcn_readfirstlane(c.tid >> 6);
    c.gw = blockIdx.x * (NTHREADS / 64) + c.wave; c.NGW = gridDim.x * (NTHREADS / 64);
    c.gt = (long)blockIdx.x * NTHREADS + c.tid; c.GT = (long)gridDim.x * NTHREADS;
    unsigned char* ws = p.ws;
    float* ADA = (float*)(ws + WS_ADA); const float2* CS32 = (const float2*)(ws + WS_CS32); const float2* CS16 = (const float2*)(ws + WS_CS16);
    bf16_t* WinT = (bf16_t*)(ws + WS_WIN); bf16_t* WuqT = (bf16_t*)(ws + WS_WUQ); bf16_t* WukvT = (bf16_t*)(ws + WS_WUKV); bf16_t* WoutT = (bf16_t*)(ws + WS_WOUT);
    float* RSQ = (float*)(ws + WS_RSQ); float* RSKV = (float*)(ws + WS_RSKV); float* GG = (float*)(ws + WS_GG);
    bf16_t* H = (bf16_t*)(ws + WS_H); bf16_t* PROJ = (bf16_t*)(ws + WS_PROJ); bf16_t* Q = (bf16_t*)(ws + WS_Q); bf16_t* KV = (bf16_t*)(ws + WS_KV); bf16_t* MIX = (bf16_t*)(ws + WS_MIX);
    float* GC = (float*)(ws + WS_GCUM);
    PG8_LAS unsigned char* ldsp = (PG8_LAS unsigned char*)lds;
    volatile LAS unsigned* MISC = (volatile LAS unsigned*)(ldsp + 131072);
    if (c.tid < 32) MISC[c.tid] = 0u;
    __syncthreads();
    XcdBarrier xbar = xcd_barrier_post((unsigned*)(ws + WS_CTL), MISC + 8);
#define GRID_BAR() xcd_barrier(xbar)

    ph_prep(p, fresh(c), ldsp);
#if PROBE_DUP & 64
    ph_prep(p, fresh(c), ldsp);
#endif
    grid.sync();
#pragma unroll 1
    for (int l = 0; l < DEPTH; ++l) {
        const float* xin = (l == 0) ? p.x : p.out;
        const float* ADA_l = ADA + (size_t)l * NB * 3072;
        ph_norm(fresh(c), xin, p.norm_w + l * D, ADA_l, H);
#if PROBE_DUP & 32
        ph_norm(fresh(c), xin, p.norm_w + l * D, ADA_l, H);
#endif
        GRID_BAR();
        run_gemm(ldsp, H, D, WinT + (size_t)l * NP * 1024, T, NP, 1024, EpiIn{PROJ, GG, CS32, CS16});
#if PROBE_DUP & 1
        run_gemm(ldsp, H, D, WinT + (size_t)l * NP * 1024, T, NP, 1024, EpiIn{PROJ, GG, CS32, CS16});
#endif
        GRID_BAR();
        ph_rstd(fresh(c), PROJ, RSQ, RSKV);
        GRID_BAR();
        run_gemm(ldsp, PROJ + P_MQ, NP, WuqT + (size_t)l * 768 * 256, T, 768, 256, EpiQ{Q, RSQ, CS16});
        run_gemm(ldsp, PROJ + P_MKV, NP, WukvT + (size_t)l * 1024 * 128, T, 1024, 128, EpiKV{KV, RSKV});
#if PROBE_DUP & 2
        run_gemm(ldsp, PROJ + P_MQ, NP, WuqT + (size_t)l * 768 * 256, T, 768, 256, EpiQ{Q, RSQ, CS16});
        run_gemm(ldsp, PROJ + P_MKV, NP, WukvT + (size_t)l * 1024 * 128, T, 1024, 128, EpiKV{KV, RSKV});
#endif
        GRID_BAR();
        att::attn_phase(Q, KV, PROJ, MIX, (char*)lds);
#if PROBE_DUP & 4
        att::attn_phase(Q, KV, PROJ, MIX, (char*)lds);
#endif
        chain::chain_phase(PROJ, GG, p.w_g2 + (size_t)l * 16 * 128, p.b_g2 + l * 128, p.gnw + l * 64, MIX, (LDS3 char*)lds);
#if PROBE_DUP & 8
        chain::chain_phase(PROJ, GG, p.w_g2 + (size_t)l * 16 * 128, p.b_g2 + l * 128, p.gnw + l * 64, MIX, (LDS3 char*)lds);
#endif
        GRID_BAR();
        run_gemm(ldsp, MIX, 1024, WoutT + (size_t)l * 1024 * 1024, T, 1024, 1024, EpiOut{xin, p.out, ADA_l});
#if PROBE_DUP & 16
        if (l == 0) run_gemm(ldsp, MIX, 1024, WoutT + (size_t)l * 1024 * 1024, T, 1024, 1024, EpiOut{xin, p.out, ADA_l});
#endif
        GRID_BAR();
    }
    ph_final(fresh(c), p.out, p.fnw, p.out);
}

extern "C" void kernel_launch(void* const* d_in, const int* in_sizes, int n_in, void* d_out, int out_size, void* d_ws, size_t ws_size, hipStream_t stream) {
    static int grid_blocks = 0;
    if (grid_blocks == 0) {
        if (n_in != 16 || in_sizes[0] != T * D || out_size != T * D || ws_size < WS_END) {
            fprintf(stderr, "kernel_launch: shape/ws mismatch n_in %d in0 %d out %d ws %zu (need %zu)\n", n_in, n_in > 0 ? in_sizes[0] : -1, out_size, ws_size, (size_t)WS_END);
            grid_blocks = -1; return;
        }
        int dev = 0, cus = 0, per_cu = 0;
        hipGetDevice(&dev); hipDeviceGetAttribute(&cus, hipDeviceAttributeMultiprocessorCount, dev);
        if (hipFuncSetAttribute((const void*)mk_fwd, hipFuncAttributeMaxDynamicSharedMemorySize, LDS_BYTES) != hipSuccess) { fprintf(stderr, "kernel_launch: hipFuncSetAttribute failed\n"); grid_blocks = -1; return; }
        if (hipOccupancyMaxActiveBlocksPerMultiprocessor(&per_cu, (const void*)mk_fwd, NTHREADS, LDS_BYTES) != hipSuccess || per_cu < 1) { fprintf(stderr, "kernel_launch: occupancy query says %d blocks/CU\n", per_cu); grid_blocks = -1; return; }
        grid_blocks = cus;
        fprintf(stderr, "kernel_launch: cus %d per_cu %d grid %d\n", cus, per_cu, grid_blocks);
    }
    if (grid_blocks < 0) return;
    Params p{};
    p.x = (const float*)d_in[0]; p.c = (const float*)d_in[1]; p.pos = (const int*)d_in[2]; p.norm_w = (const float*)d_in[3]; p.ada_w = (const float*)d_in[4];
    p.ada_b = (const float*)d_in[5]; p.w_in = (const float*)d_in[6]; p.qnw = (const float*)d_in[7]; p.w_uq = (const float*)d_in[8]; p.kvnw = (const float*)d_in[9];
    p.w_ukv = (const float*)d_in[10]; p.w_g2 = (const float*)d_in[11]; p.b_g2 = (const float*)d_in[12]; p.gnw = (const float*)d_in[13]; p.w_out = (const float*)d_in[14];
    p.fnw = (const float*)d_in[15]; p.out = (float*)d_out; p.ws = (unsigned char*)d_ws;
    if (hipMemsetAsync((char*)d_ws + WS_CTL, 0, 65536, stream) != hipSuccess) { fprintf(stderr, "kernel_launch: memset failed\n"); return; }
    void* args[] = {&p};
    hipError_t e = hipLaunchCooperativeKernel((void*)mk_fwd, dim3(grid_blocks), dim3(NTHREADS), args, LDS_BYTES, stream);
    if (e != hipSuccess) fprintf(stderr, "cooperative launch failed: %s (grid %d)\n", hipGetErrorString(e), grid_blocks);
}
```

```cpp
#include <hip/hip_runtime.h>
#include <hip/hip_cooperative_groups.h>
namespace cg = cooperative_groups;
#include <cstdio>
#include <cstdint>
#include <cmath>

typedef unsigned short bf16_t;
typedef short bf16x8 __attribute__((ext_vector_type(8)));
typedef float f32x4 __attribute__((ext_vector_type(4)));
typedef unsigned u32x4 __attribute__((ext_vector_type(4)));
typedef unsigned u32x2 __attribute__((ext_vector_type(2)));

constexpr int D = 1024, NB = 32, S = 2048, T = NB * S, DEPTH = 2, CH = 64;
constexpr int NIN = 2736, NP = 2816;
constexpr float EPS = 1e-6f;
constexpr int P_RQ = 0, P_RK = 256, P_RV = 512, P_RZ = 768, P_MQ = 1024, P_MKV = 1280, P_KPE = 1408, P_GG = 1440, P_PAD = 1456,
              P_MZ = 1536, P_GQ = 2048, P_GK = 2176, P_GV = 2304, P_GZ = 2560;
constexpr float QSCALE = 0.10206207261596577f * 1.4426950408889634f;

constexpr size_t MiB = 1u << 20;
constexpr size_t WS_CTL = 0;
constexpr size_t WS_ADA = 1 * MiB;
constexpr size_t WS_CS32 = 2 * MiB;
constexpr size_t WS_CS16 = 18 * MiB;
constexpr size_t WS_WIN = 26 * MiB;
constexpr size_t WS_WUQ = 38 * MiB;
constexpr size_t WS_WUKV = 39 * MiB;
constexpr size_t WS_WOUT = 40 * MiB;
constexpr size_t WS_RSQ = 44 * MiB;
constexpr size_t WS_RSKV = 45 * MiB;
constexpr size_t WS_GG = 46 * MiB;
constexpr size_t WS_H = 50 * MiB;
constexpr size_t WS_PROJ = 178 * MiB;
constexpr size_t WS_Q = 530 * MiB;
constexpr size_t WS_KV = 626 * MiB;
constexpr size_t WS_MIX = 754 * MiB;
constexpr size_t WS_GP = 882 * MiB;
constexpr int GP_ITEM = 5 * 64 * 32 + 64;
constexpr size_t WS_SSP = 963 * MiB;
constexpr size_t WS_END = 966 * MiB;

__device__ __forceinline__ unsigned f2bf(float f) { unsigned u = __builtin_bit_cast(unsigned, f); return (u + 0x7fffu + ((u >> 16) & 1u)) >> 16; }
typedef float f32x2_t __attribute__((ext_vector_type(2))); typedef __bf16 bf16x2_t __attribute__((ext_vector_type(2)));
__device__ __forceinline__ unsigned cvt_pk_bf16(float lo, float hi) { f32x2_t v = {lo, hi}; bf16x2_t b = __builtin_convertvector(v, bf16x2_t); return __builtin_bit_cast(unsigned, b); }
__device__ __forceinline__ unsigned pk2(float lo, float hi) { return f2bf(lo) | (f2bf(hi) << 16); }
__device__ __forceinline__ float bf2f(bf16_t v) { return __builtin_bit_cast(float, (unsigned)v << 16); }
__device__ __forceinline__ float silu_f(float x) { return x / (1.f + __expf(-x)); }

__host__ __device__ inline int in_logical(int p) {
    if (p < 512) { int c = p & 63; return (p & ~63) + (c >> 1) + 32 * (c & 1); }
    if (p < 1408) return p;
    if (p < 1440) { int c = p - 1408; return 1408 + (c >> 1) + 16 * (c & 1); }
    if (p < 1456) return 2464 + (p - 1440);
    if (p < 1536) return -1;
    if (p < 2048) return 1440 + (p - 1536);
    if (p < 2304) return 1952 + (p - 2048);
    if (p < 2560) return 2208 + (p - 2304);
    return 2480 + (p - 2560);
}
__host__ __device__ inline int uq_logical(int p) {
    int h = p / 96, c = p % 96;
    if (c < 64) return p;
    int cc = c - 64; return h * 96 + 64 + (cc >> 1) + 16 * (cc & 1);
}

struct Params {
    const float* x; const float* c; const int* pos; const float* norm_w; const float* ada_w; const float* ada_b; const float* w_in; const float* qnw;
    const float* w_uq; const float* kvnw; const float* w_ukv; const float* w_g2; const float* b_g2; const float* gnw; const float* w_out; const float* fnw;
    float* out; unsigned char* ws; unsigned long long never;
};
struct Ctx { int tid, lane, wave, gw, NGW; long gt, GT; };
__device__ __forceinline__ Ctx mkctx() {
    Ctx r; int t = threadIdx.x; asm volatile("" : "+v"(t)); r.tid = t; r.lane = t & 63; r.wave = __builtin_amdgcn_readfirstlane(t >> 6);
    r.gw = blockIdx.x * 8 + r.wave; r.NGW = gridDim.x * 8; r.gt = (long)blockIdx.x * 512 + t; r.GT = (long)gridDim.x * 512; return r; }

__device__ __forceinline__ float wave_sum(float v) {
#pragma unroll
    for (int o = 1; o < 64; o <<= 1) v += __shfl_xor(v, o);
    return v;
}

template <class Map>
__device__ __forceinline__ void tr_item(const float* __restrict__ W, int K, int ldw, const float* __restrict__ rs, bf16_t* __restrict__ WT, int nblk, int item, int lane,
                                        __attribute__((address_space(3))) float* scr, const Map& lmap) {
    const int kb = item / nblk, nb = item % nblk, k0 = 64 * kb, n0 = 32 * nb;
    const int lc = lmap(n0 + (lane & 31));
#pragma unroll 8
    for (int i = 0; i < 32; ++i) { const int kk = 2 * i + (lane >> 5);
        float v = 0.f; if (lc >= 0) { v = W[(size_t)(k0 + kk) * ldw + lc]; if (rs) v *= rs[k0 + kk]; }
        scr[kk * 33 + (lane & 31)] = v; }
    asm volatile("s_waitcnt lgkmcnt(0)" ::: "memory");
    const int cc = lane & 7;
#pragma unroll
    for (int j = 0; j < 4; ++j) { const int n = (lane >> 3) + 8 * j; const __attribute__((address_space(3))) float* s = scr + (8 * cc) * 33 + n;
        u32x4 o; o.x = pk2(s[0 * 33], s[1 * 33]); o.y = pk2(s[2 * 33], s[3 * 33]); o.z = pk2(s[4 * 33], s[5 * 33]); o.w = pk2(s[6 * 33], s[7 * 33]);
        *(u32x4*)(WT + (size_t)(n0 + n) * K + k0 + 8 * cc) = o; }
    asm volatile("s_waitcnt lgkmcnt(0)" ::: "memory");
}
struct MapIn { __device__ __forceinline__ int operator()(int p) const { return in_logical(p); } };
struct MapUq { __device__ __forceinline__ int operator()(int p) const { return uq_logical(p); } };
struct MapId { __device__ __forceinline__ int operator()(int p) const { return p; } };
template <int PARTS = 7>
__device__ __forceinline__ void ph_prep(const Params& p, const Ctx& c, __attribute__((address_space(3))) unsigned char* lds) {
    typedef __attribute__((address_space(3))) float lfloat;
    unsigned char* ws = p.ws;
    bf16_t* WinT = (bf16_t*)(ws + WS_WIN); bf16_t* WuqT = (bf16_t*)(ws + WS_WUQ); bf16_t* WukvT = (bf16_t*)(ws + WS_WUKV); bf16_t* WoutT = (bf16_t*)(ws + WS_WOUT);
    float2* CS32 = (float2*)(ws + WS_CS32); float2* CS16 = (float2*)(ws + WS_CS16); float* ADA = (float*)(ws + WS_ADA);
    const int lane = c.lane, wave = c.wave, tid = c.tid;
    if (PARTS & 1) for (int item = blockIdx.x; item < DEPTH * 96; item += gridDim.x) {
        const int l = item / 96, cg = item % 96, n = cg * 32 + (lane & 31), kh = lane >> 5, k0 = wave * 128;
        lfloat* ca = (lfloat*)(lds + wave * 16384);
        for (int i = lane; i < 32 * 128; i += 64) { const int b = i >> 7, kk = i & 127; ca[i] = silu_f(p.c[b * 1024 + k0 + kk]); }
        asm volatile("s_waitcnt lgkmcnt(0)" ::: "memory");
        float acc[32];
#pragma unroll
        for (int b = 0; b < 32; ++b) acc[b] = 0.f;
        const float* wp = p.ada_w + ((size_t)l * 1024 + k0 + kh * 64) * 3072 + n;
        const lfloat* cb = ca + kh * 64;
#pragma unroll 1
        for (int kk = 0; kk < 64; kk += 8) {
            float w[8];
#pragma unroll
            for (int j = 0; j < 8; ++j) w[j] = wp[(size_t)(kk + j) * 3072];
#pragma unroll
            for (int hf = 0; hf < 2; ++hf) {
#pragma unroll
                for (int b = 0; b < 32; ++b) { const f32x4 c4 = *(const __attribute__((address_space(3))) f32x4*)(cb + b * 128 + kk + 4 * hf);
                    acc[b] += c4.x * w[4 * hf + 0] + c4.y * w[4 * hf + 1] + c4.z * w[4 * hf + 2] + c4.w * w[4 * hf + 3]; }
                asm volatile("" ::: "memory"); }
        }
#pragma unroll
        for (int b = 0; b < 32; ++b) acc[b] += __shfl_xor(acc[b], 32);
        __syncthreads();
        lfloat* red = (lfloat*)lds;
        if (lane < 32) {
#pragma unroll
            for (int b = 0; b < 32; ++b) red[(wave * 32 + b) * 32 + lane] = acc[b]; }
        __syncthreads();
        for (int o = tid; o < 1024; o += 512) { const int b = o >> 5, nn = o & 31; float s = 0.f;
#pragma unroll
            for (int w = 0; w < 8; ++w) s += red[(w * 32 + b) * 32 + nn];
            ADA[((size_t)l * NB + b) * 3072 + cg * 32 + nn] = s + p.ada_b[l * 3072 + cg * 32 + nn]; }
        __syncthreads();
    }
    lfloat* scr = (lfloat*)(lds + wave * 16384);
    constexpr int I_IN = 16 * (NP / 32), I_UQ = 4 * 24, I_UKV = 2 * 32, I_OUT = 16 * 32, I_L = I_IN + I_UQ + I_UKV + I_OUT;
    if (PARTS & 2) for (int it = c.gw; it < DEPTH * I_L; it += c.NGW) {
        const int l = it / I_L; int r = it % I_L;
        if (r < I_IN) { tr_item(p.w_in + (size_t)l * 1024 * NIN, 1024, NIN, nullptr, WinT + (size_t)l * NP * 1024, NP / 32, r, lane, scr, MapIn{}); continue; } r -= I_IN;
        if (r < I_UQ) { tr_item(p.w_uq + (size_t)l * 256 * 768, 256, 768, p.qnw + l * 256, WuqT + (size_t)l * 768 * 256, 24, r, lane, scr, MapUq{}); continue; } r -= I_UQ;
        if (r < I_UKV) { tr_item(p.w_ukv + (size_t)l * 128 * 1024, 128, 1024, p.kvnw + l * 128, WukvT + (size_t)l * 1024 * 128, 32, r, lane, scr, MapId{}); continue; } r -= I_UKV;
        tr_item(p.w_out + (size_t)l * 1024 * 1024, 1024, 1024, nullptr, WoutT + (size_t)l * 1024 * 1024, 32, r, lane, scr, MapId{});
    }
    if (PARTS & 4) { const int j = (int)(c.gt & 31); const double inv = pow(10000.0, -(double)j / 32.0) * 0.15915494309189535;
      for (long i = c.gt; i < (long)T * 32; i += c.GT) { const int t = (int)(i >> 5); const double tr = (double)p.pos[t] * inv; const float fr = (float)(tr - rint(tr));
          CS32[i] = make_float2(__builtin_amdgcn_cosf(fr), __builtin_amdgcn_sinf(fr)); } }
    if (PARTS & 4) { const int j = (int)(c.gt & 15); const double inv = pow(10000.0, -(double)j / 16.0) * 0.15915494309189535;
      for (long i = c.gt; i < (long)T * 16; i += c.GT) { const int t = (int)(i >> 4); const double tr = (double)p.pos[t] * inv; const float fr = (float)(tr - rint(tr));
          CS16[i] = make_float2(__builtin_amdgcn_cosf(fr), __builtin_amdgcn_sinf(fr)); } }
}

__device__ __forceinline__ float sumsq4(f32x4 v) { return v.x * v.x + v.y * v.y + v.z * v.z + v.w * v.w; }
__device__ __forceinline__ f32x4 bf4_to_f32(u32x2 w) { return (f32x4){__builtin_bit_cast(float, w.x << 16), __builtin_bit_cast(float, w.x & 0xffff0000u), __builtin_bit_cast(float, w.y << 16), __builtin_bit_cast(float, w.y & 0xffff0000u)}; }
template <bool XBF, int NR>
__device__ __forceinline__ void ph_norm(const Ctx& c, const void* xv, const float* nw, const float* ADA_l, bf16_t* H) {
    const int lane = c.lane;
    for (int row0 = c.gw * NR; row0 < T; row0 += c.NGW * NR) {
        f32x4 v[NR][4]; float s[NR];
#pragma unroll
        for (int r = 0; r < NR; ++r) {
            if (XBF) { const u32x2* xr = (const u32x2*)((const bf16_t*)xv + (size_t)(row0 + r) * D) + lane;
#pragma unroll
                for (int j = 0; j < 4; ++j) v[r][j] = bf4_to_f32(xr[64 * j]); }
            else { const f32x4* xr = (const f32x4*)((const float*)xv + (size_t)(row0 + r) * D) + lane;
#pragma unroll
                for (int j = 0; j < 4; ++j) v[r][j] = xr[64 * j]; } }
#pragma unroll
        for (int r = 0; r < NR; ++r) s[r] = sumsq4(v[r][0]) + sumsq4(v[r][1]) + sumsq4(v[r][2]) + sumsq4(v[r][3]);
#pragma unroll
        for (int o = 1; o < 64; o <<= 1) {
#pragma unroll
            for (int r = 0; r < NR; ++r) s[r] += __shfl_xor(s[r], o); }
        const int b = row0 / S;
        const float* shift = ADA_l + (size_t)b * 3072; const float* scale = shift + 1024;
#pragma unroll
        for (int j = 0; j < 4; ++j) {
            const int c0 = 4 * lane + 256 * j; const f32x4 w = *(const f32x4*)(nw + c0), sc = *(const f32x4*)(scale + c0), sh = *(const f32x4*)(shift + c0);
            const f32x4 ws = w * (sc + 1.f);
#pragma unroll
            for (int r = 0; r < NR; ++r) { const float rstd = rsqrtf(s[r] * (1.f / D) + EPS);
                const f32x4 y = v[r][j] * rstd * ws + sh;
                u32x2 pk; pk.x = cvt_pk_bf16(y.x, y.y); pk.y = cvt_pk_bf16(y.z, y.w); ((u32x2*)(H + (size_t)(row0 + r) * D) + lane)[64 * j] = pk; }
        }
    }
}

template <int NR>
__device__ __forceinline__ void ph_final(const Ctx& c, const bf16_t* x, const float* w, float* out) {
    const int lane = c.lane;
    for (int row0 = c.gw * NR; row0 < T; row0 += c.NGW * NR) {
        f32x4 v[NR][4]; float s[NR];
#pragma unroll
        for (int r = 0; r < NR; ++r) { const u32x2* xr = (const u32x2*)(x + (size_t)(row0 + r) * D) + lane;
#pragma unroll
            for (int j = 0; j < 4; ++j) v[r][j] = bf4_to_f32(xr[64 * j]); }
#pragma unroll
        for (int r = 0; r < NR; ++r) s[r] = sumsq4(v[r][0]) + sumsq4(v[r][1]) + sumsq4(v[r][2]) + sumsq4(v[r][3]);
#pragma unroll
        for (int o = 1; o < 64; o <<= 1) {
#pragma unroll
            for (int r = 0; r < NR; ++r) s[r] += __shfl_xor(s[r], o); }
#pragma unroll
        for (int j = 0; j < 4; ++j) { const f32x4 ww = *(const f32x4*)(w + 4 * lane + 256 * j);
#pragma unroll
            for (int r = 0; r < NR; ++r) { const float rstd = rsqrtf(s[r] * (1.f / D) + EPS); ((f32x4*)(out + (size_t)(row0 + r) * D) + lane)[64 * j] = v[r][j] * rstd * ww; } }
    }
}

__device__ __forceinline__ u32x4 pack8bf(f32x4 a, f32x4 b) { u32x4 w; w.x = cvt_pk_bf16(a.x, a.y); w.y = cvt_pk_bf16(a.z, a.w); w.z = cvt_pk_bf16(b.x, b.y); w.w = cvt_pk_bf16(b.z, b.w); return w; }
__device__ __forceinline__ float silu_fast(float x) { return x * __builtin_amdgcn_rcpf(1.f + __builtin_amdgcn_exp2f(-1.4426950408889634f * x)); }
__device__ __forceinline__ f32x4 rope4(f32x4 v, f32x4 cs) { f32x4 o; o.x = v.x * cs.x - v.y * cs.y; o.y = v.y * cs.x + v.x * cs.y; o.z = v.z * cs.z - v.w * cs.w; o.w = v.w * cs.z + v.z * cs.w; return o; }
__device__ __forceinline__ f32x4 silu4(f32x4 v) { v.x = silu_fast(v.x); v.y = silu_fast(v.y); v.z = silu_fast(v.z); v.w = silu_fast(v.w); return v; }
typedef f32x4 acc_t[2][2][4][2];
struct EpiIn {
    bf16_t* PROJ; float* GG; const float2* CS32; const float2* CS16; float* SSP; bf16_t* MQF; bf16_t* MKVF; bf16_t* KPE;
    template <int NKS> __device__ __forceinline__ void rows_ss(const acc_t& acc, int bj, int row0, int dcol, int slice, bf16_t* F) const {
        const unsigned fbase = (((unsigned)(row0 >> 5) * NKS + (dcol >> 4)) * 2 + ((dcol >> 3) & 1)) * 256 + (row0 & 15) * 8;
#pragma unroll
        for (int i = 0; i < 8; ++i) { const int ai = i >> 2, m = i & 3; const int row = row0 + ai * 128 + m * 16; const f32x4 a = acc[ai][bj][m][0], b = acc[ai][bj][m][1];
            float ss = sumsq4(a) + sumsq4(b); ss += __shfl_xor(ss, 16); ss += __shfl_xor(ss, 32);
            if ((dcol & 31) == 0) SSP[(unsigned)row * 12 + slice] = ss;
            *(u32x4*)(F + (fbase + (unsigned)((ai * 4 + (m >> 1)) * (NKS * 512) + (m & 1) * 128))) = pack8bf(a, b);
            if (i & 1) asm volatile("" ::: "memory"); }
    }
    template <int MODE> __device__ __forceinline__ void rows(const acc_t& acc, int bj, int row0, int col, float sc) const {
#pragma unroll
        for (int i = 0; i < 8; ++i) { const int ai = i >> 2, m = i & 3; const int row = row0 + ai * 128 + m * 16; f32x4 a = acc[ai][bj][m][0], b = acc[ai][bj][m][1];
            if (MODE == 1) { a = silu4(a); b = silu4(b); }
            if (MODE == 2) { const f32x4* p = (const f32x4*)(CS32 + (unsigned)row * 32 + ((col & 63) >> 1)); a = rope4(a, p[0]); b = rope4(b, p[1]); }
            if (MODE == 3) { const f32x4* p = (const f32x4*)(CS16 + (unsigned)row * 16 + ((col - 1408) >> 1)); a = rope4(a, p[0]); b = rope4(b, p[1]); }
            if (MODE == 0 || MODE == 2) { a = a * sc; b = b * sc; }
            if (MODE == 3) *(u32x4*)(KPE + ((((unsigned)(row0 >> 6) + 2 * ai) * 4 + ((col - 1408) >> 3)) * 512 + ((row0 & 15) + 16 * m) * 8)) = pack8bf(a, b);
            else *(u32x4*)(PROJ + (unsigned)row * NP + col) = pack8bf(a, b);
            if (i & 1) asm volatile("" ::: "memory"); }
    }
    __device__ __forceinline__ void cols(const acc_t& acc, int bj, int row0, int colw, int c8) const {
        const int col = colw + c8;
        if (colw < 256) rows<2>(acc, bj, row0, col, 1.f);
        else if (colw < 512) rows<2>(acc, bj, row0, col, 0.125f);
        else if (colw < 768) rows<0>(acc, bj, row0, col, 1.f);
        else if (colw < 1024) rows<1>(acc, bj, row0, col, 1.f);
        else if (colw < 1280) rows_ss<16>(acc, bj, row0, col - 1024, (colw - 1024) >> 5, MQF);
        else if (colw < 1408) rows_ss<8>(acc, bj, row0, col - 1280, (colw - 1024) >> 5, MKVF);
        else if (colw < 1440) rows<3>(acc, bj, row0, col, 1.f);
        else if (colw < 1472) { if (c8 < 16) {
#pragma unroll
                for (int i = 0; i < 8; ++i) { const int ai = i >> 2, m = i & 3; f32x4* g = (f32x4*)(GG + (unsigned)(row0 + ai * 128 + m * 16) * 16 + c8); g[0] = acc[ai][bj][m][0]; g[1] = acc[ai][bj][m][1]; } } }
        else if (colw < 1536) { }
        else if (colw < 2048) rows<1>(acc, bj, row0, col, 1.f);
        else if (colw < 2176) rows<0>(acc, bj, row0, col, 1.f);
        else if (colw < 2304) rows<0>(acc, bj, row0, col, 0.17677669529663687f);
        else if (colw < 2560) rows<0>(acc, bj, row0, col, 1.f);
        else rows<1>(acc, bj, row0, col, 1.f);
    }
};
struct EpiQ {
    bf16_t* Q; const float* RSQ; const float2* CS16;
    template <bool ROPE> __device__ __forceinline__ void rows(const acc_t& acc, int bj, int row0, int col) const {
#pragma unroll
        for (int ai = 0; ai < 2; ++ai) {
            float rs[4]; f32x4 cs[4][2];
#pragma unroll
            for (int m = 0; m < 4; ++m) { const int row = row0 + ai * 128 + m * 16; { const f32x4* sp = (const f32x4*)(RSQ + (unsigned)row * 12); const f32x4 s0 = sp[0], s1 = sp[1]; rs[m] = rsqrtf(((s0.x + s0.y) + (s0.z + s0.w) + (s1.x + s1.y) + (s1.z + s1.w)) * (1.f / 256.f) + EPS) * QSCALE; }
                if (ROPE) { const f32x4* p = (const f32x4*)(CS16 + (unsigned)row * 16 + ((col % 96 - 64) >> 1)); cs[m][0] = p[0]; cs[m][1] = p[1]; } }
#pragma unroll
            for (int m = 0; m < 4; ++m) { f32x4 a = acc[ai][bj][m][0], b = acc[ai][bj][m][1];
                if (ROPE) { a = rope4(a, cs[m][0]); b = rope4(b, cs[m][1]); }
                *(u32x4*)(Q + (unsigned)(row0 + ai * 128 + m * 16) * 768 + col) = pack8bf(a * rs[m], b * rs[m]); }
        }
    }
    __device__ __forceinline__ void cols(const acc_t& acc, int bj, int row0, int colw, int c8) const {
        if (colw % 96 == 64) rows<true>(acc, bj, row0, colw + c8); else rows<false>(acc, bj, row0, colw + c8);
    }
};
struct EpiKV {
    bf16_t* KV; const float* RSKV;
    __device__ __forceinline__ void cols(const acc_t& acc, int bj, int row0, int colw, int c8) const {
        float rs[8];
#pragma unroll
        for (int i = 0; i < 8; ++i) { const f32x4 s = *(const f32x4*)(RSKV + (unsigned)(row0 + (i >> 2) * 128 + (i & 3) * 16) * 12 + 8); rs[i] = rsqrtf(((s.x + s.y) + (s.z + s.w)) * (1.f / 128.f) + EPS); }
#pragma unroll
        for (int i = 0; i < 8; ++i) { const int ai = i >> 2, m = i & 3;
            *(u32x4*)(KV + (unsigned)(row0 + ai * 128 + m * 16) * 1024 + colw + c8) = pack8bf(acc[ai][bj][m][0] * rs[i], acc[ai][bj][m][1] * rs[i]); }
    }
};
template <bool XBF> struct EpiOut {
    const void* xi; bf16_t* xo; const float* ADA_l;
    __device__ __forceinline__ void cols(const acc_t& acc, int bj, int row0, int colw, int c8) const {
        const int col = colw + c8; const int bb = row0 / S;
        const f32x4* gp = (const f32x4*)(ADA_l + (unsigned)bb * 3072 + 2048 + col); const f32x4 g0 = gp[0], g1 = gp[1];
#pragma unroll
        for (int half = 0; half < 2; ++half) {
            f32x4 x0[4], x1[4];
#pragma unroll
            for (int m = 0; m < 4; ++m) { const size_t off = (unsigned)(row0 + half * 128 + m * 16) * D + col;
                if (XBF) { const u32x4 w = *(const u32x4*)((const bf16_t*)xi + off); x0[m] = bf4_to_f32((u32x2){w.x, w.y}); x1[m] = bf4_to_f32((u32x2){w.z, w.w}); }
                else { const f32x4* xv = (const f32x4*)((const float*)xi + off); x0[m] = xv[0]; x1[m] = xv[1]; } }
#pragma unroll
            for (int m = 0; m < 4; ++m) *(u32x4*)(xo + (unsigned)(row0 + half * 128 + m * 16) * D + col) = pack8bf(x0[m] + g0 * acc[half][bj][m][0], x1[m] + g1 * acc[half][bj][m][1]);
        }
    }
};

namespace pg8 {
#define PG8_LAS __attribute__((address_space(3)))
constexpr int BM = 256, BK = 64, HALF = 128, HTB = HALF * BK * 2  , STAGE_BYTES = 8 * HTB, NXCD = 8, WGM = 8;

__host__ __device__ __forceinline__ int lds_byte(int r, int c) { const int st = (r >> 4) * 2 + (c >> 5), rr = r & 15, cc = c & 31, ob = rr * 64 + cc * 2; return st * 1024 + (ob ^ (((ob >> 9) & 1) << 5)); }
__host__ __device__ __forceinline__ void stage_rc(int b, int& R, int& C) { const int st = b / 1024, sb = b % 1024, swz = sb ^ (((sb >> 9) & 1) << 5); R = (st >> 1) * 16 + swz / 64; C = (st & 1) * 32 + (swz % 64) / 2; }
__host__ __device__ __forceinline__ int perm32(int rho) { const int n = rho >> 4, i = rho & 15; return 8 * (i >> 2) + 4 * n + (i & 3); }

struct Unit { int pm, pn; };
struct Gemm { const bf16_t* A; const bf16_t* Bt; int M, N, K, lda; };

struct StaticOrder {
    int nM, nN, nwg, G, c;
    __host__ __device__ void init(int M, int N, int G_, int c_) { nM = M / BM; nN = N / BM; nwg = nM * nN; G = G_; c = c_; }
    __host__ __device__ bool next(int i, Unit& u) const {
        const long L = (long)i * G + c; if (L >= nwg) return false;
        int wgid = (int)L; { const int q = nwg / NXCD, r = nwg % NXCD, xcd = wgid % NXCD, off = wgid / NXCD; wgid = (xcd < r ? xcd * (q + 1) : r * (q + 1) + (xcd - r) * q) + off; }
        const int nig = WGM * nN, gid = wgid / nig, fm = gid * WGM, gsz = (nM - fm) < WGM ? (nM - fm) : WGM;
        u.pm = fm + ((wgid % nig) % gsz); u.pn = (wgid % nig) / gsz; return true;
    }
    __device__ __forceinline__ void a_ready(const Unit&) const {}
    __device__ __forceinline__ void done(const Unit&) const {}
};

template <class Epi, class Sched, bool ALIGN_EPI = false, bool SP2 = false>
__device__ __forceinline__ void gemm_phase(PG8_LAS unsigned char* lds, const Gemm g, const Sched& S, const Epi& E) {
    int tid_ = threadIdx.x; asm volatile("" : "+v"(tid_));
    const int tid = tid_, wid = __builtin_amdgcn_readfirstlane(tid >> 6), lane = tid & 63, wr = wid >> 2, wc = wid & 3, fr = lane & 15, fq = lane >> 4;
    const int K = g.K, nt = K / BK;
    unsigned voffA[2], voffB[2];
#pragma unroll
    for (int i = 0; i < 2; ++i) { int R, C; stage_rc(tid * 16 + i * 8192, R, C); const int Rb = Epi::PERM ? ((R & ~31) + perm32(R & 31)) : R;
        voffA[i] = (unsigned)(R * g.lda + C) * 2u; voffB[i] = (unsigned)(Rb * K + C) * 2u; }
    const size_t kstep = (size_t)(BK * 2);
    const size_t hstep = (size_t)HALF * K * 2;
    const size_t tstep = 2 * hstep; const size_t hstepA = (size_t)HALF * g.lda * 2, tstepA = 2 * hstepA;
    const unsigned ldsw = (unsigned)wid * 1024u;
    const int aoff = lds_byte(wr * 64 + fr, fq * 8), boff = lds_byte(wc * 32 + fr, fq * 8);
#define PG8_SA(b, h) (((b) * 2 + (h)) * HTB)
#define PG8_SB(b, h) ((4 + (b) * 2 + (h)) * HTB)
#define PG8_STAGE(bufoff, gbase, voff) do { _Pragma("unroll") for (int _i = 0; _i < 2; ++_i) \
        __builtin_amdgcn_global_load_lds((const unsigned*)((const char*)(gbase) + (voff)[_i]), (PG8_LAS unsigned*)(lds + (bufoff) + ldsw + _i * 8192), 16, 0, 0); } while (0)
#define PG8_LDA(dst, b, h) do { _Pragma("unroll") for (int m = 0; m < 4; ++m) _Pragma("unroll") for (int k = 0; k < 2; ++k) dst[m][k] = *(const PG8_LAS bf16x8*)(lds + PG8_SA(b, h) + aoff + m * 2048 + k * 1024); } while (0)
#define PG8_LDB(dst, b, h) do { _Pragma("unroll") for (int n = 0; n < 2; ++n) _Pragma("unroll") for (int k = 0; k < 2; ++k) dst[n][k] = *(const PG8_LAS bf16x8*)(lds + PG8_SB(b, h) + boff + n * 2048 + k * 1024); } while (0)
#define PG8_MMA(ai, bj, At, Bt) do { __builtin_amdgcn_s_setprio(1); _Pragma("unroll") for (int m = 0; m < 4; ++m) _Pragma("unroll") for (int n = 0; n < 2; ++n) _Pragma("unroll") for (int k = 0; k < 2; ++k) \
        acc[ai][bj][m][n] = __builtin_amdgcn_mfma_f32_16x16x32_bf16(Bt[n][k], At[m][k], acc[ai][bj][m][n], 0, 0, 0); __builtin_amdgcn_s_setprio(0); } while (0)
#define PG8_WAIT_V(n) asm volatile("s_waitcnt vmcnt(" #n ")" ::: "memory")
#define PG8_WAIT_L(n) asm volatile("s_waitcnt lgkmcnt(" #n ")" ::: "memory")
#define PG8_BAR __builtin_amdgcn_s_barrier()
#define PG8_SCHED __builtin_amdgcn_sched_barrier(0)
    Unit cur, nxt; int ui = 0;
    if (!S.next(0, cur)) return;
    f32x4 acc[2][2][4][2];
#pragma unroll
    for (int a = 0; a < 2; ++a)
#pragma unroll
        for (int b = 0; b < 2; ++b)
#pragma unroll
            for (int m = 0; m < 4; ++m)
#pragma unroll
                for (int n = 0; n < 2; ++n) acc[a][b][m][n] = (f32x4){0.f, 0.f, 0.f, 0.f};
    bf16x8 At[4][2], B0[2][2], B1[2][2];
    const char* cA = (const char*)g.A + (size_t)cur.pm * tstepA; const char* cB = (const char*)g.Bt + (size_t)cur.pn * tstep;
    S.a_ready(cur);
    if constexpr (SP2) {
        PG8_STAGE(PG8_SB(0, 0), cB, voffB); PG8_STAGE(PG8_SB(0, 1), cB + hstep, voffB); PG8_STAGE(PG8_SA(0, 0), cA, voffA); PG8_STAGE(PG8_SA(0, 1), cA + hstepA, voffA);
        if (wr == 1) PG8_BAR;
        PG8_WAIT_V(2); PG8_BAR;
        PG8_STAGE(PG8_SB(1, 0), cB + kstep, voffB); PG8_STAGE(PG8_SA(1, 0), cA + kstep, voffA); PG8_STAGE(PG8_SB(1, 1), cB + hstep + kstep, voffB);
        PG8_WAIT_V(6); PG8_BAR;
    } else {
        PG8_STAGE(PG8_SB(0, 0), cB, voffB); PG8_STAGE(PG8_SA(0, 0), cA, voffA); PG8_STAGE(PG8_SB(0, 1), cB + hstep, voffB); PG8_STAGE(PG8_SA(0, 1), cA + hstepA, voffA);
        if (wr == 1) PG8_BAR;
        PG8_WAIT_V(4); PG8_BAR;
        PG8_STAGE(PG8_SB(1, 0), cB + kstep, voffB); PG8_STAGE(PG8_SA(1, 0), cA + kstep, voffA); PG8_STAGE(PG8_SB(1, 1), cB + hstep + kstep, voffB);
        PG8_WAIT_V(6); PG8_BAR;
    }
    for (;;) {
        const bool has_next = S.next(ui + 1, nxt);
        const char* nA = has_next ? (const char*)g.A + (size_t)nxt.pm * tstepA : cA; const char* nB = has_next ? (const char*)g.Bt + (size_t)nxt.pn * tstep : cB;
        for (int t = 0; t < nt; t += 2) {
            const bool last = (t == nt - 2);
            const char* a1 = cA + (size_t)(t + 1) * kstep;
            const char* a2 = last ? nA : cA + (size_t)(t + 2) * kstep; const char* b2 = last ? nB : cB + (size_t)(t + 2) * kstep;
            const char* a3 = a2 + kstep; const char* b3 = b2 + kstep;
            if (last && has_next) S.a_ready(nxt);
            if constexpr (SP2) {
            PG8_LDB(B0, 0, 0); PG8_LDB(B1, 0, 1); PG8_SCHED; PG8_LDA(At, 0, 0); PG8_STAGE(PG8_SA(1, 1), a1 + hstepA, voffA);
            PG8_WAIT_V(8); PG8_WAIT_L(0); PG8_BAR; PG8_MMA(0, 0, At, B0); PG8_MMA(0, 1, At, B1); PG8_BAR; PG8_SCHED;
            PG8_LDA(At, 0, 1); PG8_STAGE(PG8_SB(0, 0), b2, voffB); PG8_STAGE(PG8_SB(0, 1), b2 + hstep, voffB); PG8_STAGE(PG8_SA(0, 0), a2, voffA);
            PG8_WAIT_V(8); PG8_WAIT_L(0); PG8_BAR; PG8_MMA(1, 0, At, B0); PG8_MMA(1, 1, At, B1); PG8_BAR; PG8_SCHED;
            PG8_LDB(B0, 1, 0); PG8_LDB(B1, 1, 1); PG8_SCHED; PG8_LDA(At, 1, 0); PG8_STAGE(PG8_SA(0, 1), a2 + hstepA, voffA);
            PG8_WAIT_V(8); PG8_WAIT_L(0); PG8_BAR; PG8_MMA(0, 0, At, B0); PG8_MMA(0, 1, At, B1); PG8_BAR; PG8_SCHED;
            PG8_LDA(At, 1, 1); PG8_STAGE(PG8_SB(1, 0), b3, voffB); PG8_STAGE(PG8_SB(1, 1), b3 + hstep, voffB); PG8_STAGE(PG8_SA(1, 0), a3, voffA);
            PG8_WAIT_V(8); PG8_WAIT_L(0); PG8_BAR; PG8_MMA(1, 0, At, B0); PG8_MMA(1, 1, At, B1); PG8_BAR; PG8_SCHED;
            } else {
            PG8_LDB(B0, 0, 0); PG8_SCHED; PG8_LDA(At, 0, 0); PG8_STAGE(PG8_SA(1, 1), a1 + hstepA, voffA);
            PG8_WAIT_L(8); PG8_BAR; PG8_WAIT_L(0); PG8_MMA(0, 0, At, B0); PG8_BAR; PG8_SCHED;
            PG8_LDB(B1, 0, 1); PG8_STAGE(PG8_SB(0, 0), b2, voffB);
            PG8_BAR; PG8_WAIT_L(0); PG8_MMA(0, 1, At, B1); PG8_BAR;
            PG8_LDA(At, 0, 1); PG8_STAGE(PG8_SA(0, 0), a2, voffA);
            PG8_BAR; PG8_WAIT_L(0); PG8_MMA(1, 0, At, B0); PG8_BAR; PG8_SCHED;
            PG8_STAGE(PG8_SB(0, 1), b2 + hstep, voffB);
            PG8_WAIT_V(6); PG8_BAR; PG8_MMA(1, 1, At, B1); PG8_BAR;
            PG8_LDB(B0, 1, 0); PG8_SCHED; PG8_LDA(At, 1, 0); PG8_STAGE(PG8_SA(0, 1), a2 + hstepA, voffA);
            PG8_WAIT_L(8); PG8_BAR; PG8_WAIT_L(0); PG8_MMA(0, 0, At, B0); PG8_BAR; PG8_SCHED;
            PG8_LDB(B1, 1, 1); PG8_STAGE(PG8_SB(1, 0), b3, voffB);
            PG8_BAR; PG8_WAIT_L(0); PG8_MMA(0, 1, At, B1); PG8_BAR;
            PG8_LDA(At, 1, 1); PG8_STAGE(PG8_SA(1, 0), a3, voffA);
            PG8_BAR; PG8_WAIT_L(0); PG8_MMA(1, 0, At, B0); PG8_BAR; PG8_SCHED;
            PG8_STAGE(PG8_SB(1, 1), b3 + hstep, voffB);
            PG8_WAIT_V(6); PG8_BAR; PG8_MMA(1, 1, At, B1); PG8_BAR;
            }
        }
        if constexpr (ALIGN_EPI) { if (wr == 0) PG8_BAR; }
        if constexpr (!Epi::AFTER_DRAIN) { E(acc, cur, wr, wc, fr, fq); S.done(cur); }
        if (!has_next) break;
#pragma unroll
        for (int a = 0; a < 2; ++a)
#pragma unroll
            for (int b = 0; b < 2; ++b)
#pragma unroll
                for (int m = 0; m < 4; ++m)
#pragma unroll
                    for (int n = 0; n < 2; ++n) acc[a][b][m][n] = (f32x4){0.f, 0.f, 0.f, 0.f};
        cur = nxt; cA = nA; cB = nB; ++ui;
        if constexpr (ALIGN_EPI) { if (wr == 1) PG8_BAR; }
    }
    PG8_WAIT_V(0);
    if constexpr (!ALIGN_EPI) { if (wr == 0) PG8_BAR; }
    PG8_BAR;
    if constexpr (Epi::AFTER_DRAIN) { E.fused(acc, cur, wr, wc, fr, fq, lds, wid, lane); S.done(cur); }
#undef PG8_SA
#undef PG8_SB
#undef PG8_STAGE
#undef PG8_LDA
#undef PG8_LDB
#undef PG8_MMA
#undef PG8_WAIT_V
#undef PG8_WAIT_L
#undef PG8_BAR
#undef PG8_SCHED
}
}

template <class E> struct EpiAd {
    static constexpr bool PERM = true, AFTER_DRAIN = false;
    E e;
    __device__ __forceinline__ void operator()(const f32x4 (&acc)[2][2][4][2], const pg8::Unit& u, int wr, int wc, int fr, int fq) const {
        const int row0 = u.pm * 256 + wr * 64 + fr;
#pragma unroll
        for (int bj = 0; bj < 2; ++bj) e.cols(acc, bj, row0, __builtin_amdgcn_readfirstlane(u.pn * 256 + bj * 128 + wc * 32), 8 * fq);
    }
};
template <class E> __device__ __forceinline__ void run_gemm(PG8_LAS unsigned char* lds, const bf16_t* A, int lda, const bf16_t* Bt, int M, int N, int K, const E& e) {
    int Ko = K; asm volatile("" : "+s"(Ko));
    pg8::Gemm g{A, Bt, M, N, Ko, lda}; pg8::StaticOrder S; S.init(M, N, (int)gridDim.x, (int)blockIdx.x);
    EpiAd<E> ad{e};
    if (K >= 512) pg8::gemm_phase<EpiAd<E>, pg8::StaticOrder, true, true>(lds, g, S, ad); else pg8::gemm_phase<EpiAd<E>, pg8::StaticOrder, true, false>(lds, g, S, ad);
}

template <class Epi>
__device__ __forceinline__ void gemm_wave(const Ctx& c, const bf16_t* A, int lda, const bf16_t* Bt, int M, int N, int K, const Epi& epi) {
    const int fr = c.lane & 15, fq = c.lane >> 4; const int ntn = N / 64, nt = (M / 32) * ntn;
    for (int tile = c.gw; tile < nt; tile += c.NGW) {
        const int m0 = (tile / ntn) * 32, n0 = (tile % ntn) * 64;
        f32x4 acc[2][4];
#pragma unroll
        for (int i = 0; i < 2; ++i)
#pragma unroll
            for (int j = 0; j < 4; ++j) acc[i][j] = (f32x4){0.f, 0.f, 0.f, 0.f};
        const bf16_t* ap = A + (size_t)(m0 + fr) * lda + fq * 8; const bf16_t* bp = Bt + (size_t)(n0 + fr) * K + fq * 8;
        for (int k0 = 0; k0 < K; k0 += 32) {
            bf16x8 a[2], b[4];
#pragma unroll
            for (int i = 0; i < 2; ++i) a[i] = *(const bf16x8*)(ap + (size_t)(16 * i) * lda + k0);
#pragma unroll
            for (int j = 0; j < 4; ++j) b[j] = *(const bf16x8*)(bp + (size_t)(16 * j) * K + k0);
#pragma unroll
            for (int i = 0; i < 2; ++i)
#pragma unroll
                for (int j = 0; j < 4; ++j) acc[i][j] = __builtin_amdgcn_mfma_f32_16x16x32_bf16(b[j], a[i], acc[i][j], 0, 0, 0);
        }
#pragma unroll
        for (int i = 0; i < 2; ++i)
#pragma unroll
            for (int j = 0; j < 4; ++j) epi(m0 + 16 * i + fr, n0 + 16 * j + 4 * fq, acc[i][j]);
    }
}

__device__ __forceinline__ void ph_rstd(const Ctx& c, const bf16_t* PROJ, float* RSQ, float* RSKV) {
    const int lane = c.lane;
    for (int row0 = c.gw * 8; row0 < T; row0 += c.NGW * 8) {
        u32x2 q[8]; unsigned k[8];
#pragma unroll
        for (int r = 0; r < 8; ++r) { const bf16_t* p = PROJ + (size_t)(row0 + r) * NP; q[r] = *(const u32x2*)(p + P_MQ + 4 * lane); k[r] = *(const unsigned*)(p + P_MKV + 2 * lane); }
        float s[8], s2[8];
#pragma unroll
        for (int r = 0; r < 8; ++r) { const float a0 = __builtin_bit_cast(float, q[r].x << 16), a1 = __builtin_bit_cast(float, q[r].x & 0xffff0000u), a2 = __builtin_bit_cast(float, q[r].y << 16), a3 = __builtin_bit_cast(float, q[r].y & 0xffff0000u);
            const float b0 = __builtin_bit_cast(float, k[r] << 16), b1 = __builtin_bit_cast(float, k[r] & 0xffff0000u);
            s[r] = a0 * a0 + a1 * a1 + a2 * a2 + a3 * a3; s2[r] = b0 * b0 + b1 * b1; }
#pragma unroll
        for (int o = 1; o < 64; o <<= 1) {
#pragma unroll
            for (int r = 0; r < 8; ++r) { s[r] += __shfl_xor(s[r], o); s2[r] += __shfl_xor(s2[r], o); } }
        if (lane < 8) { float sv = s[0], s2v = s2[0];
#pragma unroll
            for (int r = 1; r < 8; ++r) { if (lane == r) { sv = s[r]; s2v = s2[r]; } }
            RSQ[row0 + lane] = rsqrtf(sv * (1.f / 256.f) + EPS); RSKV[row0 + lane] = rsqrtf(s2v * (1.f / 128.f) + EPS); }
    }
}

__device__ __forceinline__ void ph_attn_naive(const Ctx& c, const bf16_t* Q, const bf16_t* KV, const bf16_t* PROJ, bf16_t* MIX) {
    const int lane = c.lane;
    for (int W = c.gw; W < (T / 64) * 16; W += c.NGW) {
        const int cgk = W >> 4, h = (W >> 1) & 7, vh = W & 1; const int t = cgk * 64 + lane; const int b = (cgk * 64) / S; const int nk = ((cgk * 64) % S) + 64; const int kb = b * S;
        float q[96];
        const bf16_t* qp = Q + (size_t)t * 768 + h * 96;
#pragma unroll
        for (int d = 0; d < 96; ++d) q[d] = bf2f(qp[d]);
        float o[32];
#pragma unroll
        for (int e = 0; e < 32; ++e) o[e] = 0.f;
        float m = -1e30f, l = 0.f;
        for (int j = 0; j < nk; ++j) {
            const bf16_t* kn = KV + (size_t)(kb + j) * 1024 + h * 128; const bf16_t* kp = PROJ + (size_t)(kb + j) * NP + P_KPE;
            float s = 0.f;
#pragma unroll
            for (int d = 0; d < 64; ++d) s = fmaf(q[d], bf2f(kn[d]), s);
#pragma unroll
            for (int d = 0; d < 32; ++d) s = fmaf(q[64 + d], bf2f(kp[d]), s);
            const float mn = fmaxf(m, s); const float sc = exp2f(m - mn), pp = exp2f(s - mn); m = mn; l = l * sc + pp;
#pragma unroll
            for (int e = 0; e < 32; ++e) o[e] = o[e] * sc + pp * bf2f(kn[64 + vh * 32 + e]);
        }
        const float rl = 1.f / l;
        const bf16_t* z = PROJ + (size_t)t * NP + P_MZ + h * 64 + vh * 32; bf16_t* mo = MIX + (size_t)t * 1024 + 256 + h * 64 + vh * 32;
#pragma unroll
        for (int e = 0; e < 32; ++e) mo[e] = (bf16_t)f2bf(o[e] * rl * bf2f(z[e]));
    }
}

__device__ __forceinline__ void ph_ret_naive(const Ctx& c, const bf16_t* PROJ, bf16_t* MIX) {
    const int lane = c.lane;
    for (int W = c.gw; W < (T / 64) * 4; W += c.NGW) {
        const int cgk = W >> 2, h = W & 3; const int t = cgk * 64 + lane; const int b = (cgk * 64) / S; const int nk = ((cgk * 64) % S) + 64; const int kb = b * S;
        const float lg = log1pf(-exp2f(-5.f - (float)h));
        float q[64];
        const bf16_t* qp = PROJ + (size_t)t * NP + P_RQ + h * 64;
#pragma unroll
        for (int d = 0; d < 64; ++d) q[d] = bf2f(qp[d]);
        float o[64];
#pragma unroll
        for (int e = 0; e < 64; ++e) o[e] = 0.f;
        const int ti = t - kb;
        for (int j = 0; j < nk; ++j) {
            const bf16_t* kr = PROJ + (size_t)(kb + j) * NP + P_RK + h * 64; const bf16_t* vr = PROJ + (size_t)(kb + j) * NP + P_RV + h * 64;
            float s = 0.f;
#pragma unroll
            for (int d = 0; d < 64; ++d) s = fmaf(q[d], bf2f(kr[d]), s);
            const int dd = ti - j; s *= __expf(lg * (float)(dd < 0 ? -dd : dd));
#pragma unroll
            for (int e = 0; e < 64; ++e) o[e] = fmaf(s, bf2f(vr[e]), o[e]);
        }
        float ss = 0.f;
#pragma unroll
        for (int e = 0; e < 64; ++e) ss += o[e] * o[e];
        const float rstd = rsqrtf(ss * (1.f / 64.f) + EPS);
        const bf16_t* z = PROJ + (size_t)t * NP + P_RZ + h * 64; bf16_t* mo = MIX + (size_t)t * 1024 + h * 64;
#pragma unroll
        for (int e = 0; e < 64; ++e) mo[e] = (bf16_t)f2bf(o[e] * rstd * bf2f(z[e]));
    }
}

__device__ __forceinline__ void ph_gla_prep(const Ctx& c, const bf16_t* PROJ, const float* GG, const float* w_g2, const float* b_g2, bf16_t* GP, __attribute__((address_space(3))) float* wl) {
    const int lane = c.lane;
    for (int i = c.tid; i < 2048 + 128; i += 512) wl[i] = i < 2048 ? w_g2[i] : b_g2[i - 2048];
    __syncthreads();
    for (int item = c.gw; item < (T / 64) * 4; item += c.NGW) {
        const int cg = item >> 2, h = item & 3; const size_t t = (size_t)cg * 64 + lane;
        const f32x4* gp4 = (const f32x4*)(GG + t * 16); const f32x4 g0 = gp4[0], g1 = gp4[1], g2 = gp4[2], g3 = gp4[3];
        const float gg[16] = {g0.x, g0.y, g0.z, g0.w, g1.x, g1.y, g1.z, g1.w, g2.x, g2.y, g2.z, g2.w, g3.x, g3.y, g3.z, g3.w};
        const u32x4* qp4 = (const u32x4*)(PROJ + t * NP + P_GQ + h * 32); const u32x4* kp4 = (const u32x4*)(PROJ + t * NP + P_GK + h * 32);
        u32x4 qw[4], kw[4];
#pragma unroll
        for (int i = 0; i < 4; ++i) { qw[i] = qp4[i]; kw[i] = kp4[i]; }
        bf16_t* out = GP + (size_t)item * GP_ITEM + lane * 8; float* ALi = (float*)(GP + (size_t)item * GP_ITEM + 5 * 64 * 32);
#pragma unroll
        for (int i = 0; i < 4; ++i) {
            float cum[8];
            { const int n0 = h * 32 + 8 * i; typedef __attribute__((address_space(3))) f32x4 lf4;
              f32x4 za = *(const lf4*)(wl + 2048 + n0), zb = *(const lf4*)(wl + 2048 + n0 + 4);
#pragma unroll
              for (int r = 0; r < 16; ++r) { const f32x4 wa = *(const lf4*)(wl + r * 128 + n0), wb = *(const lf4*)(wl + r * 128 + n0 + 4); za = za + wa * gg[r]; zb = zb + wb * gg[r]; }
              const float zz[8] = {za.x, za.y, za.z, za.w, zb.x, zb.y, zb.z, zb.w};
#pragma unroll
              for (int d = 0; d < 8; ++d) cum[d] = (fminf(zz[d], 0.f) - __logf(1.f + __expf(-fabsf(zz[d])))) * (1.f / 16.f); }
#pragma unroll
            for (int off = 1; off < 64; off <<= 1)
#pragma unroll
                for (int d = 0; d < 8; ++d) { const float tt = __shfl_up(cum[d], off); if (lane >= off) cum[d] += tt; }
            float qv[8], kv[8];
            { const unsigned qq[4] = {qw[i].x, qw[i].y, qw[i].z, qw[i].w}, kk[4] = {kw[i].x, kw[i].y, kw[i].z, kw[i].w};
#pragma unroll
              for (int j = 0; j < 4; ++j) { qv[2 * j] = __builtin_bit_cast(float, qq[j] << 16); qv[2 * j + 1] = __builtin_bit_cast(float, qq[j] & 0xffff0000u);
                  kv[2 * j] = __builtin_bit_cast(float, kk[j] << 16); kv[2 * j + 1] = __builtin_bit_cast(float, kk[j] & 0xffff0000u); } }
            float o[5][8];
#pragma unroll
            for (int d = 0; d < 8; ++d) { const float ep = __expf(cum[d]), en = __builtin_amdgcn_rcpf(ep); const float al = __shfl(ep, 63), ed = al * en;
                o[0][d] = qv[d] * ep; o[1][d] = qv[d] * en; o[2][d] = kv[d] * en; o[3][d] = kv[d] * ep; o[4][d] = kv[d] * ed;
                if (lane == 63) ALi[8 * i + d] = al; }
#pragma unroll
            for (int kd = 0; kd < 5; ++kd) { u32x4 w; w.x = cvt_pk_bf16(o[kd][0], o[kd][1]); w.y = cvt_pk_bf16(o[kd][2], o[kd][3]); w.z = cvt_pk_bf16(o[kd][4], o[kd][5]); w.w = cvt_pk_bf16(o[kd][6], o[kd][7]);
                *(u32x4*)(out + kd * (64 * 32) + i * (64 * 8)) = w; }
        }
    }
}
namespace att {
typedef short s16x4 __attribute__((ext_vector_type(4)));
typedef float f32x16 __attribute__((ext_vector_type(16)));
constexpr int KROW = 208, SHM_K = 64 * KROW, SHM_V = 64 * 64 * 2;
constexpr int L_K = 0, L_V = 2 * SHM_K, L_WS = L_V + 3 * SHM_V, L_END = L_WS + 8 * 64 * 4;
constexpr float THR = 4.f;
#define ASBAR() __builtin_amdgcn_sched_barrier(0)
__device__ __forceinline__ int crow(int r, int hi) { return (r & 3) + 8 * (r >> 2) + 4 * hi; }
__device__ __forceinline__ unsigned cvtpk(float lo, float hi) { unsigned r; asm volatile("v_cvt_pk_bf16_f32 %0, %1, %2" : "=v"(r) : "v"(lo), "v"(hi)); return r; }

__device__ __forceinline__ void partialSM(f32x16& p0, f32x16& p1, float& m_reg, float& mn, float& alpha) {
  float pmax = p0[0];
#pragma unroll
  for (int r = 1; r < 16; ++r) pmax = fmaxf(pmax, p0[r]);
#pragma unroll
  for (int r = 0; r < 16; ++r) pmax = fmaxf(pmax, p1[r]);
  { auto rr = __builtin_amdgcn_permlane32_swap(__float_as_uint(pmax), __float_as_uint(pmax), false, false);
    pmax = fmaxf(__uint_as_float(rr[0]), __uint_as_float(rr[1])); }
  if (__builtin_expect(__all(pmax - m_reg <= THR), 1)) { mn = m_reg; alpha = 1.f; }
  else { mn = fmaxf(m_reg, pmax); alpha = __builtin_amdgcn_exp2f(m_reg - mn); m_reg = mn; }
#pragma unroll
  for (int r = 0; r < 16; ++r) p0[r] = p0[r] - mn;
#pragma unroll
  for (int r = 0; r < 16; ++r) p1[r] = p1[r] - mn;
#pragma unroll
  for (int r = 0; r < 16; ++r) p0[r] = __builtin_amdgcn_exp2f(p0[r]);
}
__device__ __forceinline__ void finishSM(f32x16& p0, f32x16& p1, float alpha, float& l_reg, bf16x8& pa0, bf16x8& pa1, bf16x8& pa2, bf16x8& pa3) {
#pragma unroll
  for (int r = 0; r < 16; ++r) p1[r] = __builtin_amdgcn_exp2f(p1[r]);
  float ps = 0;
#pragma unroll
  for (int r = 0; r < 16; ++r) ps += p0[r];
#pragma unroll
  for (int r = 0; r < 16; ++r) ps += p1[r];
  { auto rr = __builtin_amdgcn_permlane32_swap(__float_as_uint(ps), __float_as_uint(ps), false, false);
    ps = __uint_as_float(rr[0]) + __uint_as_float(rr[1]); }
  l_reg = l_reg * alpha + ps;
#define PK4(P, BASE, OUT) do { unsigned a0 = cvtpk(P[BASE + 0], P[BASE + 1]), a1 = cvtpk(P[BASE + 2], P[BASE + 3]);   \
    unsigned b0 = cvtpk(P[BASE + 4], P[BASE + 5]), b1 = cvtpk(P[BASE + 6], P[BASE + 7]);                              \
    auto r0 = __builtin_amdgcn_permlane32_swap(a0, b0, false, false); auto r1 = __builtin_amdgcn_permlane32_swap(a1, b1, false, false); \
    u32x4 w = {r0[0], r1[0], r0[1], r1[1]}; OUT = *reinterpret_cast<bf16x8*>(&w); } while (0)
  PK4(p0, 0, pa0); PK4(p0, 8, pa1); PK4(p1, 0, pa2); PK4(p1, 8, pa3);
#undef PK4
}
__device__ __forceinline__ void qkt(f32x16& p0, f32x16& p1, const char* Ks, const bf16x8* qr, int r32, int hi) {
  const char* kb = Ks + r32 * KROW + hi * 16;
  const f32x16 z16 = {};
#pragma unroll
  for (int d0 = 0; d0 < 6; ++d0) {
    bf16x8 b0 = *reinterpret_cast<const bf16x8*>(kb + d0 * 32);
    bf16x8 b1 = *reinterpret_cast<const bf16x8*>(kb + 32 * KROW + d0 * 32);
    p0 = __builtin_amdgcn_mfma_f32_32x32x16_bf16(b0, qr[d0], d0 == 0 ? z16 : p0, 0, 0, 0);
    p1 = __builtin_amdgcn_mfma_f32_32x32x16_bf16(b1, qr[d0], d0 == 0 ? z16 : p1, 0, 0, 0); }
}
__device__ __forceinline__ int v_st(int k, int c) { const int kk = (k & ~0xC) | ((k & 4) << 1) | ((k & 8) >> 1); return ((kk >> 3) * 2 + (c >> 5)) * 512 + ((kk & 7) * 32 + (c & 31)) * 2; }
__device__ __forceinline__ int v_rd_base(int lane) { return ((lane & 3) << 3) | (((lane >> 2) & 3) << 6) | (((lane >> 4) & 1) << 5) | (((lane >> 5) & 1) << 8); }
constexpr int v_rd_off(int d0, int ks, int half) { return d0 * 512 + ks * 2048 + half * 1024; }
template <int OFF> __device__ __forceinline__ s16x4 tr_read(int vb) {
  s16x4 r; asm volatile("ds_read_b64_tr_b16 %0, %1 offset:%2" : "=&v"(r) : "v"(vb), "i"(OFF) : "memory"); return r;
}
template <int D0> __device__ __forceinline__ void pv_one(f32x16& od, int vb, bf16x8 pa0, bf16x8 pa1, bf16x8 pa2, bf16x8 pa3) {
  const s16x4 l0 = tr_read<v_rd_off(D0, 0, 0)>(vb), h0 = tr_read<v_rd_off(D0, 0, 1)>(vb), l1 = tr_read<v_rd_off(D0, 1, 0)>(vb), h1 = tr_read<v_rd_off(D0, 1, 1)>(vb);
  const s16x4 l2 = tr_read<v_rd_off(D0, 2, 0)>(vb), h2 = tr_read<v_rd_off(D0, 2, 1)>(vb), l3 = tr_read<v_rd_off(D0, 3, 0)>(vb), h3 = tr_read<v_rd_off(D0, 3, 1)>(vb);
  asm volatile("s_waitcnt lgkmcnt(0)" ::: "memory"); ASBAR();
#define PK(L, H) (bf16x8){L[0], L[1], L[2], L[3], H[0], H[1], H[2], H[3]}
  od = __builtin_amdgcn_mfma_f32_32x32x16_bf16(pa0, PK(l0, h0), od, 0, 0, 0);
  od = __builtin_amdgcn_mfma_f32_32x32x16_bf16(pa1, PK(l1, h1), od, 0, 0, 0);
  od = __builtin_amdgcn_mfma_f32_32x32x16_bf16(pa2, PK(l2, h2), od, 0, 0, 0);
  od = __builtin_amdgcn_mfma_f32_32x32x16_bf16(pa3, PK(l3, h3), od, 0, 0, 0);
#undef PK
}
__device__ __forceinline__ void pv_d0(f32x16* o, int vb, bf16x8 pa0, bf16x8 pa1, bf16x8 pa2, bf16x8 pa3) {
  pv_one<0>(o[0], vb, pa0, pa1, pa2, pa3); pv_one<1>(o[1], vb, pa0, pa1, pa2, pa3);
}

__device__ __forceinline__ void attn_unit(const bf16_t* __restrict__ Q, const bf16_t* __restrict__ KV, const bf16_t* __restrict__ PROJ, bf16_t* __restrict__ MIX,
                                          int h, int tq0, int kb0, int NT, char* lds) {
  int tid_ = threadIdx.x; asm volatile("" : "+v"(tid_));
  const int tid = tid_, wid = __builtin_amdgcn_readfirstlane(tid >> 6), lane = tid & 63, r32 = lane & 31, hi = lane >> 5;
  char* V_lds = lds + L_V; char* K_lds = lds + L_K;
  float* ws = (float*)(lds + L_WS) + wid * 64; float* li_l = ws; float* al_l = ws + 32;
  const int tmax = NT - 4 + (wid >> 1);
  float m_reg = -1e30f, l_reg = 0; f32x16 o[2] = {}; bf16x8 qr[6];
  const bf16_t* Qw = Q + (size_t)(tq0 + wid * 32 + r32) * 768 + h * 96 + hi * 8;
#pragma unroll
  for (int d0 = 0; d0 < 6; ++d0) qr[d0] = *reinterpret_cast<const bf16x8*>(Qw + d0 * 16);
  const int srow = tid >> 3, sch = tid & 7, prow = (tid & 255) >> 2, pch = tid & 3;
  const bf16_t* Kn = KV + (size_t)(kb0 + srow) * 1024 + h * 128 + sch * 8;
  const bf16_t* Kp = PROJ + (size_t)(kb0 + prow) * NP + P_KPE + pch * 8;
  const int kst = srow * KROW + sch * 16, pst = prow * KROW + 128 + pch * 16, vst = v_st(srow, sch * 8);
  const int vb0 = (int)(uintptr_t)V_lds + v_rd_base(lane);
  struct { bf16x8 kn, vv, kp; } sr_[2];
#define SLOAD(i, k0) do { sr_[i].kn = *reinterpret_cast<const bf16x8*>(Kn + (size_t)(k0) * 1024); sr_[i].vv = *reinterpret_cast<const bf16x8*>(Kn + (size_t)(k0) * 1024 + 64); \
    sr_[i].kp = *reinterpret_cast<const bf16x8*>(Kp + (size_t)(k0) * NP); } while (0)
#define SWRITE(kb_, vo_, i) do { *(bf16x8*)(K_lds + (kb_) * SHM_K + kst) = sr_[i].kn; *(bf16x8*)(K_lds + (kb_) * SHM_K + pst) = sr_[i].kp; *(bf16x8*)(V_lds + (vo_) + vst) = sr_[i].vv; } while (0)
#define RESC(a) do { if (__any((a) < 1.f)) { if (hi == 0) al_l[r32] = (a); asm volatile("s_waitcnt lgkmcnt(0)" ::: "memory"); \
    _Pragma("unroll") for (int d = 0; d < 2; ++d) _Pragma("unroll") for (int r = 0; r < 16; ++r) o[d][r] *= al_l[crow(r, hi)]; } } while (0)
#define MASKT(P0, P1, tt) do { if (__builtin_expect(__builtin_amdgcn_readfirstlane((tt) > tmax), 0)) { _Pragma("unroll") for (int r = 0; r < 16; ++r) { P0[r] = -1e30f; P1[r] = -1e30f; } } } while (0)
#define VNEXT(x) ((x) == 2 * SHM_V ? 0 : (x) + SHM_V)
#define SGB(mask, n) __builtin_amdgcn_sched_group_barrier((mask), (n), 0)
  f32x16 pA0, pA1, pB0, pB1; float mnA, mnB, alA, alB; bf16x8 pa0, pa1, pa2, pa3;
  s16x4 vl[2][4], vh[2][4];
#define VREADS(vo_) do { const int vb_ = vb0 + (vo_); \
    vl[0][0] = tr_read<v_rd_off(0, 0, 0)>(vb_); vh[0][0] = tr_read<v_rd_off(0, 0, 1)>(vb_); vl[1][0] = tr_read<v_rd_off(1, 0, 0)>(vb_); vh[1][0] = tr_read<v_rd_off(1, 0, 1)>(vb_); \
    vl[0][1] = tr_read<v_rd_off(0, 1, 0)>(vb_); vh[0][1] = tr_read<v_rd_off(0, 1, 1)>(vb_); vl[1][1] = tr_read<v_rd_off(1, 1, 0)>(vb_); vh[1][1] = tr_read<v_rd_off(1, 1, 1)>(vb_); \
    vl[0][2] = tr_read<v_rd_off(0, 2, 0)>(vb_); vh[0][2] = tr_read<v_rd_off(0, 2, 1)>(vb_); vl[1][2] = tr_read<v_rd_off(1, 2, 0)>(vb_); vh[1][2] = tr_read<v_rd_off(1, 2, 1)>(vb_); \
    vl[0][3] = tr_read<v_rd_off(0, 3, 0)>(vb_); vh[0][3] = tr_read<v_rd_off(0, 3, 1)>(vb_); vl[1][3] = tr_read<v_rd_off(1, 3, 0)>(vb_); vh[1][3] = tr_read<v_rd_off(1, 3, 1)>(vb_); } while (0)
#define PKV(d_, k_) (bf16x8){vl[d_][k_][0], vl[d_][k_][1], vl[d_][k_][2], vl[d_][k_][3], vh[d_][k_][0], vh[d_][k_][1], vh[d_][k_][2], vh[d_][k_][3]}
#define PVMM() do { \
    o[0] = __builtin_amdgcn_mfma_f32_32x32x16_bf16(pa0, PKV(0, 0), o[0], 0, 0, 0); o[1] = __builtin_amdgcn_mfma_f32_32x32x16_bf16(pa0, PKV(1, 0), o[1], 0, 0, 0); \
    o[0] = __builtin_amdgcn_mfma_f32_32x32x16_bf16(pa1, PKV(0, 1), o[0], 0, 0, 0); o[1] = __builtin_amdgcn_mfma_f32_32x32x16_bf16(pa1, PKV(1, 1), o[1], 0, 0, 0); \
    o[0] = __builtin_amdgcn_mfma_f32_32x32x16_bf16(pa2, PKV(0, 2), o[0], 0, 0, 0); o[1] = __builtin_amdgcn_mfma_f32_32x32x16_bf16(pa2, PKV(1, 2), o[1], 0, 0, 0); \
    o[0] = __builtin_amdgcn_mfma_f32_32x32x16_bf16(pa3, PKV(0, 3), o[0], 0, 0, 0); o[1] = __builtin_amdgcn_mfma_f32_32x32x16_bf16(pa3, PKV(1, 3), o[1], 0, 0, 0); } while (0)
#define STEP_FULL(BAND, PN0, PN1, mnN, alN, PO0, PO1, alO, ks_, tt) do { \
    ASBAR(); VREADS(vrd); \
    qkt(PN0, PN1, K_lds + (ks_) * SHM_K, qr, r32, hi); \
    finishSM(PO0, PO1, alO, l_reg, pa0, pa1, pa2, pa3); \
    _Pragma("unroll") for (int g_ = 0; g_ < 12; ++g_) { SGB(0x008, 1); SGB(0x100, 1); SGB(0x002, 7); } \
    ASBAR(); asm volatile("s_waitcnt lgkmcnt(0)" ::: "memory"); ASBAR(); \
    if (BAND) { const bool msk_ = (tt) > tmax; _Pragma("unroll") for (int r = 0; r < 16; ++r) { PN0[r] = msk_ ? -1e30f : PN0[r]; PN1[r] = msk_ ? -1e30f : PN1[r]; } } \
    PVMM(); partialSM(PN0, PN1, m_reg, mnN, alN); \
    _Pragma("unroll") for (int g_ = 0; g_ < 8; ++g_) { SGB(0x008, 1); SGB(0x002, 10); } \
    ASBAR(); RESC(alN); } while (0)
#define STEP(BAND, PN0, PN1, mnN, alN, PO0, PO1, alO, ks_, tt) do { \
    if (!(BAND) || __builtin_amdgcn_readfirstlane((tt) <= tmax + 1)) STEP_FULL(BAND, PN0, PN1, mnN, alN, PO0, PO1, alO, ks_, tt); \
    vrd = VNEXT(vrd); vwr = VNEXT(vwr); \
    __syncthreads(); } while (0)
  SLOAD(0, 0); SLOAD(1, 64);
  SWRITE(0, 0, 0); SWRITE(1, SHM_V, 1);
  SLOAD(0, 2 * 64); SLOAD(1, 3 * 64);
  __syncthreads();
  qkt(pA0, pA1, K_lds, qr, r32, hi); partialSM(pA0, pA1, m_reg, mnA, alA);
  __syncthreads();
  int vrd = 0, vwr = 2 * SHM_V;
  int j = 1;
  for (; j + 1 <= NT - 4; j += 2) {
    SWRITE(0, vwr, 0); if (j + 3 < NT) SLOAD(0, (j + 3) * 64);
    STEP(false, pB0, pB1, mnB, alB, pA0, pA1, alA, 1, j);
    SWRITE(1, vwr, 1); if (j + 4 < NT) SLOAD(1, (j + 4) * 64);
    STEP(false, pA0, pA1, mnA, alA, pB0, pB1, alB, 0, j + 1);
  }
  for (; j + 1 < NT; j += 2) {
    SWRITE(0, vwr, 0); if (j + 3 < NT) SLOAD(0, (j + 3) * 64);
    STEP(true, pB0, pB1, mnB, alB, pA0, pA1, alA, 1, j);
    if (j + 2 < NT) { SWRITE(1, vwr, 1); if (j + 4 < NT) SLOAD(1, (j + 4) * 64); }
    STEP(true, pA0, pA1, mnA, alA, pB0, pB1, alB, 0, j + 1);
  }
  STEP(true, pB0, pB1, mnB, alB, pA0, pA1, alA, 1, NT - 1);
  if (__builtin_amdgcn_readfirstlane(tmax >= NT - 2)) {
    ASBAR(); VREADS(vrd); finishSM(pB0, pB1, alB, l_reg, pa0, pa1, pa2, pa3);
    ASBAR(); asm volatile("s_waitcnt lgkmcnt(0)" ::: "memory"); ASBAR(); PVMM(); }
#undef STEP_FULL
#undef STEP
#undef PVMM
#undef PKV
#undef VREADS
#undef SGB
  if (hi == 0) li_l[r32] = l_reg; asm volatile("s_waitcnt lgkmcnt(0)" ::: "memory");
  float* stg = (float*)(lds + L_END) + wid * (32 * 68);
  const size_t trow = (size_t)(tq0 + wid * 32 + (lane >> 3)); const int ch = (lane & 7) * 8;
  u32x4 zz[4];
#pragma unroll
  for (int i = 0; i < 4; ++i) zz[i] = *(const u32x4*)(PROJ + (trow + 8 * i) * NP + P_MZ + h * 64 + ch);
#pragma unroll
  for (int r = 0; r < 16; ++r) { const float rl = __builtin_amdgcn_rcpf(li_l[crow(r, hi)]); const int orow = crow(r, hi);
#pragma unroll
    for (int d0 = 0; d0 < 2; ++d0) stg[orow * 68 + d0 * 32 + r32] = o[d0][r] * rl; }
  asm volatile("s_waitcnt lgkmcnt(0)" ::: "memory");
#pragma unroll
  for (int i = 0; i < 4; ++i) { const float* sp = stg + ((lane >> 3) + 8 * i) * 68 + ch; const f32x4 a = *(const f32x4*)sp, b = *(const f32x4*)(sp + 4);
    const f32x4 za = {__builtin_bit_cast(float, zz[i].x << 16), __builtin_bit_cast(float, zz[i].x & 0xffff0000u), __builtin_bit_cast(float, zz[i].y << 16), __builtin_bit_cast(float, zz[i].y & 0xffff0000u)};
    const f32x4 zb = {__builtin_bit_cast(float, zz[i].z << 16), __builtin_bit_cast(float, zz[i].z & 0xffff0000u), __builtin_bit_cast(float, zz[i].w << 16), __builtin_bit_cast(float, zz[i].w & 0xffff0000u)};
    *(u32x4*)(MIX + (trow + 8 * i) * 1024 + 256 + h * 64 + ch) = pack8bf(a * za, b * zb); }
  __syncthreads();
#undef SLOAD
#undef SWRITE
#undef RESC
#undef MASKT
#undef VNEXT
}
__device__ __forceinline__ void attn_phase(const bf16_t* Q, const bf16_t* KV, const bf16_t* PROJ, bf16_t* MIX, char* lds) {
  const int G = gridDim.x, bx = blockIdx.x; const int v = (G % 8 == 0) ? (bx % 8) * (G / 8) + bx / 8 : bx;
  for (int bh = v; bh < NB * 8; bh += G) {
    const int b = bh >> 3, h = bh & 7;
    for (int qb = 0; qb < S / 256; ++qb) attn_unit(Q, KV, PROJ, MIX, h, b * S + qb * 256, b * S, 4 * (qb + 1), lds);
  }
}
#undef ASBAR
}

namespace chain {
#define LDS3 __attribute__((address_space(3)))
typedef short v4i16_t __attribute__((ext_vector_type(4)));
__device__ __forceinline__ bf16x8 tr2(const LDS3 char* p0, const LDS3 char* p1) {
  const v4i16_t a = __builtin_amdgcn_ds_read_tr16_b64_v4i16((LDS3 v4i16_t*)p0), b = __builtin_amdgcn_ds_read_tr16_b64_v4i16((LDS3 v4i16_t*)p1);
  return (bf16x8){a[0], a[1], a[2], a[3], b[0], b[1], b[2], b[3]};
}
__device__ __forceinline__ bf16x8 ld16(const LDS3 char* p) { return *(const LDS3 bf16x8*)p; }
__device__ __forceinline__ bf16x8 pack8(f32x4 a, f32x4 b) { return __builtin_bit_cast(bf16x8, pack8bf(a, b)); }
__device__ __forceinline__ float grp16_sum(float v) { v += __shfl_xor(v, 1); v += __shfl_xor(v, 2); v += __shfl_xor(v, 4); v += __shfl_xor(v, 8); return v; }
__device__ __forceinline__ float bflo(unsigned w) { return __builtin_bit_cast(float, w << 16); }
__device__ __forceinline__ float bfhi(unsigned w) { return __builtin_bit_cast(float, w & 0xffff0000u); }
#define MFMA16(a, b, c) __builtin_amdgcn_mfma_f32_16x16x32_bf16((a), (b), (c), 0, 0, 0)
constexpr int RS = 144, TSZ = 64 * RS;
constexpr int RS2 = 80, TSZ2 = 64 * RS2;
constexpr int OSS = 68, OSZ = 16 * OSS * 4;
constexpr int NCH = S / 64;
#define CHAIN_BAR() do { asm volatile("s_waitcnt lgkmcnt(0)" ::: "memory"); __builtin_amdgcn_s_barrier(); asm volatile("" ::: "memory"); } while (0)

#define CSB() __builtin_amdgcn_sched_barrier(0)
template <bool HASW>
__device__ __forceinline__ void out_store(const f32x4 (&o)[4], LDS3 float* os, const LDS3 char* zrow, int lane, int fr, int g, const f32x4 (&gw4)[4], bf16_t* dst) {
#pragma unroll
  for (int et = 0; et < 4; ++et)
#pragma unroll
    for (int r = 0; r < 4; ++r) os[(4 * g + r) * OSS + 16 * et + fr] = o[et][r];
  const LDS3 f32x4* rp = (const LDS3 f32x4*)(os + (lane >> 2) * OSS + 16 * (lane & 3));
  f32x4 a = rp[0], b = rp[1], c = rp[2], d = rp[3];
  const u32x4 z0 = *(const LDS3 u32x4*)zrow, z1 = *(const LDS3 u32x4*)(zrow + 16);
  CSB();
  float ss = sumsq4(a) + sumsq4(b) + sumsq4(c) + sumsq4(d);
  ss += __shfl_xor(ss, 1); ss += __shfl_xor(ss, 2);
  const float rs = rsqrtf(ss * (1.f / 64.f) + EPS);
  a = a * rs; b = b * rs; c = c * rs; d = d * rs;
  if (HASW) { a = a * gw4[0]; b = b * gw4[1]; c = c * gw4[2]; d = d * gw4[3]; }
  f32x4 za = {bflo(z0.x), bfhi(z0.x), bflo(z0.y), bfhi(z0.y)}, zb = {bflo(z0.z), bfhi(z0.z), bflo(z0.w), bfhi(z0.w)};
  f32x4 zc = {bflo(z1.x), bfhi(z1.x), bflo(z1.y), bfhi(z1.y)}, zd = {bflo(z1.z), bfhi(z1.z), bflo(z1.w), bfhi(z1.w)};
  *(u32x4*)dst = pack8bf(a * za, b * zb); *(u32x4*)(dst + 8) = pack8bf(c * zc, d * zd);
}

struct RetStage { u32x4 k, v, q, z; };
__device__ __forceinline__ void ret_chain(const bf16_t* __restrict__ PROJ, bf16_t* __restrict__ MIX, int b, int h, LDS3 char* L) {
  int tid_ = threadIdx.x; asm volatile("" : "+v"(tid_));
  const int tid = tid_, wid = __builtin_amdgcn_readfirstlane(tid >> 6), lane = tid & 63, fr = lane & 15, g = lane >> 4, q4 = fr >> 2, p4 = fr & 3;
  constexpr int O_K = 0, O_V = 2 * TSZ, O_VS = 4 * TSZ, O_Q = 6 * TSZ, O_Z = 8 * TSZ, O_ST = 10 * TSZ, O_OS = 12 * TSZ;
  int ho = h; asm volatile("" : "+s"(ho));
  const float lg = ho == 0 ? -0.031748698314580298f : ho == 1 ? -0.015748356968139112f : ho == 2 ? -0.007843177461025892f : -0.003913899321136329f;
  const int t00 = b * S;
  const int srow = tid >> 3, spc = tid & 7, sOff = srow * RS + spc * 16;
  const bf16_t* gk = PROJ + (size_t)(t00 + srow) * NP + P_RK + h * 64 + spc * 8;
  const float kwj = __expf(lg * (float)(63 - srow));
  const bool outw = wid < 4; const int rb = wid & 3;
  bf16_t* gm = MIX + (size_t)(t00 + 16 * rb + (lane >> 2)) * 1024 + h * 64 + 16 * (lane & 3);
  LDS3 float* os = (LDS3 float*)(L + O_OS + rb * OSZ);
  const int zoff = (16 * rb + (lane >> 2)) * RS + 32 * (lane & 3);
  f32x4 gw4[4] = {};
  float decay[4][4], qw[4];
#pragma unroll
  for (int jt = 0; jt < 4; ++jt)
#pragma unroll
    for (int r = 0; r < 4; ++r) { const int d = (16 * rb + fr) - (16 * jt + 4 * g + r); decay[jt][r] = __expf(lg * (float)(d < 0 ? -d : d)); }
#pragma unroll
  for (int r = 0; r < 4; ++r) qw[r] = __expf(lg * (float)(16 * rb + 4 * g + r + 1));
  const float a64 = __expf(lg * 64.f);
  f32x4 Sacc[4];
#pragma unroll
  for (int e = 0; e < 4; ++e) Sacc[e] = (f32x4){0.f, 0.f, 0.f, 0.f};
  __syncthreads();
  for (int i = tid; i < TSZ / 4; i += 512) ((LDS3 unsigned*)(L + O_ST))[i] = 0u;
  RetStage R[4];
#define RLOAD(s, nn) do { const bf16_t* gn = gk + (size_t)(nn) * 64 * NP; R[s].k = *(const u32x4*)gn; R[s].v = *(const u32x4*)(gn + 256); R[s].q = *(const u32x4*)(gn - 256); R[s].z = *(const u32x4*)(gn + 512); } while (0)
#pragma unroll
  for (int s = 0; s < 4; ++s) RLOAD(s, s);
  for (int n0 = 0; n0 < NCH; n0 += 4) {
#pragma unroll
    for (int s = 0; s < 4; ++s) {
      const int n = n0 + s, buf = s & 1;
      *(LDS3 u32x4*)(L + O_K + buf * TSZ + sOff) = R[s].k; *(LDS3 u32x4*)(L + O_V + buf * TSZ + sOff) = R[s].v;
      *(LDS3 u32x4*)(L + O_Q + buf * TSZ + sOff) = R[s].q; *(LDS3 u32x4*)(L + O_Z + buf * TSZ + sOff) = R[s].z;
      { const u32x4 vw = R[s].v;
        f32x4 lo = {bflo(vw.x), bfhi(vw.x), bflo(vw.y), bfhi(vw.y)}, hi2 = {bflo(vw.z), bfhi(vw.z), bflo(vw.w), bfhi(vw.w)};
        *(LDS3 u32x4*)(L + O_VS + buf * TSZ + sOff) = pack8bf(lo * kwj, hi2 * kwj); }
      { const int nn = (n + 4 < NCH) ? n + 4 : NCH - 1; RLOAD(s, nn); }
      CHAIN_BAR();
      const LDS3 char* KT = L + O_K + buf * TSZ; const LDS3 char* VT = L + O_V + buf * TSZ; const LDS3 char* VS = L + O_VS + buf * TSZ; const LDS3 char* QT = L + O_Q + buf * TSZ;
      if (outw) {
        const LDS3 char* STc = L + O_ST + buf * TSZ;
        const bf16x8 q0 = ld16(QT + (16 * rb + fr) * RS + 16 * g), q1 = ld16(QT + (16 * rb + fr) * RS + 64 + 16 * g);
        bf16x8 kf[4][2];
#pragma unroll
        for (int jt = 0; jt < 4; ++jt) { kf[jt][0] = ld16(KT + (16 * jt + fr) * RS + 16 * g); kf[jt][1] = ld16(KT + (16 * jt + fr) * RS + 64 + 16 * g); }
        CSB();
        f32x4 sT[4], o[4];
#pragma unroll
        for (int jt = 0; jt < 4; ++jt) { f32x4 a = (f32x4){0.f, 0.f, 0.f, 0.f}; a = MFMA16(kf[jt][0], q0, a); a = MFMA16(kf[jt][1], q1, a); sT[jt] = a; }
        bf16x8 sf[4][2], vf[4][2];
#pragma unroll
        for (int et = 0; et < 4; ++et) { sf[et][0] = ld16(STc + (16 * et + fr) * RS + 16 * g); sf[et][1] = ld16(STc + (16 * et + fr) * RS + 64 + 16 * g); }
#pragma unroll
        for (int et = 0; et < 4; ++et) {
          vf[et][0] = tr2(VT + (4 * g + q4) * RS + (16 * et + 4 * p4) * 2, VT + (16 + 4 * g + q4) * RS + (16 * et + 4 * p4) * 2);
          vf[et][1] = tr2(VT + (32 + 4 * g + q4) * RS + (16 * et + 4 * p4) * 2, VT + (48 + 4 * g + q4) * RS + (16 * et + 4 * p4) * 2); }
        CSB();
#pragma unroll
        for (int et = 0; et < 4; ++et) { f32x4 a = (f32x4){0.f, 0.f, 0.f, 0.f}; a = MFMA16(q0, sf[et][0], a); a = MFMA16(q1, sf[et][1], a); o[et] = a; }
#pragma unroll
        for (int jt = 0; jt < 4; ++jt)
#pragma unroll
          for (int r = 0; r < 4; ++r) sT[jt][r] *= decay[jt][r];
        const bf16x8 af0 = pack8(sT[0], sT[1]), af1 = pack8(sT[2], sT[3]);
#pragma unroll
        for (int et = 0; et < 4; ++et) {
#pragma unroll
          for (int r = 0; r < 4; ++r) o[et][r] *= qw[r];
          o[et] = MFMA16(af0, vf[et][0], o[et]); o[et] = MFMA16(af1, vf[et][1], o[et]); }
        out_store<false>(o, os, L + O_Z + buf * TSZ + zoff, lane, fr, g, gw4, gm + (size_t)n * 64 * 1024);
      } else {
        const int s4 = wid - 4; LDS3 char* STn = L + O_ST + (buf ^ 1) * TSZ;
        const bf16x8 kt0 = tr2(KT + (8 * g + q4) * RS + (16 * s4 + 4 * p4) * 2, KT + (8 * g + 4 + q4) * RS + (16 * s4 + 4 * p4) * 2);
        const bf16x8 kt1 = tr2(KT + (32 + 8 * g + q4) * RS + (16 * s4 + 4 * p4) * 2, KT + (32 + 8 * g + 4 + q4) * RS + (16 * s4 + 4 * p4) * 2);
        bf16x8 vs[4][2];
#pragma unroll
        for (int et = 0; et < 4; ++et) {
          vs[et][0] = tr2(VS + (8 * g + q4) * RS + (16 * et + 4 * p4) * 2, VS + (8 * g + 4 + q4) * RS + (16 * et + 4 * p4) * 2);
          vs[et][1] = tr2(VS + (32 + 8 * g + q4) * RS + (16 * et + 4 * p4) * 2, VS + (32 + 8 * g + 4 + q4) * RS + (16 * et + 4 * p4) * 2); }
        CSB();
#pragma unroll
        for (int et = 0; et < 4; ++et) {
          f32x4 a = Sacc[et] * a64;
          a = MFMA16(kt0, vs[et][0], a); a = MFMA16(kt1, vs[et][1], a);
          Sacc[et] = a;
          u32x2 w; w.x = cvt_pk_bf16(a[0], a[1]); w.y = cvt_pk_bf16(a[2], a[3]);
          *(LDS3 u32x2*)(STn + (16 * et + fr) * RS + (16 * s4 + 4 * g) * 2) = w;
        }
      }
    }
  }
#undef RLOAD
  __syncthreads();
}

struct GlaStage { u32x4 g0, g1, g2, v, z; };
__device__ __forceinline__ void gla_chain(const bf16_t* __restrict__ PROJ, const bf16_t* __restrict__ GP, const float* __restrict__ gnw, bf16_t* __restrict__ MIX, int b, int h, LDS3 char* L) {
  int tid_ = threadIdx.x; asm volatile("" : "+v"(tid_));
  const int tid = tid_, wid = __builtin_amdgcn_readfirstlane(tid >> 6), lane = tid & 63, fr = lane & 15, g = lane >> 4, q4 = fr >> 2, p4 = fr & 3;
  constexpr int O_QP = 0, O_QN = 2 * TSZ2, O_KN = 4 * TSZ2, O_KP = 6 * TSZ2, O_KD = 8 * TSZ2, O_V = 10 * TSZ2, O_Z = O_V + 2 * TSZ, O_ST = O_Z + 2 * TSZ, O_AL = O_ST + 2 * TSZ2, O_OS = O_AL + 256;
  const int t00 = b * S;
  const int srow = tid >> 3, spc = tid & 7, sOff = srow * RS + spc * 16;
  const bf16_t* gv = PROJ + (size_t)(t00 + srow) * NP + P_GV + h * 64 + spc * 8;
  const size_t item0 = ((size_t)(t00 >> 6)) * 4 + h;
  const bf16_t* gp = GP + item0 * GP_ITEM + (size_t)tid * 8;
  const int lpo = (tid & 63) * RS2 + ((tid >> 6) & 3) * 16;
  const int l0 = (tid >> 8) * 2 * TSZ2 + lpo;
  const int l1 = (2 + (tid >> 8)) * 2 * TSZ2 + lpo;
  const int l2 = tid < 256 ? 4 * 2 * TSZ2 + lpo : O_AL + (tid - 256) * 16;
  const int l2s = tid < 256 ? TSZ2 : 128;
  const bool has2 = tid < 264;
  const bool outw = wid < 4; const int rb = wid & 3;
  bf16_t* gm = MIX + (size_t)(t00 + 16 * rb + (lane >> 2)) * 1024 + 768 + h * 64 + 16 * (lane & 3);
  LDS3 float* os = (LDS3 float*)(L + O_OS + rb * OSZ);
  const int zoff = (16 * rb + (lane >> 2)) * RS + 32 * (lane & 3);
  f32x4 gw4[4];
#pragma unroll
  for (int i = 0; i < 4; ++i) gw4[i] = *(const f32x4*)(gnw + 16 * (lane & 3) + 4 * i);
  const int sdt = wid & 1, set0 = ((wid >> 1) & 1) * 2;
  f32x4 Sacc[2];
  Sacc[0] = (f32x4){0.f, 0.f, 0.f, 0.f}; Sacc[1] = (f32x4){0.f, 0.f, 0.f, 0.f};
  __syncthreads();
  for (int i = tid; i < TSZ2 / 4; i += 512) ((LDS3 unsigned*)(L + O_ST))[i] = 0u;
  GlaStage R[4];
#define GLOAD(s, nn) do { const bf16_t* gpn = gp + (size_t)(nn) * (4 * GP_ITEM); R[s].g0 = *(const u32x4*)gpn; R[s].g1 = *(const u32x4*)(gpn + 512 * 8); if (has2) R[s].g2 = *(const u32x4*)(gpn + 1024 * 8); \
    R[s].v = *(const u32x4*)(gv + (size_t)(nn) * 64 * NP); R[s].z = *(const u32x4*)(gv + (size_t)(nn) * 64 * NP + 256); } while (0)
#pragma unroll
  for (int s = 0; s < 4; ++s) GLOAD(s, s);
  for (int n0 = 0; n0 < NCH; n0 += 4) {
#pragma unroll
    for (int s = 0; s < 4; ++s) {
      const int n = n0 + s, buf = s & 1;
      *(LDS3 u32x4*)(L + O_V + buf * TSZ + sOff) = R[s].v; *(LDS3 u32x4*)(L + O_Z + buf * TSZ + sOff) = R[s].z;
      *(LDS3 u32x4*)(L + buf * TSZ2 + l0) = R[s].g0; *(LDS3 u32x4*)(L + buf * TSZ2 + l1) = R[s].g1; if (has2) *(LDS3 u32x4*)(L + buf * l2s + l2) = R[s].g2;
      { const int nn = (n + 4 < NCH) ? n + 4 : NCH - 1; GLOAD(s, nn); }
      CHAIN_BAR();
      const LDS3 char* VT = L + O_V + buf * TSZ;
      if (outw) {
        const LDS3 char* QP = L + O_QP + buf * TSZ2; const LDS3 char* QN = L + O_QN + buf * TSZ2; const LDS3 char* KN = L + O_KN + buf * TSZ2; const LDS3 char* KP = L + O_KP + buf * TSZ2;
        const LDS3 char* STc = L + O_ST + buf * TSZ2;
        const bf16x8 qpf = ld16(QP + (16 * rb + fr) * RS2 + 16 * g), qnf = ld16(QN + (16 * rb + fr) * RS2 + 16 * g);
        bf16x8 knf[4], kpf[4];
#pragma unroll
        for (int jt = 0; jt < 4; ++jt) { knf[jt] = ld16(KN + (16 * jt + fr) * RS2 + 16 * g); kpf[jt] = ld16(KP + (16 * jt + fr) * RS2 + 16 * g); }
        CSB();
        f32x4 past[4], fut[4], o[4];
        const f32x4 z4 = (f32x4){0.f, 0.f, 0.f, 0.f};
#pragma unroll
        for (int jt = 0; jt < 4; ++jt) { past[jt] = MFMA16(knf[jt], qpf, z4); fut[jt] = MFMA16(kpf[jt], qnf, z4); }
        bf16x8 sf[4], vf[4][2];
#pragma unroll
        for (int et = 0; et < 4; ++et) sf[et] = ld16(STc + (16 * et + fr) * RS2 + 16 * g);
#pragma unroll
        for (int et = 0; et < 4; ++et) {
          vf[et][0] = tr2(VT + (4 * g + q4) * RS + (16 * et + 4 * p4) * 2, VT + (16 + 4 * g + q4) * RS + (16 * et + 4 * p4) * 2);
          vf[et][1] = tr2(VT + (32 + 4 * g + q4) * RS + (16 * et + 4 * p4) * 2, VT + (48 + 4 * g + q4) * RS + (16 * et + 4 * p4) * 2); }
        CSB();
#pragma unroll
        for (int et = 0; et < 4; ++et) o[et] = MFMA16(qpf, sf[et], z4);
        f32x4 sT[4];
#pragma unroll
        for (int jt = 0; jt < 4; ++jt)
#pragma unroll
          for (int r = 0; r < 4; ++r) sT[jt][r] = ((16 * rb + fr) >= (16 * jt + 4 * g + r)) ? past[jt][r] : fut[jt][r];
        const bf16x8 af0 = pack8(sT[0], sT[1]), af1 = pack8(sT[2], sT[3]);
#pragma unroll
        for (int et = 0; et < 4; ++et) { o[et] = MFMA16(af0, vf[et][0], o[et]); o[et] = MFMA16(af1, vf[et][1], o[et]); }
        out_store<true>(o, os, L + O_Z + buf * TSZ + zoff, lane, fr, g, gw4, gm + (size_t)n * 64 * 1024);
      } else {
        const LDS3 char* KD = L + O_KD + buf * TSZ2; LDS3 char* STn = L + O_ST + (buf ^ 1) * TSZ2;
        const f32x4 al = *(const LDS3 f32x4*)(L + O_AL + buf * 128 + (16 * sdt + 4 * g) * 4);
        const bf16x8 kt0 = tr2(KD + (8 * g + q4) * RS2 + (16 * sdt + 4 * p4) * 2, KD + (8 * g + 4 + q4) * RS2 + (16 * sdt + 4 * p4) * 2);
        const bf16x8 kt1 = tr2(KD + (32 + 8 * g + q4) * RS2 + (16 * sdt + 4 * p4) * 2, KD + (32 + 8 * g + 4 + q4) * RS2 + (16 * sdt + 4 * p4) * 2);
        bf16x8 vv[2][2];
#pragma unroll
        for (int e2 = 0; e2 < 2; ++e2) { const int et = set0 + e2;
          vv[e2][0] = tr2(VT + (8 * g + q4) * RS + (16 * et + 4 * p4) * 2, VT + (8 * g + 4 + q4) * RS + (16 * et + 4 * p4) * 2);
          vv[e2][1] = tr2(VT + (32 + 8 * g + q4) * RS + (16 * et + 4 * p4) * 2, VT + (32 + 8 * g + 4 + q4) * RS + (16 * et + 4 * p4) * 2); }
        CSB();
#pragma unroll
        for (int e2 = 0; e2 < 2; ++e2) { const int et = set0 + e2;
          f32x4 a = Sacc[e2] * al;
          a = MFMA16(kt0, vv[e2][0], a); a = MFMA16(kt1, vv[e2][1], a);
          Sacc[e2] = a;
          u32x2 w; w.x = cvt_pk_bf16(a[0], a[1]); w.y = cvt_pk_bf16(a[2], a[3]);
          *(LDS3 u32x2*)(STn + (16 * et + fr) * RS2 + (16 * sdt + 4 * g) * 2) = w;
        }
      }
    }
  }
#undef GLOAD
  __syncthreads();
}
__device__ __forceinline__ void chain_phase(const bf16_t* PROJ, const bf16_t* GP, const float* gnw, bf16_t* MIX, LDS3 char* L) {
  const int G = gridDim.x, bx = blockIdx.x; const int v = (G % 8 == 0) ? (bx % 8) * (G / 8) + bx / 8 : bx;
  for (int c = v; c < NB * 8; c += G) {
    const int b = c >> 3, h = c & 3;
    if ((c >> 2) & 1) gla_chain(PROJ, GP, gnw, MIX, b, h, L); else ret_chain(PROJ, MIX, b, h, L);
  }
}
#undef MFMA16
}

namespace atths {
using bf16=unsigned short;
using s16x4=__attribute__((ext_vector_type(4)))short;
using f32x16=__attribute__((ext_vector_type(16)))float;
constexpr int QP=768,KVP=1024;
constexpr int NW=8,QBLK=32,QB=QBLK*NW,KVBLK=64;
__device__ __forceinline__ int crow(int r,int hi){return (r&3)+8*(r>>2)+4*hi;}
#define SBAR() __builtin_amdgcn_sched_barrier(0)
__device__ __forceinline__ void cmask(f32x16&p0,f32x16&p1,int jb,int wq){
  const float NEG=-INFINITY;
  if(jb>wq){
  #pragma unroll
  for(int r=0;r<16;++r){p0[r]=NEG;p1[r]=NEG;}}
}

constexpr int NSK=4, SLOTK=12288, NSV=3, SLOTV=8192;
constexpr int LDS_K=0, LDS_V=NSK*SLOTK, LDS_WS=LDS_V+NSV*SLOTV, LDS_W=LDS_WS+NW*64*4, LDS_WKV=LDS_W+49152, LDS_OST=0, LDS_BYTES=LDS_WKV+32768;
__device__ __forceinline__ void glds16(const void*gbase,unsigned voff,unsigned lds_dst){unsigned keep;
  asm volatile("s_mov_b32 %0, m0\n\ts_mov_b32 m0, %3\n\ts_nop 0\n\tglobal_load_lds_dwordx4 %1, %2\n\ts_mov_b32 m0, %0":"=&s"(keep):"v"(voff),"s"(gbase),"s"(lds_dst):"memory");}
__device__ __forceinline__ float max3f(float a,float b,float c){float r;asm("v_max3_f32 %0, %1, %2, %3":"=v"(r):"v"(a),"v"(b),"v"(c));return r;}
__device__ __forceinline__ float max2f(float a,float b){float r;asm("v_max_f32_e32 %0, %1, %2":"=v"(r):"v"(a),"v"(b));return r;}
__device__ __forceinline__ float fadd_s(float a,float b){float r;asm("v_add_f32_e32 %0, %1, %2":"=v"(r):"v"(a),"v"(b));return r;}
__device__ __forceinline__ float fsub_s(float a,float b){float r;asm("v_sub_f32_e32 %0, %1, %2":"=v"(r):"v"(a),"v"(b));return r;}
typedef float f32x2_t __attribute__((ext_vector_type(2))); typedef __bf16 bf16x2_t __attribute__((ext_vector_type(2)));
__device__ __forceinline__ unsigned cvtpk_s(float lo,float hi){f32x2_t v={lo,hi};bf16x2_t b=__builtin_convertvector(v,bf16x2_t);return __builtin_bit_cast(unsigned,b);}
#define WAIT_BAR(N) asm volatile("s_waitcnt vmcnt(" #N ") lgkmcnt(0)\n\ts_barrier":::"memory")

__device__ __forceinline__ void qkt(f32x16&p0,f32x16&p1,const char*Kslot,const bf16x8*qr,const f32x16&negm,int r32,int hi){
  const char*kb=Kslot+hi*1024+r32*16;
  #pragma unroll
  for(int d0=0;d0<6;++d0){
    const bf16x8 b0=*reinterpret_cast<const bf16x8*>(kb+d0*2048);
    const bf16x8 b1=*reinterpret_cast<const bf16x8*>(kb+d0*2048+512);
    if(d0==0){p0=__builtin_amdgcn_mfma_f32_32x32x16_bf16(b0,qr[0],negm,0,0,0);p1=__builtin_amdgcn_mfma_f32_32x32x16_bf16(b1,qr[0],negm,0,0,0);}
    else{p0=__builtin_amdgcn_mfma_f32_32x32x16_bf16(b0,qr[d0],p0,0,0,0);p1=__builtin_amdgcn_mfma_f32_32x32x16_bf16(b1,qr[d0],p1,0,0,0);}}
}
typedef __attribute__((address_space(3))) const char* lds_cptr;
typedef short v4i16_t __attribute__((ext_vector_type(4)));
__device__ __forceinline__ void kload8(bf16x8*kf,lds_cptr kp){
  kf[0]=*(const __attribute__((address_space(3))) bf16x8*)(kp);      kf[1]=*(const __attribute__((address_space(3))) bf16x8*)(kp+512);
  kf[2]=*(const __attribute__((address_space(3))) bf16x8*)(kp+2048); kf[3]=*(const __attribute__((address_space(3))) bf16x8*)(kp+2560);
  kf[4]=*(const __attribute__((address_space(3))) bf16x8*)(kp+4096); kf[5]=*(const __attribute__((address_space(3))) bf16x8*)(kp+4608);
  kf[6]=*(const __attribute__((address_space(3))) bf16x8*)(kp+6144); kf[7]=*(const __attribute__((address_space(3))) bf16x8*)(kp+6656);
}
__device__ __forceinline__ void kload2(bf16x8*kf,lds_cptr kp,int j){ kf[2*j]=*(const __attribute__((address_space(3))) bf16x8*)(kp+j*2048); kf[2*j+1]=*(const __attribute__((address_space(3))) bf16x8*)(kp+j*2048+512); }
__device__ __forceinline__ s16x4 vtr(lds_cptr p){ return __builtin_bit_cast(s16x4,__builtin_amdgcn_ds_read_tr16_b64_v4i16((__attribute__((address_space(3))) v4i16_t*)p)); }
__device__ __forceinline__ float rowmax(const f32x16&p0,const f32x16&p1){
  float a=max3f(p0[0],p0[1],p1[0]),b=max3f(p0[2],p0[3],p1[1]);a=max3f(a,p1[2],p1[3]);
  #pragma unroll
  for(int r=4;r<16;r+=4){a=max3f(a,p0[r],p0[r+1]);b=max3f(b,p0[r+2],p0[r+3]);a=max3f(a,p1[r],p1[r+1]);b=max3f(b,p1[r+2],p1[r+3]);}
  const float m=max2f(a,b);
  auto rr=__builtin_amdgcn_permlane32_swap(__float_as_uint(m),__float_as_uint(m),false,false);
  return max2f(__uint_as_float(rr[0]),__uint_as_float(rr[1]));
}
__device__ __forceinline__ void pv(f32x16*o,int vb,bf16x8 pa0,bf16x8 pa1,bf16x8 pa2,bf16x8 pa3){
  #pragma unroll
  for(int d0=0;d0<2;++d0){s16x4 lo[4],hi[4];
    #pragma unroll
    for(int ks=0;ks<4;++ks){
      asm volatile("ds_read_b64_tr_b16 %0,%1 offset:%c2":"=&v"(lo[ks]):"v"(vb),"i"(d0*4096+ks*1024):"memory");
      asm volatile("ds_read_b64_tr_b16 %0,%1 offset:%c2":"=&v"(hi[ks]):"v"(vb),"i"(d0*4096+ks*1024+512):"memory");}
    asm volatile("s_waitcnt lgkmcnt(0)":::"memory");SBAR();
    #define PK(k) (bf16x8){lo[k][0],lo[k][1],lo[k][2],lo[k][3],hi[k][0],hi[k][1],hi[k][2],hi[k][3]}
    o[d0]=__builtin_amdgcn_mfma_f32_32x32x16_bf16(pa0,PK(0),o[d0],0,0,0);
    o[d0]=__builtin_amdgcn_mfma_f32_32x32x16_bf16(pa1,PK(1),o[d0],0,0,0);
    o[d0]=__builtin_amdgcn_mfma_f32_32x32x16_bf16(pa2,PK(2),o[d0],0,0,0);
    o[d0]=__builtin_amdgcn_mfma_f32_32x32x16_bf16(pa3,PK(3),o[d0],0,0,0);
    #undef PK
  }
}

#ifndef ATTN_STORE16
#define ATTN_STORE16(p,v) (*(u32x4*)(p)=(v))
#endif
template<int THRL> __device__ __forceinline__ void attn_unit(int b,int h,int qb,const bf16*__restrict__ Wq,const bf16*__restrict__ Wkv,const bf16*__restrict__ MQF,const bf16*__restrict__ MKVF,const float*__restrict__ SSP,const float2*__restrict__ CS16,bf16*KT,const bf16*__restrict__ KPE,const bf16*__restrict__ PROJ,bf16*MIX,char*shm,bool first){
  int tid_=threadIdx.x; asm volatile("":"+v"(tid_));
  const int tid=tid_,lane=tid&63,r32=lane&31,hi=lane>>5; const int wid=__builtin_amdgcn_readfirstlane(tid>>6);
  const long rowbase=(long)b*S; const int q0=qb*QB;
  bf16*KTh=KT+(size_t)((b*8+h)*(S/KVBLK))*8192; const bf16*Ph=KPE+(size_t)(b*(S/KVBLK))*2048;
  const unsigned lds0=(unsigned)(uintptr_t)shm;
  float*wsf=(float*)(shm+LDS_WS)+wid*64;
  const unsigned ksrc=(unsigned)(wid*512+lane*8)*2u;
  const unsigned ksrc2=(unsigned)((wid&3)*512+lane*8)*2u;
  const unsigned vsrc=(unsigned)(4096+wid*512+lane*8)*2u;
  const unsigned kdst=lds0+LDS_K+wid*1024, kdst2=lds0+LDS_K+(8+(wid&3))*1024, vdst=lds0+LDS_V+wid*1024;
  #define DMA_K(t,slot) do{ glds16(KTh,ksrc+(unsigned)(t)*16384u,(unsigned)__builtin_amdgcn_readfirstlane(kdst+(slot))); glds16(Ph,ksrc2+(unsigned)(t)*4096u,(unsigned)__builtin_amdgcn_readfirstlane(kdst2+(slot))); }while(0)
  #define DMA_V(t,slot) glds16(KTh,vsrc+(unsigned)(t)*16384u,(unsigned)__builtin_amdgcn_readfirstlane(vdst+(slot)))
  const int vb0=(int)(lds0+LDS_V)+((lane>>4)&1)*32+(lane&3)*8+(4*hi+((lane&15)>>2))*64;
  const char*Kbase=shm+LDS_K; bf16x8 kf[8];
  const lds_cptr shm3=(lds_cptr)shm; const lds_cptr kp0=shm3+LDS_K+hi*1024+r32*16; const lds_cptr vp0=shm3+LDS_V+((lane>>4)&1)*32+(lane&3)*8+(4*hi+((lane&15)>>2))*64;
  const int NT=(q0+QB)/KVBLK;
  if(first){
    const int m_=lane&31; const int pc_=16*(m_>>4)+8*((m_>>2)&1)+4*((m_>>3)&1)+(m_&3);
    const unsigned wv=(unsigned)(pc_*256+8*hi)*2u, wv2=(unsigned)(pc_*128+8*hi)*2u;
    #pragma unroll
    for(int i=0;i<6;++i){ const int blk=wid*6+i; const int nb=blk>>4,ks=blk&15;
      glds16((const char*)Wq+(size_t)(((h*96+32*nb)*256+16*ks)*2),wv,(unsigned)__builtin_amdgcn_readfirstlane(lds0+LDS_W+blk*1024)); }
    #pragma unroll
    for(int i=0;i<4;++i){ const int blk=wid*4+i; const int nb=blk>>3,ks=blk&7;
      glds16((const char*)Wkv+(size_t)(((h*128+32*nb)*128+16*ks)*2),wv2,(unsigned)__builtin_amdgcn_readfirstlane(lds0+LDS_WKV+blk*1024)); } }
  if(qb>0){DMA_K(0,0);DMA_V(0,0);DMA_K(1,SLOTK);}
  bf16x8 qr[6];
  { const unsigned trq=(unsigned)(rowbase+q0+wid*QBLK+r32);
    bf16x8 bkv[8],bq[16];
    #pragma unroll
    for(int ks=0;ks<8;++ks)bkv[ks]=*reinterpret_cast<const bf16x8*>(MKVF+((((trq>>5)*8+ks)*2+hi)*32+r32)*8);
    const f32x4*sp=(const f32x4*)(SSP+trq*12); const f32x4 s2=sp[2];
    if(first){WAIT_BAR(0);}
    {
      f32x16 ka[4];ka[0]=f32x16{};ka[1]=f32x16{};ka[2]=f32x16{};ka[3]=f32x16{};
      const lds_cptr wk_=(lds_cptr)shm+LDS_WKV+lane*16;
      #pragma unroll
      for(int ks=0;ks<8;++ks){
        #pragma unroll
        for(int nb=0;nb<4;++nb){ const bf16x8 af=*(const __attribute__((address_space(3))) bf16x8*)(wk_+(nb*8+ks)*1024); ka[nb]=__builtin_amdgcn_mfma_f32_32x32x16_bf16(af,bkv[ks],ka[nb],0,0,0); } }
      asm volatile("":::"memory");
      #pragma unroll
      for(int ks=0;ks<16;++ks)bq[ks]=*reinterpret_cast<const bf16x8*>(MQF+((((trq>>5)*16+ks)*2+hi)*32+r32)*8);
      const float rk=rsqrtf(((s2.x+s2.y)+(s2.z+s2.w))*(1.f/128.f)+EPS);
      bf16*tb=KTh+(size_t)(4*qb+(wid>>1))*8192; const int rt=32*(wid&1)+r32;
      #pragma unroll
      for(int nb=0;nb<4;++nb){
        #pragma unroll
        for(int hf=0;hf<2;++hf){ u32x4 w;
          w.x=cvtpk_s(ka[nb][8*hf+0]*rk,ka[nb][8*hf+1]*rk); w.y=cvtpk_s(ka[nb][8*hf+2]*rk,ka[nb][8*hf+3]*rk); w.z=cvtpk_s(ka[nb][8*hf+4]*rk,ka[nb][8*hf+5]*rk); w.w=cvtpk_s(ka[nb][8*hf+6]*rk,ka[nb][8*hf+7]*rk);
          if(nb<2) *(u32x4*)(tb+((4*nb+2*hf+hi)*512+rt*8))=w;
          else     *(u32x4*)(tb+(4096+(nb-2)*2048+rt*32+(2*hf+hi)*8))=w; } } }
    const f32x4 s0=sp[0],s1=sp[1];
    const f32x4*cp=(const f32x4*)(CS16+trq*16+4*hi); const f32x4 c0=cp[0],c1=cp[1],c2=cp[4],c3=cp[5];
    f32x16 qa[3];qa[0]=f32x16{};qa[1]=f32x16{};qa[2]=f32x16{};
    const lds_cptr wp_=(lds_cptr)shm+LDS_W+lane*16;
    #pragma unroll
    for(int ks=0;ks<16;++ks){
      #pragma unroll
      for(int nb=0;nb<3;++nb){ const bf16x8 af=*(const __attribute__((address_space(3))) bf16x8*)(wp_+(nb*16+ks)*1024); qa[nb]=__builtin_amdgcn_mfma_f32_32x32x16_bf16(af,bq[ks],qa[nb],0,0,0); } }
    const float rs=rsqrtf(((s0.x+s0.y)+(s0.z+s0.w)+(s1.x+s1.y)+(s1.z+s1.w))*(1.f/256.f)+EPS)*QSCALE;
    { const f32x4 a={qa[2][0],qa[2][1],qa[2][2],qa[2][3]},b4={qa[2][4],qa[2][5],qa[2][6],qa[2][7]},c4={qa[2][8],qa[2][9],qa[2][10],qa[2][11]},d4={qa[2][12],qa[2][13],qa[2][14],qa[2][15]};
      const f32x4 ra=rope4(a,c0),rb=rope4(b4,c1),rc=rope4(c4,c2),rd=rope4(d4,c3);
      #pragma unroll
      for(int i=0;i<4;++i){qa[2][i]=ra[i];qa[2][4+i]=rb[i];qa[2][8+i]=rc[i];qa[2][12+i]=rd[i];} }
    #pragma unroll
    for(int nb=0;nb<3;++nb){
      #pragma unroll
      for(int hf=0;hf<2;++hf){ u32x4 w;
        w.x=cvtpk_s(qa[nb][8*hf+0]*rs,qa[nb][8*hf+1]*rs); w.y=cvtpk_s(qa[nb][8*hf+2]*rs,qa[nb][8*hf+3]*rs); w.z=cvtpk_s(qa[nb][8*hf+4]*rs,qa[nb][8*hf+5]*rs); w.w=cvtpk_s(qa[nb][8*hf+6]*rs,qa[nb][8*hf+7]*rs);
        qr[2*nb+hf]=__builtin_bit_cast(bf16x8,w); } } }
  WAIT_BAR(0);
  float mhat=0.f,l_reg=0.f;f32x16 o[2];o[0]=f32x16{};o[1]=f32x16{};f32x16 negm=f32x16{};asm volatile("":"+v"(negm));
  const int wq=wid>>1;
  #define CMASK(P0,P1,t) do{int jb_=(t)-(NT-4); if(jb_>=0)cmask(P0,P1,jb_,wq);}while(0)
  bool resc=false;
  #define START(P0,P1) do{ const float rm=rowmax(P0,P1); resc=false; \
    { const float dl=rm; mhat=fadd_s(mhat,dl); \
      _Pragma("unroll") for(int r=0;r<16;++r){P0[r]=fsub_s(P0[r],dl);P1[r]=fsub_s(P1[r],dl);} \
      _Pragma("unroll") for(int r=0;r<16;++r)negm[r]=-mhat; asm volatile("":"+v"(negm)); } \
    _Pragma("unroll") for(int r=0;r<16;++r)P0[r]=__builtin_amdgcn_exp2f(P0[r]); }while(0)
  #define RESC() do{ if(resc){ asm volatile("s_waitcnt lgkmcnt(0)":::"memory"); \
      _Pragma("unroll") for(int d_=0;d_<2;++d_) _Pragma("unroll") for(int r=0;r<16;++r)o[d_][r]*=wsf[crow(r,hi)]; } }while(0)
  f32x16 pA0,pA1,pB0,pB1;
  int sl_prev=0,sl_cur=0,sl_next=SLOTV;
  int kc=0,kn=SLOTK,kw=3*SLOTK;
  #define ROT() do{sl_prev=sl_cur;sl_cur=sl_next;sl_next=(sl_next==(NSV-1)*SLOTV)?0:sl_next+SLOTV; kc=kn;kn=(kn==(NSK-1)*SLOTK)?0:kn+SLOTK;kw=(kw==(NSK-1)*SLOTK)?0:kw+SLOTK;}while(0)
  if(qb>0){ DMA_K(2,2*SLOTK); WAIT_BAR(2); }
  else { DMA_K(0,0);DMA_V(0,0);DMA_K(1,SLOTK);DMA_K(2,2*SLOTK); WAIT_BAR(5); }
  qkt(pA0,pA1,Kbase,qr,negm,r32,hi);asm volatile("s_nop 15\n\ts_nop 7":"+v"(pA0),"+v"(pA1));CMASK(pA0,pA1,0);
  START(pA0,pA1);
  _Pragma("unroll") for(int r=0;r<16;++r)pA1[r]=__builtin_amdgcn_exp2f(pA1[r]);
  WAIT_BAR(0);
  DMA_K(3,3*SLOTK);DMA_V(1,SLOTV);
  ROT();
  kload8(kf,kp0+kc);
  WAIT_BAR(3);
  s16x4 vlo[8],vhi[8]; u32x4 pw0,pw1,pw2,pw3;
  #define PKW(P,B) cvtpk_s(P[B],P[B+1])
  #define PAF(k) __builtin_bit_cast(bf16x8,pw##k)
  #define VFR(i) (bf16x8){vlo[i][0],vlo[i][1],vlo[i][2],vlo[i][3],vhi[i][0],vhi[i][1],vhi[i][2],vhi[i][3]}
  #define PIN(x) asm volatile("":"+v"(x))
  #define MX3(a,b,c) __builtin_fmaxf(__builtin_fmaxf((a),(b)),(c))
  #define GAPA(MF,A0,A1,A2,A3,W0,W1,PW) do{ MF; sacc+=A0; sacc+=A1; sacc+=A2; sacc+=A3; PIN(sacc); W0; W1; PIN(PW); SBAR(); }while(0)
  #define EX(v) __builtin_amdgcn_exp2f(v)
  #define GAPB(MF,X,B) do{ MF; X[B]=EX(X[B]); X[B+1]=EX(X[B+1]); X[B+2]=EX(X[B+2]); X[B+3]=EX(X[B+3]); PIN(X); SBAR(); }while(0)
  #define VRD(i) do{ vlo[i]=vtr(vp_+(((i)>>2)*4096+((i)&3)*1024)); vhi[i]=vtr(vp_+(((i)>>2)*4096+((i)&3)*1024+512)); }while(0)
  #define KRD(G,j) do{ if(G){ kload2(kf,kp0+kn,j); SBAR(); } }while(0)
  #define STEP(C0,C1,P0,P1,t,GK,GV,GL) do{ SBAR(); \
    const lds_cptr vp_=vp0+sl_prev; const lds_cptr ke_=kp0+kc+8192; bf16x8 e0_,e1_,e2_,e3_; \
    VRD(0); SBAR(); float sacc=(P0[0]+P0[1]); \
    GAPA(C0=__builtin_amdgcn_mfma_f32_32x32x16_bf16(kf[0],qr[0],negm,0,0,0), P0[2],P0[3],P0[4],P0[5],     pw0[0]=PKW(P0,0), pw0[1]=PKW(P0,2), pw0); \
    VRD(4); SBAR(); GAPA(C1=__builtin_amdgcn_mfma_f32_32x32x16_bf16(kf[1],qr[0],negm,0,0,0), P0[6],P0[7],P0[8],P0[9],     pw0[2]=PKW(P0,4), pw0[3]=PKW(P0,6), pw0); \
    VRD(1); SBAR(); GAPA(C0=__builtin_amdgcn_mfma_f32_32x32x16_bf16(kf[2],qr[1],C0,0,0,0),   P0[10],P0[11],P0[12],P0[13], pw1[0]=PKW(P0,8), pw1[1]=PKW(P0,10), pw1); \
    VRD(5); SBAR(); GAPA(C1=__builtin_amdgcn_mfma_f32_32x32x16_bf16(kf[3],qr[1],C1,0,0,0),   P0[14],P0[15],P1[0],P1[1],   pw1[2]=PKW(P0,12),pw1[3]=PKW(P0,14), pw1); \
    e0_=*(const __attribute__((address_space(3))) bf16x8*)(ke_); e1_=*(const __attribute__((address_space(3))) bf16x8*)(ke_+512); \
    VRD(2); SBAR(); GAPA(C0=__builtin_amdgcn_mfma_f32_32x32x16_bf16(kf[4],qr[2],C0,0,0,0),   P1[2],P1[3],P1[4],P1[5],     pw2[0]=PKW(P1,0), pw2[1]=PKW(P1,2), pw2); \
    VRD(6); SBAR(); GAPA(C1=__builtin_amdgcn_mfma_f32_32x32x16_bf16(kf[5],qr[2],C1,0,0,0),   P1[6],P1[7],P1[8],P1[9],     pw2[2]=PKW(P1,4), pw2[3]=PKW(P1,6), pw2); \
    e2_=*(const __attribute__((address_space(3))) bf16x8*)(ke_+2048); e3_=*(const __attribute__((address_space(3))) bf16x8*)(ke_+2560); \
    VRD(3); SBAR(); GAPA(C0=__builtin_amdgcn_mfma_f32_32x32x16_bf16(kf[6],qr[3],C0,0,0,0),   P1[10],P1[11],P1[12],P1[13], pw3[0]=PKW(P1,8), pw3[1]=PKW(P1,10), pw3); \
    VRD(7); SBAR(); GAPA(C1=__builtin_amdgcn_mfma_f32_32x32x16_bf16(kf[7],qr[3],C1,0,0,0),   P1[14],P1[15],0.f,0.f,       pw3[2]=PKW(P1,12),pw3[3]=PKW(P1,14), pw3); \
    C0=__builtin_amdgcn_mfma_f32_32x32x16_bf16(e0_,qr[4],C0,0,0,0); C1=__builtin_amdgcn_mfma_f32_32x32x16_bf16(e1_,qr[4],C1,0,0,0); \
    C0=__builtin_amdgcn_mfma_f32_32x32x16_bf16(e2_,qr[5],C0,0,0,0); C1=__builtin_amdgcn_mfma_f32_32x32x16_bf16(e3_,qr[5],C1,0,0,0); SBAR(); \
    l_reg+=sacc; \
    if(GK){DMA_K((t)+3,kw);} if(GV){DMA_V((t)+1,sl_next);} \
    CMASK(C0,C1,t); \
    { float a=MX3(C0[0],C0[1],C1[0]),b=MX3(C0[2],C0[3],C1[1]); a=MX3(a,C1[2],C1[3]); \
      _Pragma("unroll") for(int r=4;r<16;r+=4){a=MX3(a,C0[r],C0[r+1]);b=MX3(b,C0[r+2],C0[r+3]);a=MX3(a,C1[r],C1[r+1]);b=MX3(b,C1[r+2],C1[r+3]);} \
      float rm=__builtin_fmaxf(a,b); { auto rr=__builtin_amdgcn_permlane32_swap(__float_as_uint(rm),__float_as_uint(rm),false,false); rm=__builtin_fmaxf(__uint_as_float(rr[0]),__uint_as_float(rr[1])); } \
      resc=false; \
      if(__builtin_expect(__any(rm>(float)THRL),0)){ const float dl=__builtin_fmaxf(rm,0.f); mhat+=dl; \
        _Pragma("unroll") for(int r=0;r<16;++r){C0[r]-=dl;C1[r]-=dl;} \
        _Pragma("unroll") for(int r=0;r<16;++r)negm[r]=-mhat; asm volatile("":"+v"(negm)); \
        const float f=__builtin_amdgcn_exp2f(-dl); l_reg*=f; if(hi==0)wsf[r32]=f; resc=true; } } \
    SBAR(); \
    GAPB(o[0]=__builtin_amdgcn_mfma_f32_32x32x16_bf16(PAF(0),VFR(0),o[0],0,0,0), C0,0); \
    GAPB(o[1]=__builtin_amdgcn_mfma_f32_32x32x16_bf16(PAF(0),VFR(4),o[1],0,0,0), C0,4); \
    KRD(GL,0); GAPB(o[0]=__builtin_amdgcn_mfma_f32_32x32x16_bf16(PAF(1),VFR(1),o[0],0,0,0), C0,8); \
    KRD(GL,1); GAPB(o[1]=__builtin_amdgcn_mfma_f32_32x32x16_bf16(PAF(1),VFR(5),o[1],0,0,0), C0,12); \
    KRD(GL,2); GAPB(o[0]=__builtin_amdgcn_mfma_f32_32x32x16_bf16(PAF(2),VFR(2),o[0],0,0,0), C1,0); \
    KRD(GL,3); GAPB(o[1]=__builtin_amdgcn_mfma_f32_32x32x16_bf16(PAF(2),VFR(6),o[1],0,0,0), C1,4); \
    GAPB(o[0]=__builtin_amdgcn_mfma_f32_32x32x16_bf16(PAF(3),VFR(3),o[0],0,0,0), C1,8); \
    GAPB(o[1]=__builtin_amdgcn_mfma_f32_32x32x16_bf16(PAF(3),VFR(7),o[1],0,0,0), C1,12); \
    }while(0)
  int t=1;
  #undef CMASK
  #define CMASK(P0,P1,t) do{}while(0)
  for(;t+5<NT;t+=2){
    STEP(pB0,pB1,pA0,pA1,t,true,true,true);     WAIT_BAR(3); RESC(); ROT();
    STEP(pA0,pA1,pB0,pB1,t+1,true,true,true);   WAIT_BAR(3); RESC(); ROT();
  }
  #undef CMASK
  #define CMASK(P0,P1,t) do{int jb_=(t)-(NT-4); if(jb_>=0)cmask(P0,P1,jb_,wq);}while(0)
  #define ENDW(tt) do{ if((tt)+3<NT){WAIT_BAR(3);} else if((tt)+2<NT){WAIT_BAR(1);} else {WAIT_BAR(0);} }while(0)
  for(;t+1<NT;t+=2){
    STEP(pB0,pB1,pA0,pA1,t,(t+3<NT),(t+1<NT),(t+1<NT));       ENDW(t);   RESC(); ROT();
    STEP(pA0,pA1,pB0,pB1,t+1,(t+4<NT),(t+2<NT),(t+2<NT));     ENDW(t+1); RESC(); ROT();
  }
  STEP(pB0,pB1,pA0,pA1,NT-1,false,false,false); RESC();
  { float sacc=pB0[0]+pB0[1]; _Pragma("unroll") for(int r=2;r<16;++r)sacc+=pB0[r]; _Pragma("unroll") for(int r=0;r<16;++r)sacc+=pB1[r]; l_reg+=sacc;
    pw0=(u32x4){PKW(pB0,0),PKW(pB0,2),PKW(pB0,4),PKW(pB0,6)};pw1=(u32x4){PKW(pB0,8),PKW(pB0,10),PKW(pB0,12),PKW(pB0,14)};pw2=(u32x4){PKW(pB1,0),PKW(pB1,2),PKW(pB1,4),PKW(pB1,6)};pw3=(u32x4){PKW(pB1,8),PKW(pB1,10),PKW(pB1,12),PKW(pB1,14)};
    SBAR(); pv(o,vb0+sl_cur,PAF(0),PAF(1),PAF(2),PAF(3)); }
  asm volatile("s_waitcnt lgkmcnt(0)\n\ts_barrier":::"memory");
  #undef PKW
  #undef PAF
  #undef VFR
  #undef PIN
  #undef MX3
  #undef GAPA
  #undef GAPB
  #undef EX
  #undef VRD
  #undef KRD
  #undef STEP
  #undef ENDW
  {auto rr=__builtin_amdgcn_permlane32_swap(__float_as_uint(l_reg),__float_as_uint(l_reg),false,false);l_reg=__uint_as_float(rr[0])+__uint_as_float(rr[1]);}
  if(hi==0)wsf[32+r32]=l_reg;asm volatile("s_waitcnt lgkmcnt(0)":::"memory");
  { float*stg=(float*)(shm+LDS_OST)+wid*(32*68);
    const unsigned trow=(unsigned)(rowbase+q0+wid*QBLK+(lane>>3)); const int ch=(lane&7)*8;
    u32x4 zz[4];
    #pragma unroll
    for(int i=0;i<4;++i)zz[i]=*(const u32x4*)(PROJ+(unsigned)((trow+8*i)*NP+P_MZ+h*64+ch));
    #pragma unroll
    for(int r=0;r<16;++r){const float rl=__builtin_amdgcn_rcpf(wsf[32+crow(r,hi)]);const int orow=crow(r,hi);
      #pragma unroll
      for(int d0=0;d0<2;++d0)stg[orow*68+d0*32+r32]=o[d0][r]*rl;}
    asm volatile("s_waitcnt lgkmcnt(0)":::"memory");
    #pragma unroll
    for(int i=0;i<4;++i){const float*sp=stg+((lane>>3)+8*i)*68+ch; const f32x4 a=*(const f32x4*)sp,bq=*(const f32x4*)(sp+4);
      const f32x4 za={__builtin_bit_cast(float,zz[i].x<<16),__builtin_bit_cast(float,zz[i].x&0xffff0000u),__builtin_bit_cast(float,zz[i].y<<16),__builtin_bit_cast(float,zz[i].y&0xffff0000u)};
      const f32x4 zb={__builtin_bit_cast(float,zz[i].z<<16),__builtin_bit_cast(float,zz[i].z&0xffff0000u),__builtin_bit_cast(float,zz[i].w<<16),__builtin_bit_cast(float,zz[i].w&0xffff0000u)};
      *(u32x4*)(MIX+(unsigned)((trow+8*i)*1024+256+h*64+ch))=pack8bf(a*za,bq*zb);} }
  asm volatile("s_waitcnt lgkmcnt(0)\n\ts_barrier":::"memory");
  #undef DMA_K
  #undef DMA_V
  #undef CMASK
  #undef START
  #undef RESC
  #undef ROT
}
#undef SBAR
#undef WAIT_BAR
}

__device__ __forceinline__ void mix_phase(const bf16_t* Wq, const bf16_t* Wkv, const bf16_t* MQF, const bf16_t* MKVF, const float* SSP, const float2* CS16, bf16_t* KV, const bf16_t* KPE, const bf16_t* PROJ, const bf16_t* GP, const float* gnw, bf16_t* MIX, unsigned char* lds) {
  const int G = gridDim.x, bx = blockIdx.x; const int v = (G % 8 == 0) ? (bx % 8) * (G / 8) + bx / 8 : bx;
  for (int bh = v; bh < NB * 8; bh += G) {
    const int b = bh >> 3, h = bh & 7;
    const int grp = bh & 3; const int cpos = grp == 0 ? 0 : grp == 1 ? 2 : grp == 2 ? 4 : 6;
    int qb = 0;
#pragma unroll 1
    for (int part = 0; part < 2; ++part) {
      const int qend = part == 0 ? cpos : S / 256; const int qbeg = qb;
#pragma unroll 1
      for (; qb < qend; ++qb) atths::attn_unit<8>(b, h, qb, Wq, Wkv, MQF, MKVF, SSP, CS16, KV, KPE, PROJ, MIX, (char*)lds, qb == qbeg);
      if (part == 0) { const int cb = bh >> 3, ch = bh & 3;
        if ((bh >> 2) & 1) chain::gla_chain(PROJ, GP, gnw, MIX, cb, ch, (LDS3 char*)lds); else chain::ret_chain(PROJ, MIX, cb, ch, (LDS3 char*)lds); }
    }
  }
}

#define GAS __attribute__((address_space(1)))
#define LAS __attribute__((address_space(3)))
typedef GAS unsigned gu32;
#define RLX_AGENT __ATOMIC_RELAXED, __HIP_MEMORY_SCOPE_AGENT
#define XB_TMO      128
#define XB_XCNT(j)  (256  + 64 * (j))
#define XB_XSUB(j)  (1280 + 64 * (j))
#define XB_XGEN(j)  (2304 + 64 * (j))
#define XB_TOP      3328
#define XB_TOPGEN   3392
#define XCD_BAR_WORDS 3456
#define XB_SPIN_CAP (1u << 18)

__device__ __forceinline__ unsigned xb_ld(unsigned* p)              { return __hip_atomic_load(p, __ATOMIC_RELAXED, __HIP_MEMORY_SCOPE_AGENT); }
__device__ __forceinline__ unsigned xb_add(unsigned* p, unsigned v) { return __hip_atomic_fetch_add(p, v, __ATOMIC_RELAXED, __HIP_MEMORY_SCOPE_AGENT); }
__device__ __forceinline__ unsigned xb_xcc_id() { return (unsigned)__builtin_amdgcn_s_getreg((3 << 11) | 20) & 0xFu; }
#define XB_SPIN(cond, bar) do { unsigned _sp = 0; while (cond) { __builtin_amdgcn_s_sleep(1); \
    if ((++_sp & 255u) == 0u) { if (xb_ld(&(bar)[XB_TMO])) break; if (_sp > XB_SPIN_CAP) { atomicAdd(&(bar)[XB_TMO], 1u); break; } } } } while (0)

struct XcdBarrier {
    unsigned* bar; unsigned x;
    volatile LAS unsigned* st;
};

__device__ __forceinline__ XcdBarrier xcd_barrier_post(unsigned* bar, volatile LAS unsigned* st) {
    XcdBarrier b; b.bar = bar; b.x = xb_xcc_id(); b.st = st;
    if (threadIdx.x == 0) (void)xb_add(&bar[XB_XCNT(b.x)], 1u);
    return b;
}
__device__ __forceinline__ void xcd_barrier_complete(unsigned* bar, unsigned x, unsigned& nloc, unsigned& nx) {
    const unsigned G = gridDim.x * gridDim.y * gridDim.z;
    unsigned sum, cnt, mine, sp = 0u;
    for (;;) {
        sum = 0u; cnt = 0u; mine = 0u;
#pragma unroll
        for (unsigned j = 0; j < 16; ++j) { const unsigned c = xb_ld(&bar[XB_XCNT(j)]); sum += c; cnt += (c > 0u) ? 1u : 0u; mine = (j == x) ? c : mine; }
        if (sum == G) break;
        __builtin_amdgcn_s_sleep(1);
        if ((++sp & 255u) == 0u) { if (xb_ld(&bar[XB_TMO])) break; if (sp > XB_SPIN_CAP) { atomicAdd(&bar[XB_TMO], 1u); break; } }
    }
    nloc = mine > 0u ? mine : 1u; nx = cnt > 0u ? cnt : 1u;
}

__device__ __forceinline__ void xcd_barrier(const XcdBarrier& b_) {
    XcdBarrier b = b_; asm volatile("" : "+s"(b.x));
    asm volatile("s_waitcnt vmcnt(0)" ::: "memory");
    __syncthreads();
    if (threadIdx.x == 0) {
        unsigned* bar = b.bar;
        __builtin_amdgcn_s_waitcnt(0);
        unsigned nloc = b.st[0], nx = b.st[1];
        if (nloc == 0u) { xcd_barrier_complete(bar, b.x, nloc, nx); b.st[0] = nloc; b.st[1] = nx; }
        const unsigned old = xb_add(&bar[XB_XSUB(b.x)], 1u);
        const unsigned gen = old / nloc;
        if (old + 1u == (gen + 1u) * nloc) {
            __builtin_amdgcn_fence(__ATOMIC_RELEASE, "agent");
            asm volatile("s_waitcnt vmcnt(0)" ::: "memory");
            const unsigned og = xb_add(&bar[XB_TOP], 1u);
            const unsigned tg = og / nx;
            if (og + 1u == (tg + 1u) * nx) xb_add(&bar[XB_TOPGEN], 1u);
            else XB_SPIN(xb_ld(&bar[XB_TOPGEN]) == tg, bar);
            __builtin_amdgcn_fence(__ATOMIC_ACQUIRE, "agent");
            xb_add(&bar[XB_XGEN(b.x)], 1u);
            asm volatile("s_waitcnt vmcnt(0)" ::: "memory");
        } else {
            XB_SPIN(xb_ld(&bar[XB_XGEN(b.x)]) == gen, bar);
            __builtin_amdgcn_fence(__ATOMIC_ACQUIRE, "agent");
            asm volatile("s_waitcnt vmcnt(0)" ::: "memory");
        }
    }
    __syncthreads();
}

#ifndef PROBE_STAMP
#define PROBE_STAMP 0
#endif
#ifndef PROBE_DUP
#define PROBE_DUP 0
#endif
constexpr int NTHREADS = 512;
constexpr int LDS_BYTES = 163840;
__global__ void __launch_bounds__(NTHREADS, 2) mk_fwd(Params p) {
    extern __shared__ __attribute__((aligned(16))) unsigned char lds[];
    cg::grid_group grid = cg::this_grid();
    unsigned char* ws = p.ws;
    float* ADA = (float*)(ws + WS_ADA); const float2* CS32 = (const float2*)(ws + WS_CS32); const float2* CS16 = (const float2*)(ws + WS_CS16);
    bf16_t* WinT = (bf16_t*)(ws + WS_WIN); bf16_t* WuqT = (bf16_t*)(ws + WS_WUQ); bf16_t* WukvT = (bf16_t*)(ws + WS_WUKV); bf16_t* WoutT = (bf16_t*)(ws + WS_WOUT);
    float* RSQ = (float*)(ws + WS_RSQ); float* RSKV = (float*)(ws + WS_RSKV); float* GG = (float*)(ws + WS_GG);
    bf16_t* H = (bf16_t*)(ws + WS_H); bf16_t* PROJ = (bf16_t*)(ws + WS_PROJ); bf16_t* Q = (bf16_t*)(ws + WS_Q); bf16_t* KV = (bf16_t*)(ws + WS_KV); bf16_t* MIX = (bf16_t*)(ws + WS_MIX);
    bf16_t* GP = (bf16_t*)(ws + WS_GP); float* SSP = (float*)(ws + WS_SSP);
    PG8_LAS unsigned char* ldsp = (PG8_LAS unsigned char*)lds;
    volatile LAS unsigned* MISC = (volatile LAS unsigned*)(ldsp + 163584);
    if (threadIdx.x < 32) MISC[threadIdx.x] = 0u;
    __syncthreads();
    XcdBarrier xbar = xcd_barrier_post((unsigned*)(ws + WS_CTL), MISC + 8);
#define GRID_BAR() xcd_barrier(xbar)
    unsigned long long* ts = (unsigned long long*)(ws + WS_CTL + 32768);
#if PROBE_STAMP
#define STAMP(i) do { if (blockIdx.x == 0 && threadIdx.x == 0) ts[i] = __builtin_amdgcn_s_memrealtime(); } while (0)
#else
#define STAMP(i) do { } while (0)
#endif
    STAMP(0);

    ph_prep<1>(p, mkctx(), ldsp);
#if PROBE_DUP & 64
    __syncthreads(); ph_prep<(PROBE_DUP >> 8) & 7>(p, mkctx(), ldsp);
#endif
    if (p.never) grid.sync();
    GRID_BAR();
    STAMP(1);
    ph_prep<6>(p, mkctx(), ldsp);
    ph_norm<false, 8>(mkctx(), p.x, p.norm_w, ADA, H);
#pragma unroll 1
    for (int l = 0; l < DEPTH; ++l) {
        bf16_t* X1 = (bf16_t*)p.out; bf16_t* X2 = H;
        const float* ADA_l = ADA + (size_t)l * NB * 3072;
        if (l > 0) ph_norm<true, 8>(mkctx(), X1, p.norm_w + l * D, ADA_l, H);
        GRID_BAR();
        STAMP(2 + 6 * l + 0);
        run_gemm(ldsp, H, D, WinT + (size_t)l * NP * 1024, T, NP, 1024, EpiIn{PROJ, GG, CS32, CS16, SSP, Q, Q + (size_t)T * 256, Q + (size_t)T * 384});
#if PROBE_DUP & 1
        run_gemm(ldsp, H, D, WinT + (size_t)l * NP * 1024, T, NP, 1024, EpiIn{PROJ, GG, CS32, CS16, SSP, Q, Q + (size_t)T * 256, Q + (size_t)T * 384});
#endif
        GRID_BAR();
        STAMP(2 + 6 * l + 1);
        ph_gla_prep(mkctx(), PROJ, GG, p.w_g2 + (size_t)l * 16 * 128, p.b_g2 + l * 128, GP, (__attribute__((address_space(3))) float*)ldsp);
#if PROBE_DUP & 2
        run_gemm(ldsp, PROJ + P_MQ, NP, WuqT + (size_t)l * 768 * 256, T, 768, 256, EpiQ{Q, SSP, CS16});
        run_gemm(ldsp, PROJ + P_MKV, NP, WukvT + (size_t)l * 1024 * 128, T, 1024, 128, EpiKV{KV, SSP});
#endif
        GRID_BAR();
        STAMP(2 + 6 * l + 3);
        mix_phase(WuqT + (size_t)l * 768 * 256, WukvT + (size_t)l * 1024 * 128, Q, Q + (size_t)T * 256, SSP, CS16, KV, Q + (size_t)T * 384, PROJ, GP, p.gnw + l * 64, MIX, lds);
        STAMP(16 + l);
#if PROBE_DUP & 4
        att::attn_phase(Q, KV, PROJ, MIX, (char*)lds);
#endif
#if PROBE_DUP & 8
        chain::chain_phase(PROJ, GP, p.gnw + l * 64, MIX, (LDS3 char*)lds);
#endif
        GRID_BAR();
        STAMP(2 + 6 * l + 4);
        if (l == 0) run_gemm(ldsp, MIX, 1024, WoutT + (size_t)l * 1024 * 1024, T, 1024, 1024, EpiOut<false>{p.x, X1, ADA_l});
        else run_gemm(ldsp, MIX, 1024, WoutT + (size_t)l * 1024 * 1024, T, 1024, 1024, EpiOut<true>{X1, X2, ADA_l});
        GRID_BAR();
        STAMP(2 + 6 * l + 5);
    }
    ph_final<8>(mkctx(), H, p.fnw, p.out);
#if PROBE_STAMP
    GRID_BAR(); STAMP(14); __syncthreads();
    {
      constexpr int PT[6][4] = {{0,0,0,0}, {0,1,1,2}, {2,3,3,4}, {4,5,5,16}, {16,6,6,7}, {13,14,8,9}};
      volatile unsigned long long* tv = ts;
      const float dA = (float)(tv[PT[PROBE_STAMP][1]] - tv[PT[PROBE_STAMP][0]]) * 0.01f, dB = (float)(tv[PT[PROBE_STAMP][3]] - tv[PT[PROBE_STAMP][2]]) * 0.01f;
      const float e = dB * (1.f / 2000.f);
      for (long i = c.gt; i < (1l << 20); i += c.GT) p.out[1024 + i] += e;
      if (blockIdx.x == 0 && c.tid == 0) p.out[0] += dA * (1.f / 2000.f); }
#endif
}

extern "C" void kernel_launch(void* const* d_in, const int* in_sizes, int n_in, void* d_out, int out_size, void* d_ws, size_t ws_size, hipStream_t stream) {
    static int grid_blocks = 0;
    if (grid_blocks == 0) {
        if (n_in != 16 || in_sizes[0] != T * D || out_size != T * D || ws_size < WS_END) {
            fprintf(stderr, "kernel_launch: shape/ws mismatch n_in %d in0 %d out %d ws %zu (need %zu)\n", n_in, n_in > 0 ? in_sizes[0] : -1, out_size, ws_size, (size_t)WS_END);
            grid_blocks = -1; return;
        }
        int dev = 0, cus = 0, per_cu = 0;
        hipGetDevice(&dev); hipDeviceGetAttribute(&cus, hipDeviceAttributeMultiprocessorCount, dev);
        if (hipFuncSetAttribute((const void*)mk_fwd, hipFuncAttributeMaxDynamicSharedMemorySize, LDS_BYTES) != hipSuccess) { fprintf(stderr, "kernel_launch: hipFuncSetAttribute failed\n"); grid_blocks = -1; return; }
        if (hipOccupancyMaxActiveBlocksPerMultiprocessor(&per_cu, (const void*)mk_fwd, NTHREADS, LDS_BYTES) != hipSuccess || per_cu < 1) { fprintf(stderr, "kernel_launch: occupancy query says %d blocks/CU\n", per_cu); grid_blocks = -1; return; }
        grid_blocks = cus;
        fprintf(stderr, "kernel_launch: cus %d per_cu %d grid %d\n", cus, per_cu, grid_blocks);
    }
    if (grid_blocks < 0) return;
    Params p{};
    p.x = (const float*)d_in[0]; p.c = (const float*)d_in[1]; p.pos = (const int*)d_in[2]; p.norm_w = (const float*)d_in[3]; p.ada_w = (const float*)d_in[4];
    p.ada_b = (const float*)d_in[5]; p.w_in = (const float*)d_in[6]; p.qnw = (const float*)d_in[7]; p.w_uq = (const float*)d_in[8]; p.kvnw = (const float*)d_in[9];
    p.w_ukv = (const float*)d_in[10]; p.w_g2 = (const float*)d_in[11]; p.b_g2 = (const float*)d_in[12]; p.gnw = (const float*)d_in[13]; p.w_out = (const float*)d_in[14];
    p.fnw = (const float*)d_in[15]; p.out = (float*)d_out; p.ws = (unsigned char*)d_ws;
    if (hipMemsetAsync((char*)d_ws + WS_CTL, 0, 65536, stream) != hipSuccess) { fprintf(stderr, "kernel_launch: memset failed\n"); return; }
    void* args[] = {&p};
    hipError_t e = hipLaunchCooperativeKernel((void*)mk_fwd, dim3(grid_blocks), dim3(NTHREADS), args, LDS_BYTES, stream);
    if (e != hipSuccess) fprintf(stderr, "cooperative launch failed: %s (grid %d)\n", hipGetErrorString(e), grid_blocks);
}
```

```cpp
#include <hip/hip_runtime.h>
#include <hip/hip_cooperative_groups.h>
namespace cg = cooperative_groups;
#include <cstdio>
#include <cstdint>
#include <cmath>

typedef unsigned short bf16_t;
typedef short bf16x8 __attribute__((ext_vector_type(8)));
typedef float f32x4 __attribute__((ext_vector_type(4)));
typedef unsigned u32x4 __attribute__((ext_vector_type(4)));
typedef unsigned u32x2 __attribute__((ext_vector_type(2)));

constexpr int D = 1024, NB = 32, S = 2048, T = NB * S, DEPTH = 2, CH = 64;
constexpr int NIN = 2736, NP = 2816;
constexpr float EPS = 1e-6f;
constexpr int P_RQ = 0, P_RK = 256, P_RV = 512, P_RZ = 768, P_MQ = 1024, P_MKV = 1280, P_KPE = 1408, P_GG = 1440, P_PAD = 1456,
              P_MZ = 1536, P_GQ = 2048, P_GK = 2176, P_GV = 2304, P_GZ = 2560;
constexpr float QSCALE = 0.10206207261596577f * 1.4426950408889634f;

constexpr size_t MiB = 1u << 20;
constexpr size_t WS_CTL = 0;
constexpr size_t WS_ADA = 1 * MiB;
constexpr size_t WS_CS32 = 2 * MiB;
constexpr size_t WS_CS16 = 18 * MiB;
constexpr size_t WS_WIN = 26 * MiB;
constexpr size_t WS_WUQ = 38 * MiB;
constexpr size_t WS_WUKV = 39 * MiB;
constexpr size_t WS_WOUT = 40 * MiB;
constexpr size_t WS_RSQ = 44 * MiB;
constexpr size_t WS_RSKV = 45 * MiB;
constexpr size_t WS_GG = 46 * MiB;
constexpr size_t WS_H = 50 * MiB;
constexpr size_t WS_PROJ = 178 * MiB;
constexpr size_t WS_Q = 530 * MiB;
constexpr size_t WS_KV = 626 * MiB;
constexpr size_t WS_MIX = 754 * MiB;
constexpr size_t WS_GP = 882 * MiB;
constexpr int GP_ITEM = 5 * 64 * 32 + 64;
constexpr size_t WS_SSP = 963 * MiB;
constexpr size_t WS_END = 966 * MiB;

__device__ __forceinline__ unsigned f2bf(float f) { unsigned u = __builtin_bit_cast(unsigned, f); return (u + 0x7fffu + ((u >> 16) & 1u)) >> 16; }
typedef float f32x2_t __attribute__((ext_vector_type(2))); typedef __bf16 bf16x2_t __attribute__((ext_vector_type(2)));
__device__ __forceinline__ unsigned cvt_pk_bf16(float lo, float hi) { f32x2_t v = {lo, hi}; bf16x2_t b = __builtin_convertvector(v, bf16x2_t); return __builtin_bit_cast(unsigned, b); }
__device__ __forceinline__ unsigned pk2(float lo, float hi) { return f2bf(lo) | (f2bf(hi) << 16); }
__device__ __forceinline__ float bf2f(bf16_t v) { return __builtin_bit_cast(float, (unsigned)v << 16); }
__device__ __forceinline__ float silu_f(float x) { return x / (1.f + __expf(-x)); }

__host__ __device__ inline int in_logical(int p) {
    if (p < 512) { int c = p & 63; return (p & ~63) + (c >> 1) + 32 * (c & 1); }
    if (p < 1408) return p;
    if (p < 1440) { int c = p - 1408; return 1408 + (c >> 1) + 16 * (c & 1); }
    if (p < 1456) return 2464 + (p - 1440);
    if (p < 1536) return -1;
    if (p < 2048) return 1440 + (p - 1536);
    if (p < 2304) return 1952 + (p - 2048);
    if (p < 2560) return 2208 + (p - 2304);
    return 2480 + (p - 2560);
}
__host__ __device__ inline int uq_logical(int p) {
    int h = p / 96, c = p % 96;
    if (c < 64) return p;
    int cc = c - 64; return h * 96 + 64 + (cc >> 1) + 16 * (cc & 1);
}

struct Params {
    const float* x; const float* c; const int* pos; const float* norm_w; const float* ada_w; const float* ada_b; const float* w_in; const float* qnw;
    const float* w_uq; const float* kvnw; const float* w_ukv; const float* w_g2; const float* b_g2; const float* gnw; const float* w_out; const float* fnw;
    float* out; unsigned char* ws; unsigned long long never;
};
struct Ctx { int tid, lane, wave, gw, NGW; long gt, GT; };
__device__ __forceinline__ Ctx mkctx() {
    Ctx r; int t = threadIdx.x; asm volatile("" : "+v"(t)); r.tid = t; r.lane = t & 63; r.wave = __builtin_amdgcn_readfirstlane(t >> 6);
    r.gw = blockIdx.x * 8 + r.wave; r.NGW = gridDim.x * 8; r.gt = (long)blockIdx.x * 512 + t; r.GT = (long)gridDim.x * 512; return r; }

struct Dom { int w, NW, r0, nr; };
__device__ __forceinline__ Dom mkdom(const Ctx& c, unsigned vb, unsigned uni) {
    Dom d; if (uni) { const int x = (int)(vb & 7u), rk = (int)(vb >> 3); d.w = rk * 8 + c.wave; d.NW = (int)gridDim.x; d.r0 = (T / 8) * x; d.nr = T / 8; } else { d.w = c.gw; d.NW = c.NGW; d.r0 = 0; d.nr = T; }
    return d; }
__device__ __forceinline__ float wave_sum(float v) {
#pragma unroll
    for (int o = 1; o < 64; o <<= 1) v += __shfl_xor(v, o);
    return v;
}

template <class Map>
__device__ __forceinline__ void tr_item(const float* __restrict__ W, int K, int ldw, const float* __restrict__ rs, bf16_t* __restrict__ WT, int nblk, int item, int lane,
                                        __attribute__((address_space(3))) float* scr, const Map& lmap) {
    const int kb = item / nblk, nb = item % nblk, k0 = 64 * kb, n0 = 32 * nb;
    const int lc = lmap(n0 + (lane & 31));
#pragma unroll 8
    for (int i = 0; i < 32; ++i) { const int kk = 2 * i + (lane >> 5);
        float v = 0.f; if (lc >= 0) { v = W[(size_t)(k0 + kk) * ldw + lc]; if (rs) v *= rs[k0 + kk]; }
        scr[kk * 33 + (lane & 31)] = v; }
    asm volatile("s_waitcnt lgkmcnt(0)" ::: "memory");
    const int cc = lane & 7;
#pragma unroll
    for (int j = 0; j < 4; ++j) { const int n = (lane >> 3) + 8 * j; const __attribute__((address_space(3))) float* s = scr + (8 * cc) * 33 + n;
        u32x4 o; o.x = pk2(s[0 * 33], s[1 * 33]); o.y = pk2(s[2 * 33], s[3 * 33]); o.z = pk2(s[4 * 33], s[5 * 33]); o.w = pk2(s[6 * 33], s[7 * 33]);
        *(u32x4*)(WT + (size_t)(n0 + n) * K + k0 + 8 * cc) = o; }
    asm volatile("s_waitcnt lgkmcnt(0)" ::: "memory");
}
struct MapIn { __device__ __forceinline__ int operator()(int p) const { return in_logical(p); } };
struct MapUq { __device__ __forceinline__ int operator()(int p) const { return uq_logical(p); } };
struct MapId { __device__ __forceinline__ int operator()(int p) const { return p; } };
template <int PARTS = 7>
__device__ __forceinline__ void ph_prep(const Params& p, const Ctx& c, __attribute__((address_space(3))) unsigned char* lds) {
    typedef __attribute__((address_space(3))) float lfloat;
    unsigned char* ws = p.ws;
    bf16_t* WinT = (bf16_t*)(ws + WS_WIN); bf16_t* WuqT = (bf16_t*)(ws + WS_WUQ); bf16_t* WukvT = (bf16_t*)(ws + WS_WUKV); bf16_t* WoutT = (bf16_t*)(ws + WS_WOUT);
    float2* CS32 = (float2*)(ws + WS_CS32); float2* CS16 = (float2*)(ws + WS_CS16); float* ADA = (float*)(ws + WS_ADA);
    const int lane = c.lane, wave = c.wave, tid = c.tid;
    if (PARTS & 1) for (int item = blockIdx.x; item < DEPTH * 96; item += gridDim.x) {
        const int l = item / 96, cg = item % 96, n = cg * 32 + (lane & 31), kh = lane >> 5, k0 = wave * 128;
        lfloat* ca = (lfloat*)(lds + wave * 16384);
        for (int i = lane; i < 32 * 128; i += 64) { const int b = i >> 7, kk = i & 127; ca[i] = silu_f(p.c[b * 1024 + k0 + kk]); }
        asm volatile("s_waitcnt lgkmcnt(0)" ::: "memory");
        float acc[32];
#pragma unroll
        for (int b = 0; b < 32; ++b) acc[b] = 0.f;
        const float* wp = p.ada_w + ((size_t)l * 1024 + k0 + kh * 64) * 3072 + n;
        const lfloat* cb = ca + kh * 64;
#pragma unroll 1
        for (int kk = 0; kk < 64; kk += 8) {
            float w[8];
#pragma unroll
            for (int j = 0; j < 8; ++j) w[j] = wp[(size_t)(kk + j) * 3072];
#pragma unroll
            for (int hf = 0; hf < 2; ++hf) {
#pragma unroll
                for (int b = 0; b < 32; ++b) { const f32x4 c4 = *(const __attribute__((address_space(3))) f32x4*)(cb + b * 128 + kk + 4 * hf);
                    acc[b] += c4.x * w[4 * hf + 0] + c4.y * w[4 * hf + 1] + c4.z * w[4 * hf + 2] + c4.w * w[4 * hf + 3]; }
                asm volatile("" ::: "memory"); }
        }
#pragma unroll
        for (int b = 0; b < 32; ++b) acc[b] += __shfl_xor(acc[b], 32);
        __syncthreads();
        lfloat* red = (lfloat*)lds;
        if (lane < 32) {
#pragma unroll
            for (int b = 0; b < 32; ++b) red[(wave * 32 + b) * 32 + lane] = acc[b]; }
        __syncthreads();
        for (int o = tid; o < 1024; o += 512) { const int b = o >> 5, nn = o & 31; float s = 0.f;
#pragma unroll
            for (int w = 0; w < 8; ++w) s += red[(w * 32 + b) * 32 + nn];
            ADA[((size_t)l * NB + b) * 3072 + cg * 32 + nn] = s + p.ada_b[l * 3072 + cg * 32 + nn]; }
        __syncthreads();
    }
    lfloat* scr = (lfloat*)(lds + wave * 16384);
    constexpr int I_IN = 16 * (NP / 32), I_UQ = 4 * 24, I_UKV = 2 * 32, I_OUT = 16 * 32, I_L = I_IN + I_UQ + I_UKV + I_OUT;
    if (PARTS & 2) for (int it = c.gw; it < DEPTH * I_L; it += c.NGW) {
        const int l = it / I_L; int r = it % I_L;
        if (r < I_IN) { tr_item(p.w_in + (size_t)l * 1024 * NIN, 1024, NIN, nullptr, WinT + (size_t)l * NP * 1024, NP / 32, r, lane, scr, MapIn{}); continue; } r -= I_IN;
        if (r < I_UQ) { tr_item(p.w_uq + (size_t)l * 256 * 768, 256, 768, p.qnw + l * 256, WuqT + (size_t)l * 768 * 256, 24, r, lane, scr, MapUq{}); continue; } r -= I_UQ;
        if (r < I_UKV) { tr_item(p.w_ukv + (size_t)l * 128 * 1024, 128, 1024, p.kvnw + l * 128, WukvT + (size_t)l * 1024 * 128, 32, r, lane, scr, MapId{}); continue; } r -= I_UKV;
        tr_item(p.w_out + (size_t)l * 1024 * 1024, 1024, 1024, nullptr, WoutT + (size_t)l * 1024 * 1024, 32, r, lane, scr, MapId{});
    }
    if (PARTS & 4) { const int j = (int)(c.gt & 31); const double inv = pow(10000.0, -(double)j / 32.0) * 0.15915494309189535;
      for (long i = c.gt; i < (long)T * 32; i += c.GT) { const int t = (int)(i >> 5); const double tr = (double)p.pos[t] * inv; const float fr = (float)(tr - rint(tr));
          CS32[i] = make_float2(__builtin_amdgcn_cosf(fr), __builtin_amdgcn_sinf(fr)); } }
    if (PARTS & 4) { const int j = (int)(c.gt & 15); const double inv = pow(10000.0, -(double)j / 16.0) * 0.15915494309189535;
      for (long i = c.gt; i < (long)T * 16; i += c.GT) { const int t = (int)(i >> 4); const double tr = (double)p.pos[t] * inv; const float fr = (float)(tr - rint(tr));
          CS16[i] = make_float2(__builtin_amdgcn_cosf(fr), __builtin_amdgcn_sinf(fr)); } }
}

__device__ __forceinline__ float sumsq4(f32x4 v) { return v.x * v.x + v.y * v.y + v.z * v.z + v.w * v.w; }
__device__ __forceinline__ f32x4 bf4_to_f32(u32x2 w) { return (f32x4){__builtin_bit_cast(float, w.x << 16), __builtin_bit_cast(float, w.x & 0xffff0000u), __builtin_bit_cast(float, w.y << 16), __builtin_bit_cast(float, w.y & 0xffff0000u)}; }
template <bool XBF, int NR>
__device__ __forceinline__ void ph_norm(const Ctx& c, const Dom& d, const void* xv, const float* nw, const float* ADA_l, bf16_t* H) {
    const int lane = c.lane;
    for (int row0 = d.r0 + d.w * NR; row0 < d.r0 + d.nr; row0 += d.NW * NR) {
        f32x4 v[NR][4]; float s[NR];
#pragma unroll
        for (int r = 0; r < NR; ++r) {
            if (XBF) { const u32x2* xr = (const u32x2*)((const bf16_t*)xv + (size_t)(row0 + (row0 & ~(T / 8 - 1)) + r) * D) + lane;
#pragma unroll
                for (int j = 0; j < 4; ++j) v[r][j] = bf4_to_f32(xr[64 * j]); }
            else { const f32x4* xr = (const f32x4*)((const float*)xv + (size_t)(row0 + r) * D) + lane;
#pragma unroll
                for (int j = 0; j < 4; ++j) v[r][j] = xr[64 * j]; } }
#pragma unroll
        for (int r = 0; r < NR; ++r) s[r] = sumsq4(v[r][0]) + sumsq4(v[r][1]) + sumsq4(v[r][2]) + sumsq4(v[r][3]);
#pragma unroll
        for (int o = 1; o < 64; o <<= 1) {
#pragma unroll
            for (int r = 0; r < NR; ++r) s[r] += __shfl_xor(s[r], o); }
        const int b = row0 / S;
        const float* shift = ADA_l + (size_t)b * 3072; const float* scale = shift + 1024;
#pragma unroll
        for (int j = 0; j < 4; ++j) {
            const int c0 = 4 * lane + 256 * j; const f32x4 w = *(const f32x4*)(nw + c0), sc = *(const f32x4*)(scale + c0), sh = *(const f32x4*)(shift + c0);
            const f32x4 ws = w * (sc + 1.f);
#pragma unroll
            for (int r = 0; r < NR; ++r) { const float rstd = rsqrtf(s[r] * (1.f / D) + EPS);
                const f32x4 y = v[r][j] * rstd * ws + sh;
                u32x2 pk; pk.x = cvt_pk_bf16(y.x, y.y); pk.y = cvt_pk_bf16(y.z, y.w); ((u32x2*)(H + (size_t)(row0 + r) * D) + lane)[64 * j] = pk; }
        }
    }
}

template <int NR>
__device__ __forceinline__ void ph_final(const Ctx& c, const Dom& d, const bf16_t* x, const float* w, float* out) {
    const int lane = c.lane;
    for (int row0 = d.r0 + d.w * NR; row0 < d.r0 + d.nr; row0 += d.NW * NR) {
        f32x4 v[NR][4]; float s[NR];
#pragma unroll
        for (int r = 0; r < NR; ++r) { const u32x2* xr = (const u32x2*)(x + (size_t)(row0 + r) * D) + lane;
#pragma unroll
            for (int j = 0; j < 4; ++j) v[r][j] = bf4_to_f32(xr[64 * j]); }
#pragma unroll
        for (int r = 0; r < NR; ++r) s[r] = sumsq4(v[r][0]) + sumsq4(v[r][1]) + sumsq4(v[r][2]) + sumsq4(v[r][3]);
#pragma unroll
        for (int o = 1; o < 64; o <<= 1) {
#pragma unroll
            for (int r = 0; r < NR; ++r) s[r] += __shfl_xor(s[r], o); }
#pragma unroll
        for (int j = 0; j < 4; ++j) { const f32x4 ww = *(const f32x4*)(w + 4 * lane + 256 * j);
#pragma unroll
            for (int r = 0; r < NR; ++r) { const float rstd = rsqrtf(s[r] * (1.f / D) + EPS); ((f32x4*)(out + (size_t)(row0 + r) * D) + lane)[64 * j] = v[r][j] * rstd * ww; } }
    }
}

__device__ __forceinline__ u32x4 pack8bf(f32x4 a, f32x4 b) { u32x4 w; w.x = cvt_pk_bf16(a.x, a.y); w.y = cvt_pk_bf16(a.z, a.w); w.z = cvt_pk_bf16(b.x, b.y); w.w = cvt_pk_bf16(b.z, b.w); return w; }
__device__ __forceinline__ float silu_fast(float x) { return x * __builtin_amdgcn_rcpf(1.f + __builtin_amdgcn_exp2f(-1.4426950408889634f * x)); }
__device__ __forceinline__ f32x4 rope4(f32x4 v, f32x4 cs) { f32x4 o; o.x = v.x * cs.x - v.y * cs.y; o.y = v.y * cs.x + v.x * cs.y; o.z = v.z * cs.z - v.w * cs.w; o.w = v.w * cs.z + v.z * cs.w; return o; }
__device__ __forceinline__ f32x4 silu4(f32x4 v) { v.x = silu_fast(v.x); v.y = silu_fast(v.y); v.z = silu_fast(v.z); v.w = silu_fast(v.w); return v; }
typedef f32x4 acc_t[2][2][4][2];
struct EpiIn {
    bf16_t* PROJ; float* GG; const float2* CS32; const float2* CS16; float* SSP; bf16_t* MQF; bf16_t* MKVF; bf16_t* KPE;
    template <int NKS> __device__ __forceinline__ void rows_ss(const acc_t& acc, int bj, int row0, int dcol, int slice, bf16_t* F) const {
        const unsigned fbase = (((unsigned)(row0 >> 5) * NKS + (dcol >> 4)) * 2 + ((dcol >> 3) & 1)) * 256 + (row0 & 15) * 8;
#pragma unroll
        for (int i = 0; i < 8; ++i) { const int ai = i >> 2, m = i & 3; const int row = row0 + ai * 128 + m * 16; const f32x4 a = acc[ai][bj][m][0], b = acc[ai][bj][m][1];
            float ss = sumsq4(a) + sumsq4(b); ss += __shfl_xor(ss, 16); ss += __shfl_xor(ss, 32);
            if ((dcol & 31) == 0) SSP[(unsigned)row * 12 + slice] = ss;
            *(u32x4*)(F + (fbase + (unsigned)((ai * 4 + (m >> 1)) * (NKS * 512) + (m & 1) * 128))) = pack8bf(a, b);
            if (i & 1) asm volatile("" ::: "memory"); }
    }
    template <int MODE> __device__ __forceinline__ void rows(const acc_t& acc, int bj, int row0, int col, float sc) const {
#pragma unroll
        for (int i = 0; i < 8; ++i) { const int ai = i >> 2, m = i & 3; const int row = row0 + ai * 128 + m * 16; f32x4 a = acc[ai][bj][m][0], b = acc[ai][bj][m][1];
            if (MODE == 1) { a = silu4(a); b = silu4(b); }
            if (MODE == 2) { const f32x4* p = (const f32x4*)(CS32 + (unsigned)row * 32 + ((col & 63) >> 1)); a = rope4(a, p[0]); b = rope4(b, p[1]); }
            if (MODE == 3) { const f32x4* p = (const f32x4*)(CS16 + (unsigned)row * 16 + ((col - 1408) >> 1)); a = rope4(a, p[0]); b = rope4(b, p[1]); }
            if (MODE == 0 || MODE == 2) { a = a * sc; b = b * sc; }
            if (MODE == 3) *(u32x4*)(KPE + ((((unsigned)(row0 >> 6) + 2 * ai) * 4 + ((col - 1408) >> 3)) * 512 + ((row0 & 15) + 16 * m) * 8)) = pack8bf(a, b);
            else *(u32x4*)(PROJ + (unsigned)row * NP + col) = pack8bf(a, b);
            if (i & 1) asm volatile("" ::: "memory"); }
    }
    __device__ __forceinline__ void cols(const acc_t& acc, int bj, int row0, int colw, int c8) const {
        const int col = colw + c8;
        if (colw < 256) rows<2>(acc, bj, row0, col, 1.f);
        else if (colw < 512) rows<2>(acc, bj, row0, col, 0.125f);
        else if (colw < 768) rows<0>(acc, bj, row0, col, 1.f);
        else if (colw < 1024) rows<1>(acc, bj, row0, col, 1.f);
        else if (colw < 1280) rows_ss<16>(acc, bj, row0, col - 1024, (colw - 1024) >> 5, MQF);
        else if (colw < 1408) rows_ss<8>(acc, bj, row0, col - 1280, (colw - 1024) >> 5, MKVF);
        else if (colw < 1440) rows<3>(acc, bj, row0, col, 1.f);
        else if (colw < 1472) { if (c8 < 16) {
#pragma unroll
                for (int i = 0; i < 8; ++i) { const int ai = i >> 2, m = i & 3; f32x4* g = (f32x4*)(GG + (unsigned)(row0 + ai * 128 + m * 16) * 16 + c8); g[0] = acc[ai][bj][m][0]; g[1] = acc[ai][bj][m][1]; } } }
        else if (colw < 1536) { }
        else if (colw < 2048) rows<1>(acc, bj, row0, col, 1.f);
        else if (colw < 2176) rows<0>(acc, bj, row0, col, 1.f);
        else if (colw < 2304) rows<0>(acc, bj, row0, col, 0.17677669529663687f);
        else if (colw < 2560) rows<0>(acc, bj, row0, col, 1.f);
        else rows<1>(acc, bj, row0, col, 1.f);
    }
};
struct EpiQ {
    bf16_t* Q; const float* RSQ; const float2* CS16;
    template <bool ROPE> __device__ __forceinline__ void rows(const acc_t& acc, int bj, int row0, int col) const {
#pragma unroll
        for (int ai = 0; ai < 2; ++ai) {
            float rs[4]; f32x4 cs[4][2];
#pragma unroll
            for (int m = 0; m < 4; ++m) { const int row = row0 + ai * 128 + m * 16; { const f32x4* sp = (const f32x4*)(RSQ + (unsigned)row * 12); const f32x4 s0 = sp[0], s1 = sp[1]; rs[m] = rsqrtf(((s0.x + s0.y) + (s0.z + s0.w) + (s1.x + s1.y) + (s1.z + s1.w)) * (1.f / 256.f) + EPS) * QSCALE; }
                if (ROPE) { const f32x4* p = (const f32x4*)(CS16 + (unsigned)row * 16 + ((col % 96 - 64) >> 1)); cs[m][0] = p[0]; cs[m][1] = p[1]; } }
#pragma unroll
            for (int m = 0; m < 4; ++m) { f32x4 a = acc[ai][bj][m][0], b = acc[ai][bj][m][1];
                if (ROPE) { a = rope4(a, cs[m][0]); b = rope4(b, cs[m][1]); }
                *(u32x4*)(Q + (unsigned)(row0 + ai * 128 + m * 16) * 768 + col) = pack8bf(a * rs[m], b * rs[m]); }
        }
    }
    __device__ __forceinline__ void cols(const acc_t& acc, int bj, int row0, int colw, int c8) const {
        if (colw % 96 == 64) rows<true>(acc, bj, row0, colw + c8); else rows<false>(acc, bj, row0, colw + c8);
    }
};
struct EpiKV {
    bf16_t* KV; const float* RSKV;
    __device__ __forceinline__ void cols(const acc_t& acc, int bj, int row0, int colw, int c8) const {
        float rs[8];
#pragma unroll
        for (int i = 0; i < 8; ++i) { const f32x4 s = *(const f32x4*)(RSKV + (unsigned)(row0 + (i >> 2) * 128 + (i & 3) * 16) * 12 + 8); rs[i] = rsqrtf(((s.x + s.y) + (s.z + s.w)) * (1.f / 128.f) + EPS); }
#pragma unroll
        for (int i = 0; i < 8; ++i) { const int ai = i >> 2, m = i & 3;
            *(u32x4*)(KV + (unsigned)(row0 + ai * 128 + m * 16) * 1024 + colw + c8) = pack8bf(acc[ai][bj][m][0] * rs[i], acc[ai][bj][m][1] * rs[i]); }
    }
};
template <bool XBF> struct EpiOut {
    const void* xi; bf16_t* xo; const float* ADA_l;
    __device__ __forceinline__ void cols(const acc_t& acc, int bj, int row0, int colw, int c8) const {
        const int col = colw + c8; const int bb = row0 / S;
        const int rx = row0 & ~(T / 8 - 1);
        const f32x4* gp = (const f32x4*)(ADA_l + (unsigned)bb * 3072 + 2048 + col); const f32x4 g0 = gp[0], g1 = gp[1];
#pragma unroll
        for (int half = 0; half < 2; ++half) {
            f32x4 x0[4], x1[4];
#pragma unroll
            for (int m = 0; m < 4; ++m) { const size_t off = (unsigned)(row0 + half * 128 + m * 16) * D + col;
                if (XBF) { const u32x4 w = *(const u32x4*)((const bf16_t*)xi + (off + (size_t)rx * D)); x0[m] = bf4_to_f32((u32x2){w.x, w.y}); x1[m] = bf4_to_f32((u32x2){w.z, w.w}); }
                else { const f32x4* xv = (const f32x4*)((const float*)xi + off); x0[m] = xv[0]; x1[m] = xv[1]; } }
#pragma unroll
            for (int m = 0; m < 4; ++m) *(u32x4*)(xo + (unsigned)(row0 + (XBF ? 0 : rx) + half * 128 + m * 16) * D + col) = pack8bf(x0[m] + g0 * acc[half][bj][m][0], x1[m] + g1 * acc[half][bj][m][1]);
        }
    }
};

namespace pg8 {
#define PG8_LAS __attribute__((address_space(3)))
constexpr int BM = 256, BK = 64, HALF = 128, HTB = HALF * BK * 2  , STAGE_BYTES = 8 * HTB, NXCD = 8, WGM = 8;

__host__ __device__ __forceinline__ int lds_byte(int r, int c) { const int st = (r >> 4) * 2 + (c >> 5), rr = r & 15, cc = c & 31, ob = rr * 64 + cc * 2; return st * 1024 + (ob ^ (((ob >> 9) & 1) << 5)); }
__host__ __device__ __forceinline__ void stage_rc(int b, int& R, int& C) { const int st = b / 1024, sb = b % 1024, swz = sb ^ (((sb >> 9) & 1) << 5); R = (st >> 1) * 16 + swz / 64; C = (st & 1) * 32 + (swz % 64) / 2; }
__host__ __device__ __forceinline__ int perm32(int rho) { const int n = rho >> 4, i = rho & 15; return 8 * (i >> 2) + 4 * n + (i & 3); }

struct Unit { int pm, pn; };
struct Gemm { const bf16_t* A; const bf16_t* Bt; int M, N, K, lda; };

struct StaticOrder {
    int nM, nN, nwg, G, c;
    __host__ __device__ void init(int M, int N, int G_, int c_) { nM = M / BM; nN = N / BM; nwg = nM * nN; G = G_; c = c_; }
    __host__ __device__ bool next(int i, Unit& u) const {
        const long L = (long)i * G + c; if (L >= nwg) return false;
        int wgid = (int)L; { const int q = nwg / NXCD, r = nwg % NXCD, xcd = wgid % NXCD, off = wgid / NXCD; wgid = (xcd < r ? xcd * (q + 1) : r * (q + 1) + (xcd - r) * q) + off; }
        const int nig = WGM * nN, gid = wgid / nig, fm = gid * WGM, gsz = (nM - fm) < WGM ? (nM - fm) : WGM;
        u.pm = fm + ((wgid % nig) % gsz); u.pn = (wgid % nig) / gsz; return true;
    }
    __device__ __forceinline__ void a_ready(const Unit&) const {}
    __device__ __forceinline__ void done(const Unit&) const {}
};

template <class Epi, class Sched, bool ALIGN_EPI = false, bool SP2 = false>
__device__ __forceinline__ void gemm_phase(PG8_LAS unsigned char* lds, const Gemm g, const Sched& S, const Epi& E) {
    int tid_ = threadIdx.x; asm volatile("" : "+v"(tid_));
    const int tid = tid_, wid = __builtin_amdgcn_readfirstlane(tid >> 6), lane = tid & 63, wr = wid >> 2, wc = wid & 3, fr = lane & 15, fq = lane >> 4;
    const int K = g.K, nt = K / BK;
    unsigned voffA[2], voffB[2];
#pragma unroll
    for (int i = 0; i < 2; ++i) { int R, C; stage_rc(tid * 16 + i * 8192, R, C); const int Rb = Epi::PERM ? ((R & ~31) + perm32(R & 31)) : R;
        voffA[i] = (unsigned)(R * g.lda + C) * 2u; voffB[i] = (unsigned)(Rb * K + C) * 2u; }
    const size_t kstep = (size_t)(BK * 2);
    const size_t hstep = (size_t)HALF * K * 2;
    const size_t tstep = 2 * hstep; const size_t hstepA = (size_t)HALF * g.lda * 2, tstepA = 2 * hstepA;
    const unsigned ldsw = (unsigned)wid * 1024u;
    const int aoff = lds_byte(wr * 64 + fr, fq * 8), boff = lds_byte(wc * 32 + fr, fq * 8);
#define PG8_SA(b, h) (((b) * 2 + (h)) * HTB)
#define PG8_SB(b, h) ((4 + (b) * 2 + (h)) * HTB)
#define PG8_STAGE(bufoff, gbase, voff) do { _Pragma("unroll") for (int _i = 0; _i < 2; ++_i) \
        __builtin_amdgcn_global_load_lds((const unsigned*)((const char*)(gbase) + (voff)[_i]), (PG8_LAS unsigned*)(lds + (bufoff) + ldsw + _i * 8192), 16, 0, 0); } while (0)
#define PG8_LDA(dst, b, h) do { _Pragma("unroll") for (int m = 0; m < 4; ++m) _Pragma("unroll") for (int k = 0; k < 2; ++k) dst[m][k] = *(const PG8_LAS bf16x8*)(lds + PG8_SA(b, h) + aoff + m * 2048 + k * 1024); } while (0)
#define PG8_LDB(dst, b, h) do { _Pragma("unroll") for (int n = 0; n < 2; ++n) _Pragma("unroll") for (int k = 0; k < 2; ++k) dst[n][k] = *(const PG8_LAS bf16x8*)(lds + PG8_SB(b, h) + boff + n * 2048 + k * 1024); } while (0)
#define PG8_MMA(ai, bj, At, Bt) do { __builtin_amdgcn_s_setprio(1); _Pragma("unroll") for (int m = 0; m < 4; ++m) _Pragma("unroll") for (int n = 0; n < 2; ++n) _Pragma("unroll") for (int k = 0; k < 2; ++k) \
        acc[ai][bj][m][n] = __builtin_amdgcn_mfma_f32_16x16x32_bf16(Bt[n][k], At[m][k], acc[ai][bj][m][n], 0, 0, 0); __builtin_amdgcn_s_setprio(0); } while (0)
#define PG8_WAIT_V(n) asm volatile("s_waitcnt vmcnt(" #n ")" ::: "memory")
#define PG8_WAIT_L(n) asm volatile("s_waitcnt lgkmcnt(" #n ")" ::: "memory")
#define PG8_BAR __builtin_amdgcn_s_barrier()
#define PG8_SCHED __builtin_amdgcn_sched_barrier(0)
    Unit cur, nxt; int ui = 0;
    if (!S.next(0, cur)) return;
    f32x4 acc[2][2][4][2];
#pragma unroll
    for (int a = 0; a < 2; ++a)
#pragma unroll
        for (int b = 0; b < 2; ++b)
#pragma unroll
            for (int m = 0; m < 4; ++m)
#pragma unroll
                for (int n = 0; n < 2; ++n) acc[a][b][m][n] = (f32x4){0.f, 0.f, 0.f, 0.f};
    bf16x8 At[4][2], B0[2][2], B1[2][2];
    const char* cA = (const char*)g.A + (size_t)cur.pm * tstepA; const char* cB = (const char*)g.Bt + (size_t)cur.pn * tstep;
    S.a_ready(cur);
    if constexpr (SP2) {
        PG8_STAGE(PG8_SB(0, 0), cB, voffB); PG8_STAGE(PG8_SB(0, 1), cB + hstep, voffB); PG8_STAGE(PG8_SA(0, 0), cA, voffA); PG8_STAGE(PG8_SA(0, 1), cA + hstepA, voffA);
        if (wr == 1) PG8_BAR;
        PG8_WAIT_V(2); PG8_BAR;
        PG8_STAGE(PG8_SB(1, 0), cB + kstep, voffB); PG8_STAGE(PG8_SA(1, 0), cA + kstep, voffA); PG8_STAGE(PG8_SB(1, 1), cB + hstep + kstep, voffB);
        PG8_WAIT_V(6); PG8_BAR;
    } else {
        PG8_STAGE(PG8_SB(0, 0), cB, voffB); PG8_STAGE(PG8_SA(0, 0), cA, voffA); PG8_STAGE(PG8_SB(0, 1), cB + hstep, voffB); PG8_STAGE(PG8_SA(0, 1), cA + hstepA, voffA);
        if (wr == 1) PG8_BAR;
        PG8_WAIT_V(4); PG8_BAR;
        PG8_STAGE(PG8_SB(1, 0), cB + kstep, voffB); PG8_STAGE(PG8_SA(1, 0), cA + kstep, voffA); PG8_STAGE(PG8_SB(1, 1), cB + hstep + kstep, voffB);
        PG8_WAIT_V(6); PG8_BAR;
    }
    for (;;) {
        const bool has_next = S.next(ui + 1, nxt);
        const char* nA = has_next ? (const char*)g.A + (size_t)nxt.pm * tstepA : cA; const char* nB = has_next ? (const char*)g.Bt + (size_t)nxt.pn * tstep : cB;
        for (int t = 0; t < nt; t += 2) {
            const bool last = (t == nt - 2);
            const char* a1 = cA + (size_t)(t + 1) * kstep;
            const char* a2 = last ? nA : cA + (size_t)(t + 2) * kstep; const char* b2 = last ? nB : cB + (size_t)(t + 2) * kstep;
            const char* a3 = a2 + kstep; const char* b3 = b2 + kstep;
            if (last && has_next) S.a_ready(nxt);
            if constexpr (SP2) {
            PG8_LDB(B0, 0, 0); PG8_LDB(B1, 0, 1); PG8_SCHED; PG8_LDA(At, 0, 0); PG8_STAGE(PG8_SA(1, 1), a1 + hstepA, voffA);
            PG8_WAIT_V(8); PG8_WAIT_L(0); PG8_BAR; PG8_MMA(0, 0, At, B0); PG8_MMA(0, 1, At, B1); PG8_BAR; PG8_SCHED;
            PG8_LDA(At, 0, 1); PG8_STAGE(PG8_SB(0, 0), b2, voffB); PG8_STAGE(PG8_SB(0, 1), b2 + hstep, voffB); PG8_STAGE(PG8_SA(0, 0), a2, voffA);
            PG8_WAIT_V(8); PG8_WAIT_L(0); PG8_BAR; PG8_MMA(1, 0, At, B0); PG8_MMA(1, 1, At, B1); PG8_BAR; PG8_SCHED;
            PG8_LDB(B0, 1, 0); PG8_LDB(B1, 1, 1); PG8_SCHED; PG8_LDA(At, 1, 0); PG8_STAGE(PG8_SA(0, 1), a2 + hstepA, voffA);
            PG8_WAIT_V(8); PG8_WAIT_L(0); PG8_BAR; PG8_MMA(0, 0, At, B0); PG8_MMA(0, 1, At, B1); PG8_BAR; PG8_SCHED;
            PG8_LDA(At, 1, 1); PG8_STAGE(PG8_SB(1, 0), b3, voffB); PG8_STAGE(PG8_SB(1, 1), b3 + hstep, voffB); PG8_STAGE(PG8_SA(1, 0), a3, voffA);
            PG8_WAIT_V(8); PG8_WAIT_L(0); PG8_BAR; PG8_MMA(1, 0, At, B0); PG8_MMA(1, 1, At, B1); PG8_BAR; PG8_SCHED;
            } else {
            PG8_LDB(B0, 0, 0); PG8_SCHED; PG8_LDA(At, 0, 0); PG8_STAGE(PG8_SA(1, 1), a1 + hstepA, voffA);
            PG8_WAIT_L(8); PG8_BAR; PG8_WAIT_L(0); PG8_MMA(0, 0, At, B0); PG8_BAR; PG8_SCHED;
            PG8_LDB(B1, 0, 1); PG8_STAGE(PG8_SB(0, 0), b2, voffB);
            PG8_BAR; PG8_WAIT_L(0); PG8_MMA(0, 1, At, B1); PG8_BAR;
            PG8_LDA(At, 0, 1); PG8_STAGE(PG8_SA(0, 0), a2, voffA);
            PG8_BAR; PG8_WAIT_L(0); PG8_MMA(1, 0, At, B0); PG8_BAR; PG8_SCHED;
            PG8_STAGE(PG8_SB(0, 1), b2 + hstep, voffB);
            PG8_WAIT_V(6); PG8_BAR; PG8_MMA(1, 1, At, B1); PG8_BAR;
            PG8_LDB(B0, 1, 0); PG8_SCHED; PG8_LDA(At, 1, 0); PG8_STAGE(PG8_SA(0, 1), a2 + hstepA, voffA);
            PG8_WAIT_L(8); PG8_BAR; PG8_WAIT_L(0); PG8_MMA(0, 0, At, B0); PG8_BAR; PG8_SCHED;
            PG8_LDB(B1, 1, 1); PG8_STAGE(PG8_SB(1, 0), b3, voffB);
            PG8_BAR; PG8_WAIT_L(0); PG8_MMA(0, 1, At, B1); PG8_BAR;
            PG8_LDA(At, 1, 1); PG8_STAGE(PG8_SA(1, 0), a3, voffA);
            PG8_BAR; PG8_WAIT_L(0); PG8_MMA(1, 0, At, B0); PG8_BAR; PG8_SCHED;
            PG8_STAGE(PG8_SB(1, 1), b3 + hstep, voffB);
            PG8_WAIT_V(6); PG8_BAR; PG8_MMA(1, 1, At, B1); PG8_BAR;
            }
        }
        if constexpr (ALIGN_EPI) { if (wr == 0) PG8_BAR; }
        if constexpr (!Epi::AFTER_DRAIN) { E(acc, cur, wr, wc, fr, fq); S.done(cur); }
        if (!has_next) break;
#pragma unroll
        for (int a = 0; a < 2; ++a)
#pragma unroll
            for (int b = 0; b < 2; ++b)
#pragma unroll
                for (int m = 0; m < 4; ++m)
#pragma unroll
                    for (int n = 0; n < 2; ++n) acc[a][b][m][n] = (f32x4){0.f, 0.f, 0.f, 0.f};
        cur = nxt; cA = nA; cB = nB; ++ui;
        if constexpr (ALIGN_EPI) { if (wr == 1) PG8_BAR; }
    }
    PG8_WAIT_V(0);
    if constexpr (!ALIGN_EPI) { if (wr == 0) PG8_BAR; }
    PG8_BAR;
    if constexpr (Epi::AFTER_DRAIN) { E.fused(acc, cur, wr, wc, fr, fq, lds, wid, lane); S.done(cur); }
#undef PG8_SA
#undef PG8_SB
#undef PG8_STAGE
#undef PG8_LDA
#undef PG8_LDB
#undef PG8_MMA
#undef PG8_WAIT_V
#undef PG8_WAIT_L
#undef PG8_BAR
#undef PG8_SCHED
}
}

template <class E> struct EpiAd {
    static constexpr bool PERM = true, AFTER_DRAIN = false;
    E e;
    __device__ __forceinline__ void operator()(const f32x4 (&acc)[2][2][4][2], const pg8::Unit& u, int wr, int wc, int fr, int fq) const {
        const int row0 = u.pm * 256 + wr * 64 + fr;
#pragma unroll
        for (int bj = 0; bj < 2; ++bj) e.cols(acc, bj, row0, __builtin_amdgcn_readfirstlane(u.pn * 256 + bj * 128 + wc * 32), 8 * fq);
    }
};
template <class E> __device__ __forceinline__ void run_gemm(PG8_LAS unsigned char* lds, int vb, const bf16_t* A, int lda, const bf16_t* Bt, int M, int N, int K, const E& e) {
    int Ko = K; asm volatile("" : "+s"(Ko));
    pg8::Gemm g{A, Bt, M, N, Ko, lda}; pg8::StaticOrder S; S.init(M, N, (int)gridDim.x, vb);
    EpiAd<E> ad{e};
    if (K >= 512) pg8::gemm_phase<EpiAd<E>, pg8::StaticOrder, true, true>(lds, g, S, ad); else pg8::gemm_phase<EpiAd<E>, pg8::StaticOrder, true, false>(lds, g, S, ad);
}

template <class Epi>
__device__ __forceinline__ void gemm_wave(const Ctx& c, const bf16_t* A, int lda, const bf16_t* Bt, int M, int N, int K, const Epi& epi) {
    const int fr = c.lane & 15, fq = c.lane >> 4; const int ntn = N / 64, nt = (M / 32) * ntn;
    for (int tile = c.gw; tile < nt; tile += c.NGW) {
        const int m0 = (tile / ntn) * 32, n0 = (tile % ntn) * 64;
        f32x4 acc[2][4];
#pragma unroll
        for (int i = 0; i < 2; ++i)
#pragma unroll
            for (int j = 0; j < 4; ++j) acc[i][j] = (f32x4){0.f, 0.f, 0.f, 0.f};
        const bf16_t* ap = A + (size_t)(m0 + fr) * lda + fq * 8; const bf16_t* bp = Bt + (size_t)(n0 + fr) * K + fq * 8;
        for (int k0 = 0; k0 < K; k0 += 32) {
            bf16x8 a[2], b[4];
#pragma unroll
            for (int i = 0; i < 2; ++i) a[i] = *(const bf16x8*)(ap + (size_t)(16 * i) * lda + k0);
#pragma unroll
            for (int j = 0; j < 4; ++j) b[j] = *(const bf16x8*)(bp + (size_t)(16 * j) * K + k0);
#pragma unroll
            for (int i = 0; i < 2; ++i)
#pragma unroll
                for (int j = 0; j < 4; ++j) acc[i][j] = __builtin_amdgcn_mfma_f32_16x16x32_bf16(b[j], a[i], acc[i][j], 0, 0, 0);
        }
#pragma unroll
        for (int i = 0; i < 2; ++i)
#pragma unroll
            for (int j = 0; j < 4; ++j) epi(m0 + 16 * i + fr, n0 + 16 * j + 4 * fq, acc[i][j]);
    }
}

__device__ __forceinline__ void ph_rstd(const Ctx& c, const bf16_t* PROJ, float* RSQ, float* RSKV) {
    const int lane = c.lane;
    for (int row0 = c.gw * 8; row0 < T; row0 += c.NGW * 8) {
        u32x2 q[8]; unsigned k[8];
#pragma unroll
        for (int r = 0; r < 8; ++r) { const bf16_t* p = PROJ + (size_t)(row0 + r) * NP; q[r] = *(const u32x2*)(p + P_MQ + 4 * lane); k[r] = *(const unsigned*)(p + P_MKV + 2 * lane); }
        float s[8], s2[8];
#pragma unroll
        for (int r = 0; r < 8; ++r) { const float a0 = __builtin_bit_cast(float, q[r].x << 16), a1 = __builtin_bit_cast(float, q[r].x & 0xffff0000u), a2 = __builtin_bit_cast(float, q[r].y << 16), a3 = __builtin_bit_cast(float, q[r].y & 0xffff0000u);
            const float b0 = __builtin_bit_cast(float, k[r] << 16), b1 = __builtin_bit_cast(float, k[r] & 0xffff0000u);
            s[r] = a0 * a0 + a1 * a1 + a2 * a2 + a3 * a3; s2[r] = b0 * b0 + b1 * b1; }
#pragma unroll
        for (int o = 1; o < 64; o <<= 1) {
#pragma unroll
            for (int r = 0; r < 8; ++r) { s[r] += __shfl_xor(s[r], o); s2[r] += __shfl_xor(s2[r], o); } }
        if (lane < 8) { float sv = s[0], s2v = s2[0];
#pragma unroll
            for (int r = 1; r < 8; ++r) { if (lane == r) { sv = s[r]; s2v = s2[r]; } }
            RSQ[row0 + lane] = rsqrtf(sv * (1.f / 256.f) + EPS); RSKV[row0 + lane] = rsqrtf(s2v * (1.f / 128.f) + EPS); }
    }
}

__device__ __forceinline__ void ph_attn_naive(const Ctx& c, const bf16_t* Q, const bf16_t* KV, const bf16_t* PROJ, bf16_t* MIX) {
    const int lane = c.lane;
    for (int W = c.gw; W < (T / 64) * 16; W += c.NGW) {
        const int cgk = W >> 4, h = (W >> 1) & 7, vh = W & 1; const int t = cgk * 64 + lane; const int b = (cgk * 64) / S; const int nk = ((cgk * 64) % S) + 64; const int kb = b * S;
        float q[96];
        const bf16_t* qp = Q + (size_t)t * 768 + h * 96;
#pragma unroll
        for (int d = 0; d < 96; ++d) q[d] = bf2f(qp[d]);
        float o[32];
#pragma unroll
        for (int e = 0; e < 32; ++e) o[e] = 0.f;
        float m = -1e30f, l = 0.f;
        for (int j = 0; j < nk; ++j) {
            const bf16_t* kn = KV + (size_t)(kb + j) * 1024 + h * 128; const bf16_t* kp = PROJ + (size_t)(kb + j) * NP + P_KPE;
            float s = 0.f;
#pragma unroll
            for (int d = 0; d < 64; ++d) s = fmaf(q[d], bf2f(kn[d]), s);
#pragma unroll
            for (int d = 0; d < 32; ++d) s = fmaf(q[64 + d], bf2f(kp[d]), s);
            const float mn = fmaxf(m, s); const float sc = exp2f(m - mn), pp = exp2f(s - mn); m = mn; l = l * sc + pp;
#pragma unroll
            for (int e = 0; e < 32; ++e) o[e] = o[e] * sc + pp * bf2f(kn[64 + vh * 32 + e]);
        }
        const float rl = 1.f / l;
        const bf16_t* z = PROJ + (size_t)t * NP + P_MZ + h * 64 + vh * 32; bf16_t* mo = MIX + (size_t)t * 1024 + 256 + h * 64 + vh * 32;
#pragma unroll
        for (int e = 0; e < 32; ++e) mo[e] = (bf16_t)f2bf(o[e] * rl * bf2f(z[e]));
    }
}

__device__ __forceinline__ void ph_ret_naive(const Ctx& c, const bf16_t* PROJ, bf16_t* MIX) {
    const int lane = c.lane;
    for (int W = c.gw; W < (T / 64) * 4; W += c.NGW) {
        const int cgk = W >> 2, h = W & 3; const int t = cgk * 64 + lane; const int b = (cgk * 64) / S; const int nk = ((cgk * 64) % S) + 64; const int kb = b * S;
        const float lg = log1pf(-exp2f(-5.f - (float)h));
        float q[64];
        const bf16_t* qp = PROJ + (size_t)t * NP + P_RQ + h * 64;
#pragma unroll
        for (int d = 0; d < 64; ++d) q[d] = bf2f(qp[d]);
        float o[64];
#pragma unroll
        for (int e = 0; e < 64; ++e) o[e] = 0.f;
        const int ti = t - kb;
        for (int j = 0; j < nk; ++j) {
            const bf16_t* kr = PROJ + (size_t)(kb + j) * NP + P_RK + h * 64; const bf16_t* vr = PROJ + (size_t)(kb + j) * NP + P_RV + h * 64;
            float s = 0.f;
#pragma unroll
            for (int d = 0; d < 64; ++d) s = fmaf(q[d], bf2f(kr[d]), s);
            const int dd = ti - j; s *= __expf(lg * (float)(dd < 0 ? -dd : dd));
#pragma unroll
            for (int e = 0; e < 64; ++e) o[e] = fmaf(s, bf2f(vr[e]), o[e]);
        }
        float ss = 0.f;
#pragma unroll
        for (int e = 0; e < 64; ++e) ss += o[e] * o[e];
        const float rstd = rsqrtf(ss * (1.f / 64.f) + EPS);
        const bf16_t* z = PROJ + (size_t)t * NP + P_RZ + h * 64; bf16_t* mo = MIX + (size_t)t * 1024 + h * 64;
#pragma unroll
        for (int e = 0; e < 64; ++e) mo[e] = (bf16_t)f2bf(o[e] * rstd * bf2f(z[e]));
    }
}

__device__ __forceinline__ void ph_gla_prep(const Ctx& c, const Dom& d, const bf16_t* PROJ, const float* GG, const float* w_g2, const float* b_g2, bf16_t* GP, __attribute__((address_space(3))) float* wl) {
    const int lane = c.lane;
    for (int i = c.tid; i < 2048 + 128; i += 512) wl[i] = i < 2048 ? w_g2[i] : b_g2[i - 2048];
    __syncthreads();
    for (int item = d.r0 / 16 + d.w; item < (d.r0 + d.nr) / 16; item += d.NW) {
        const int cg = item >> 2, h = item & 3; const size_t t = (size_t)cg * 64 + lane;
        const f32x4* gp4 = (const f32x4*)(GG + t * 16); const f32x4 g0 = gp4[0], g1 = gp4[1], g2 = gp4[2], g3 = gp4[3];
        const float gg[16] = {g0.x, g0.y, g0.z, g0.w, g1.x, g1.y, g1.z, g1.w, g2.x, g2.y, g2.z, g2.w, g3.x, g3.y, g3.z, g3.w};
        const u32x4* qp4 = (const u32x4*)(PROJ + t * NP + P_GQ + h * 32); const u32x4* kp4 = (const u32x4*)(PROJ + t * NP + P_GK + h * 32);
        u32x4 qw[4], kw[4];
#pragma unroll
        for (int i = 0; i < 4; ++i) { qw[i] = qp4[i]; kw[i] = kp4[i]; }
        bf16_t* out = GP + (size_t)item * GP_ITEM + lane * 8; float* ALi = (float*)(GP + (size_t)item * GP_ITEM + 5 * 64 * 32);
#pragma unroll
        for (int i = 0; i < 4; ++i) {
            float cum[8];
            { const int n0 = h * 32 + 8 * i; typedef __attribute__((address_space(3))) f32x4 lf4;
              f32x4 za = *(const lf4*)(wl + 2048 + n0), zb = *(const lf4*)(wl + 2048 + n0 + 4);
#pragma unroll
              for (int r = 0; r < 16; ++r) { const f32x4 wa = *(const lf4*)(wl + r * 128 + n0), wb = *(const lf4*)(wl + r * 128 + n0 + 4); za = za + wa * gg[r]; zb = zb + wb * gg[r]; }
              const float zz[8] = {za.x, za.y, za.z, za.w, zb.x, zb.y, zb.z, zb.w};
#pragma unroll
              for (int d = 0; d < 8; ++d) cum[d] = (fminf(zz[d], 0.f) - __logf(1.f + __expf(-fabsf(zz[d])))) * (1.f / 16.f); }
#pragma unroll
            for (int off = 1; off < 64; off <<= 1)
#pragma unroll
                for (int d = 0; d < 8; ++d) { const float tt = __shfl_up(cum[d], off); if (lane >= off) cum[d] += tt; }
            float qv[8], kv[8];
            { const unsigned qq[4] = {qw[i].x, qw[i].y, qw[i].z, qw[i].w}, kk[4] = {kw[i].x, kw[i].y, kw[i].z, kw[i].w};
#pragma unroll
              for (int j = 0; j < 4; ++j) { qv[2 * j] = __builtin_bit_cast(float, qq[j] << 16); qv[2 * j + 1] = __builtin_bit_cast(float, qq[j] & 0xffff0000u);
                  kv[2 * j] = __builtin_bit_cast(float, kk[j] << 16); kv[2 * j + 1] = __builtin_bit_cast(float, kk[j] & 0xffff0000u); } }
            float o[5][8];
#pragma unroll
            for (int d = 0; d < 8; ++d) { const float ep = __expf(cum[d]), en = __builtin_amdgcn_rcpf(ep); const float al = __shfl(ep, 63), ed = al * en;
                o[0][d] = qv[d] * ep; o[1][d] = qv[d] * en; o[2][d] = kv[d] * en; o[3][d] = kv[d] * ep; o[4][d] = kv[d] * ed;
                if (lane == 63) ALi[8 * i + d] = al; }
#pragma unroll
            for (int kd = 0; kd < 5; ++kd) { u32x4 w; w.x = cvt_pk_bf16(o[kd][0], o[kd][1]); w.y = cvt_pk_bf16(o[kd][2], o[kd][3]); w.z = cvt_pk_bf16(o[kd][4], o[kd][5]); w.w = cvt_pk_bf16(o[kd][6], o[kd][7]);
                *(u32x4*)(out + kd * (64 * 32) + i * (64 * 8)) = w; }
        }
    }
}
namespace att {
typedef short s16x4 __attribute__((ext_vector_type(4)));
typedef float f32x16 __attribute__((ext_vector_type(16)));
constexpr int KROW = 208, SHM_K = 64 * KROW, SHM_V = 64 * 64 * 2;
constexpr int L_K = 0, L_V = 2 * SHM_K, L_WS = L_V + 3 * SHM_V, L_END = L_WS + 8 * 64 * 4;
constexpr float THR = 4.f;
#define ASBAR() __builtin_amdgcn_sched_barrier(0)
__device__ __forceinline__ int crow(int r, int hi) { return (r & 3) + 8 * (r >> 2) + 4 * hi; }
__device__ __forceinline__ unsigned cvtpk(float lo, float hi) { unsigned r; asm volatile("v_cvt_pk_bf16_f32 %0, %1, %2" : "=v"(r) : "v"(lo), "v"(hi)); return r; }

__device__ __forceinline__ void partialSM(f32x16& p0, f32x16& p1, float& m_reg, float& mn, float& alpha) {
  float pmax = p0[0];
#pragma unroll
  for (int r = 1; r < 16; ++r) pmax = fmaxf(pmax, p0[r]);
#pragma unroll
  for (int r = 0; r < 16; ++r) pmax = fmaxf(pmax, p1[r]);
  { auto rr = __builtin_amdgcn_permlane32_swap(__float_as_uint(pmax), __float_as_uint(pmax), false, false);
    pmax = fmaxf(__uint_as_float(rr[0]), __uint_as_float(rr[1])); }
  if (__builtin_expect(__all(pmax - m_reg <= THR), 1)) { mn = m_reg; alpha = 1.f; }
  else { mn = fmaxf(m_reg, pmax); alpha = __builtin_amdgcn_exp2f(m_reg - mn); m_reg = mn; }
#pragma unroll
  for (int r = 0; r < 16; ++r) p0[r] = p0[r] - mn;
#pragma unroll
  for (int r = 0; r < 16; ++r) p1[r] = p1[r] - mn;
#pragma unroll
  for (int r = 0; r < 16; ++r) p0[r] = __builtin_amdgcn_exp2f(p0[r]);
}
__device__ __forceinline__ void finishSM(f32x16& p0, f32x16& p1, float alpha, float& l_reg, bf16x8& pa0, bf16x8& pa1, bf16x8& pa2, bf16x8& pa3) {
#pragma unroll
  for (int r = 0; r < 16; ++r) p1[r] = __builtin_amdgcn_exp2f(p1[r]);
  float ps = 0;
#pragma unroll
  for (int r = 0; r < 16; ++r) ps += p0[r];
#pragma unroll
  for (int r = 0; r < 16; ++r) ps += p1[r];
  { auto rr = __builtin_amdgcn_permlane32_swap(__float_as_uint(ps), __float_as_uint(ps), false, false);
    ps = __uint_as_float(rr[0]) + __uint_as_float(rr[1]); }
  l_reg = l_reg * alpha + ps;
#define PK4(P, BASE, OUT) do { unsigned a0 = cvtpk(P[BASE + 0], P[BASE + 1]), a1 = cvtpk(P[BASE + 2], P[BASE + 3]);   \
    unsigned b0 = cvtpk(P[BASE + 4], P[BASE + 5]), b1 = cvtpk(P[BASE + 6], P[BASE + 7]);                              \
    auto r0 = __builtin_amdgcn_permlane32_swap(a0, b0, false, false); auto r1 = __builtin_amdgcn_permlane32_swap(a1, b1, false, false); \
    u32x4 w = {r0[0], r1[0], r0[1], r1[1]}; OUT = *reinterpret_cast<bf16x8*>(&w); } while (0)
  PK4(p0, 0, pa0); PK4(p0, 8, pa1); PK4(p1, 0, pa2); PK4(p1, 8, pa3);
#undef PK4
}
__device__ __forceinline__ void qkt(f32x16& p0, f32x16& p1, const char* Ks, const bf16x8* qr, int r32, int hi) {
  const char* kb = Ks + r32 * KROW + hi * 16;
  const f32x16 z16 = {};
#pragma unroll
  for (int d0 = 0; d0 < 6; ++d0) {
    bf16x8 b0 = *reinterpret_cast<const bf16x8*>(kb + d0 * 32);
    bf16x8 b1 = *reinterpret_cast<const bf16x8*>(kb + 32 * KROW + d0 * 32);
    p0 = __builtin_amdgcn_mfma_f32_32x32x16_bf16(b0, qr[d0], d0 == 0 ? z16 : p0, 0, 0, 0);
    p1 = __builtin_amdgcn_mfma_f32_32x32x16_bf16(b1, qr[d0], d0 == 0 ? z16 : p1, 0, 0, 0); }
}
__device__ __forceinline__ int v_st(int k, int c) { const int kk = (k & ~0xC) | ((k & 4) << 1) | ((k & 8) >> 1); return ((kk >> 3) * 2 + (c >> 5)) * 512 + ((kk & 7) * 32 + (c & 31)) * 2; }
__device__ __forceinline__ int v_rd_base(int lane) { return ((lane & 3) << 3) | (((lane >> 2) & 3) << 6) | (((lane >> 4) & 1) << 5) | (((lane >> 5) & 1) << 8); }
constexpr int v_rd_off(int d0, int ks, int half) { return d0 * 512 + ks * 2048 + half * 1024; }
template <int OFF> __device__ __forceinline__ s16x4 tr_read(int vb) {
  s16x4 r; asm volatile("ds_read_b64_tr_b16 %0, %1 offset:%2" : "=&v"(r) : "v"(vb), "i"(OFF) : "memory"); return r;
}
template <int D0> __device__ __forceinline__ void pv_one(f32x16& od, int vb, bf16x8 pa0, bf16x8 pa1, bf16x8 pa2, bf16x8 pa3) {
  const s16x4 l0 = tr_read<v_rd_off(D0, 0, 0)>(vb), h0 = tr_read<v_rd_off(D0, 0, 1)>(vb), l1 = tr_read<v_rd_off(D0, 1, 0)>(vb), h1 = tr_read<v_rd_off(D0, 1, 1)>(vb);
  const s16x4 l2 = tr_read<v_rd_off(D0, 2, 0)>(vb), h2 = tr_read<v_rd_off(D0, 2, 1)>(vb), l3 = tr_read<v_rd_off(D0, 3, 0)>(vb), h3 = tr_read<v_rd_off(D0, 3, 1)>(vb);
  asm volatile("s_waitcnt lgkmcnt(0)" ::: "memory"); ASBAR();
#define PK(L, H) (bf16x8){L[0], L[1], L[2], L[3], H[0], H[1], H[2], H[3]}
  od = __builtin_amdgcn_mfma_f32_32x32x16_bf16(pa0, PK(l0, h0), od, 0, 0, 0);
  od = __builtin_amdgcn_mfma_f32_32x32x16_bf16(pa1, PK(l1, h1), od, 0, 0, 0);
  od = __builtin_amdgcn_mfma_f32_32x32x16_bf16(pa2, PK(l2, h2), od, 0, 0, 0);
  od = __builtin_amdgcn_mfma_f32_32x32x16_bf16(pa3, PK(l3, h3), od, 0, 0, 0);
#undef PK
}
__device__ __forceinline__ void pv_d0(f32x16* o, int vb, bf16x8 pa0, bf16x8 pa1, bf16x8 pa2, bf16x8 pa3) {
  pv_one<0>(o[0], vb, pa0, pa1, pa2, pa3); pv_one<1>(o[1], vb, pa0, pa1, pa2, pa3);
}

__device__ __forceinline__ void attn_unit(const bf16_t* __restrict__ Q, const bf16_t* __restrict__ KV, const bf16_t* __restrict__ PROJ, bf16_t* __restrict__ MIX,
                                          int h, int tq0, int kb0, int NT, char* lds) {
  int tid_ = threadIdx.x; asm volatile("" : "+v"(tid_));
  const int tid = tid_, wid = __builtin_amdgcn_readfirstlane(tid >> 6), lane = tid & 63, r32 = lane & 31, hi = lane >> 5;
  char* V_lds = lds + L_V; char* K_lds = lds + L_K;
  float* ws = (float*)(lds + L_WS) + wid * 64; float* li_l = ws; float* al_l = ws + 32;
  const int tmax = NT - 4 + (wid >> 1);
  float m_reg = -1e30f, l_reg = 0; f32x16 o[2] = {}; bf16x8 qr[6];
  const bf16_t* Qw = Q + (size_t)(tq0 + wid * 32 + r32) * 768 + h * 96 + hi * 8;
#pragma unroll
  for (int d0 = 0; d0 < 6; ++d0) qr[d0] = *reinterpret_cast<const bf16x8*>(Qw + d0 * 16);
  const int srow = tid >> 3, sch = tid & 7, prow = (tid & 255) >> 2, pch = tid & 3;
  const bf16_t* Kn = KV + (size_t)(kb0 + srow) * 1024 + h * 128 + sch * 8;
  const bf16_t* Kp = PROJ + (size_t)(kb0 + prow) * NP + P_KPE + pch * 8;
  const int kst = srow * KROW + sch * 16, pst = prow * KROW + 128 + pch * 16, vst = v_st(srow, sch * 8);
  const int vb0 = (int)(uintptr_t)V_lds + v_rd_base(lane);
  struct { bf16x8 kn, vv, kp; } sr_[2];
#define SLOAD(i, k0) do { sr_[i].kn = *reinterpret_cast<const bf16x8*>(Kn + (size_t)(k0) * 1024); sr_[i].vv = *reinterpret_cast<const bf16x8*>(Kn + (size_t)(k0) * 1024 + 64); \
    sr_[i].kp = *reinterpret_cast<const bf16x8*>(Kp + (size_t)(k0) * NP); } while (0)
#define SWRITE(kb_, vo_, i) do { *(bf16x8*)(K_lds + (kb_) * SHM_K + kst) = sr_[i].kn; *(bf16x8*)(K_lds + (kb_) * SHM_K + pst) = sr_[i].kp; *(bf16x8*)(V_lds + (vo_) + vst) = sr_[i].vv; } while (0)
#define RESC(a) do { if (__any((a) < 1.f)) { if (hi == 0) al_l[r32] = (a); asm volatile("s_waitcnt lgkmcnt(0)" ::: "memory"); \
    _Pragma("unroll") for (int d = 0; d < 2; ++d) _Pragma("unroll") for (int r = 0; r < 16; ++r) o[d][r] *= al_l[crow(r, hi)]; } } while (0)
#define MASKT(P0, P1, tt) do { if (__builtin_expect(__builtin_amdgcn_readfirstlane((tt) > tmax), 0)) { _Pragma("unroll") for (int r = 0; r < 16; ++r) { P0[r] = -1e30f; P1[r] = -1e30f; } } } while (0)
#define VNEXT(x) ((x) == 2 * SHM_V ? 0 : (x) + SHM_V)
#define SGB(mask, n) __builtin_amdgcn_sched_group_barrier((mask), (n), 0)
  f32x16 pA0, pA1, pB0, pB1; float mnA, mnB, alA, alB; bf16x8 pa0, pa1, pa2, pa3;
  s16x4 vl[2][4], vh[2][4];
#define VREADS(vo_) do { const int vb_ = vb0 + (vo_); \
    vl[0][0] = tr_read<v_rd_off(0, 0, 0)>(vb_); vh[0][0] = tr_read<v_rd_off(0, 0, 1)>(vb_); vl[1][0] = tr_read<v_rd_off(1, 0, 0)>(vb_); vh[1][0] = tr_read<v_rd_off(1, 0, 1)>(vb_); \
    vl[0][1] = tr_read<v_rd_off(0, 1, 0)>(vb_); vh[0][1] = tr_read<v_rd_off(0, 1, 1)>(vb_); vl[1][1] = tr_read<v_rd_off(1, 1, 0)>(vb_); vh[1][1] = tr_read<v_rd_off(1, 1, 1)>(vb_); \
    vl[0][2] = tr_read<v_rd_off(0, 2, 0)>(vb_); vh[0][2] = tr_read<v_rd_off(0, 2, 1)>(vb_); vl[1][2] = tr_read<v_rd_off(1, 2, 0)>(vb_); vh[1][2] = tr_read<v_rd_off(1, 2, 1)>(vb_); \
    vl[0][3] = tr_read<v_rd_off(0, 3, 0)>(vb_); vh[0][3] = tr_read<v_rd_off(0, 3, 1)>(vb_); vl[1][3] = tr_read<v_rd_off(1, 3, 0)>(vb_); vh[1][3] = tr_read<v_rd_off(1, 3, 1)>(vb_); } while (0)
#define PKV(d_, k_) (bf16x8){vl[d_][k_][0], vl[d_][k_][1], vl[d_][k_][2], vl[d_][k_][3], vh[d_][k_][0], vh[d_][k_][1], vh[d_][k_][2], vh[d_][k_][3]}
#define PVMM() do { \
    o[0] = __builtin_amdgcn_mfma_f32_32x32x16_bf16(pa0, PKV(0, 0), o[0], 0, 0, 0); o[1] = __builtin_amdgcn_mfma_f32_32x32x16_bf16(pa0, PKV(1, 0), o[1], 0, 0, 0); \
    o[0] = __builtin_amdgcn_mfma_f32_32x32x16_bf16(pa1, PKV(0, 1), o[0], 0, 0, 0); o[1] = __builtin_amdgcn_mfma_f32_32x32x16_bf16(pa1, PKV(1, 1), o[1], 0, 0, 0); \
    o[0] = __builtin_amdgcn_mfma_f32_32x32x16_bf16(pa2, PKV(0, 2), o[0], 0, 0, 0); o[1] = __builtin_amdgcn_mfma_f32_32x32x16_bf16(pa2, PKV(1, 2), o[1], 0, 0, 0); \
    o[0] = __builtin_amdgcn_mfma_f32_32x32x16_bf16(pa3, PKV(0, 3), o[0], 0, 0, 0); o[1] = __builtin_amdgcn_mfma_f32_32x32x16_bf16(pa3, PKV(1, 3), o[1], 0, 0, 0); } while (0)
#define STEP_FULL(BAND, PN0, PN1, mnN, alN, PO0, PO1, alO, ks_, tt) do { \
    ASBAR(); VREADS(vrd); \
    qkt(PN0, PN1, K_lds + (ks_) * SHM_K, qr, r32, hi); \
    finishSM(PO0, PO1, alO, l_reg, pa0, pa1, pa2, pa3); \
    _Pragma("unroll") for (int g_ = 0; g_ < 12; ++g_) { SGB(0x008, 1); SGB(0x100, 1); SGB(0x002, 7); } \
    ASBAR(); asm volatile("s_waitcnt lgkmcnt(0)" ::: "memory"); ASBAR(); \
    if (BAND) { const bool msk_ = (tt) > tmax; _Pragma("unroll") for (int r = 0; r < 16; ++r) { PN0[r] = msk_ ? -1e30f : PN0[r]; PN1[r] = msk_ ? -1e30f : PN1[r]; } } \
    PVMM(); partialSM(PN0, PN1, m_reg, mnN, alN); \
    _Pragma("unroll") for (int g_ = 0; g_ < 8; ++g_) { SGB(0x008, 1); SGB(0x002, 10); } \
    ASBAR(); RESC(alN); } while (0)
#define STEP(BAND, PN0, PN1, mnN, alN, PO0, PO1, alO, ks_, tt) do { \
    if (!(BAND) || __builtin_amdgcn_readfirstlane((tt) <= tmax + 1)) STEP_FULL(BAND, PN0, PN1, mnN, alN, PO0, PO1, alO, ks_, tt); \
    vrd = VNEXT(vrd); vwr = VNEXT(vwr); \
    __syncthreads(); } while (0)
  SLOAD(0, 0); SLOAD(1, 64);
  SWRITE(0, 0, 0); SWRITE(1, SHM_V, 1);
  SLOAD(0, 2 * 64); SLOAD(1, 3 * 64);
  __syncthreads();
  qkt(pA0, pA1, K_lds, qr, r32, hi); partialSM(pA0, pA1, m_reg, mnA, alA);
  __syncthreads();
  int vrd = 0, vwr = 2 * SHM_V;
  int j = 1;
  for (; j + 1 <= NT - 4; j += 2) {
    SWRITE(0, vwr, 0); if (j + 3 < NT) SLOAD(0, (j + 3) * 64);
    STEP(false, pB0, pB1, mnB, alB, pA0, pA1, alA, 1, j);
    SWRITE(1, vwr, 1); if (j + 4 < NT) SLOAD(1, (j + 4) * 64);
    STEP(false, pA0, pA1, mnA, alA, pB0, pB1, alB, 0, j + 1);
  }
  for (; j + 1 < NT; j += 2) {
    SWRITE(0, vwr, 0); if (j + 3 < NT) SLOAD(0, (j + 3) * 64);
    STEP(true, pB0, pB1, mnB, alB, pA0, pA1, alA, 1, j);
    if (j + 2 < NT) { SWRITE(1, vwr, 1); if (j + 4 < NT) SLOAD(1, (j + 4) * 64); }
    STEP(true, pA0, pA1, mnA, alA, pB0, pB1, alB, 0, j + 1);
  }
  STEP(true, pB0, pB1, mnB, alB, pA0, pA1, alA, 1, NT - 1);
  if (__builtin_amdgcn_readfirstlane(tmax >= NT - 2)) {
    ASBAR(); VREADS(vrd); finishSM(pB0, pB1, alB, l_reg, pa0, pa1, pa2, pa3);
    ASBAR(); asm volatile("s_waitcnt lgkmcnt(0)" ::: "memory"); ASBAR(); PVMM(); }
#undef STEP_FULL
#undef STEP
#undef PVMM
#undef PKV
#undef VREADS
#undef SGB
  if (hi == 0) li_l[r32] = l_reg; asm volatile("s_waitcnt lgkmcnt(0)" ::: "memory");
  float* stg = (float*)(lds + L_END) + wid * (32 * 68);
  const size_t trow = (size_t)(tq0 + wid * 32 + (lane >> 3)); const int ch = (lane & 7) * 8;
  u32x4 zz[4];
#pragma unroll
  for (int i = 0; i < 4; ++i) zz[i] = *(const u32x4*)(PROJ + (trow + 8 * i) * NP + P_MZ + h * 64 + ch);
#pragma unroll
  for (int r = 0; r < 16; ++r) { const float rl = __builtin_amdgcn_rcpf(li_l[crow(r, hi)]); const int orow = crow(r, hi);
#pragma unroll
    for (int d0 = 0; d0 < 2; ++d0) stg[orow * 68 + d0 * 32 + r32] = o[d0][r] * rl; }
  asm volatile("s_waitcnt lgkmcnt(0)" ::: "memory");
#pragma unroll
  for (int i = 0; i < 4; ++i) { const float* sp = stg + ((lane >> 3) + 8 * i) * 68 + ch; const f32x4 a = *(const f32x4*)sp, b = *(const f32x4*)(sp + 4);
    const f32x4 za = {__builtin_bit_cast(float, zz[i].x << 16), __builtin_bit_cast(float, zz[i].x & 0xffff0000u), __builtin_bit_cast(float, zz[i].y << 16), __builtin_bit_cast(float, zz[i].y & 0xffff0000u)};
    const f32x4 zb = {__builtin_bit_cast(float, zz[i].z << 16), __builtin_bit_cast(float, zz[i].z & 0xffff0000u), __builtin_bit_cast(float, zz[i].w << 16), __builtin_bit_cast(float, zz[i].w & 0xffff0000u)};
    *(u32x4*)(MIX + (trow + 8 * i) * 1024 + 256 + h * 64 + ch) = pack8bf(a * za, b * zb); }
  __syncthreads();
#undef SLOAD
#undef SWRITE
#undef RESC
#undef MASKT
#undef VNEXT
}
__device__ __forceinline__ void attn_phase(const bf16_t* Q, const bf16_t* KV, const bf16_t* PROJ, bf16_t* MIX, char* lds) {
  const int G = gridDim.x, bx = blockIdx.x; const int v = (G % 8 == 0) ? (bx % 8) * (G / 8) + bx / 8 : bx;
  for (int bh = v; bh < NB * 8; bh += G) {
    const int b = bh >> 3, h = bh & 7;
    for (int qb = 0; qb < S / 256; ++qb) attn_unit(Q, KV, PROJ, MIX, h, b * S + qb * 256, b * S, 4 * (qb + 1), lds);
  }
}
#undef ASBAR
}

namespace chain {
#define LDS3 __attribute__((address_space(3)))
typedef short v4i16_t __attribute__((ext_vector_type(4)));
__device__ __forceinline__ bf16x8 tr2(const LDS3 char* p0, const LDS3 char* p1) {
  const v4i16_t a = __builtin_amdgcn_ds_read_tr16_b64_v4i16((LDS3 v4i16_t*)p0), b = __builtin_amdgcn_ds_read_tr16_b64_v4i16((LDS3 v4i16_t*)p1);
  return (bf16x8){a[0], a[1], a[2], a[3], b[0], b[1], b[2], b[3]};
}
__device__ __forceinline__ bf16x8 ld16(const LDS3 char* p) { return *(const LDS3 bf16x8*)p; }
__device__ __forceinline__ bf16x8 pack8(f32x4 a, f32x4 b) { return __builtin_bit_cast(bf16x8, pack8bf(a, b)); }
__device__ __forceinline__ float grp16_sum(float v) { v += __shfl_xor(v, 1); v += __shfl_xor(v, 2); v += __shfl_xor(v, 4); v += __shfl_xor(v, 8); return v; }
__device__ __forceinline__ float bflo(unsigned w) { return __builtin_bit_cast(float, w << 16); }
__device__ __forceinline__ float bfhi(unsigned w) { return __builtin_bit_cast(float, w & 0xffff0000u); }
#define MFMA16(a, b, c) __builtin_amdgcn_mfma_f32_16x16x32_bf16((a), (b), (c), 0, 0, 0)
constexpr int RS = 144, TSZ = 64 * RS;
constexpr int RS2 = 80, TSZ2 = 64 * RS2;
constexpr int OSS = 68, OSZ = 16 * OSS * 4;
constexpr int NCH = S / 64;
#define CHAIN_BAR() do { asm volatile("s_waitcnt lgkmcnt(0)" ::: "memory"); __builtin_amdgcn_s_barrier(); asm volatile("" ::: "memory"); } while (0)

#define CSB() __builtin_amdgcn_sched_barrier(0)
template <bool HASW>
__device__ __forceinline__ void out_store(const f32x4 (&o)[4], LDS3 float* os, const LDS3 char* zrow, int lane, int fr, int g, const f32x4 (&gw4)[4], bf16_t* dst) {
#pragma unroll
  for (int et = 0; et < 4; ++et)
#pragma unroll
    for (int r = 0; r < 4; ++r) os[(4 * g + r) * OSS + 16 * et + fr] = o[et][r];
  const LDS3 f32x4* rp = (const LDS3 f32x4*)(os + (lane >> 2) * OSS + 16 * (lane & 3));
  f32x4 a = rp[0], b = rp[1], c = rp[2], d = rp[3];
  const u32x4 z0 = *(const LDS3 u32x4*)zrow, z1 = *(const LDS3 u32x4*)(zrow + 16);
  CSB();
  float ss = sumsq4(a) + sumsq4(b) + sumsq4(c) + sumsq4(d);
  ss += __shfl_xor(ss, 1); ss += __shfl_xor(ss, 2);
  const float rs = rsqrtf(ss * (1.f / 64.f) + EPS);
  a = a * rs; b = b * rs; c = c * rs; d = d * rs;
  if (HASW) { a = a * gw4[0]; b = b * gw4[1]; c = c * gw4[2]; d = d * gw4[3]; }
  f32x4 za = {bflo(z0.x), bfhi(z0.x), bflo(z0.y), bfhi(z0.y)}, zb = {bflo(z0.z), bfhi(z0.z), bflo(z0.w), bfhi(z0.w)};
  f32x4 zc = {bflo(z1.x), bfhi(z1.x), bflo(z1.y), bfhi(z1.y)}, zd = {bflo(z1.z), bfhi(z1.z), bflo(z1.w), bfhi(z1.w)};
  *(u32x4*)dst = pack8bf(a * za, b * zb); *(u32x4*)(dst + 8) = pack8bf(c * zc, d * zd);
}

struct RetStage { u32x4 k, v, q, z; };
__device__ __forceinline__ void ret_chain(const bf16_t* __restrict__ PROJ, bf16_t* __restrict__ MIX, int b, int h, LDS3 char* L) {
  int tid_ = threadIdx.x; asm volatile("" : "+v"(tid_));
  const int tid = tid_, wid = __builtin_amdgcn_readfirstlane(tid >> 6), lane = tid & 63, fr = lane & 15, g = lane >> 4, q4 = fr >> 2, p4 = fr & 3;
  constexpr int O_K = 0, O_V = 2 * TSZ, O_VS = 4 * TSZ, O_Q = 6 * TSZ, O_Z = 8 * TSZ, O_ST = 10 * TSZ, O_OS = 12 * TSZ;
  int ho = h; asm volatile("" : "+s"(ho));
  const float lg = ho == 0 ? -0.031748698314580298f : ho == 1 ? -0.015748356968139112f : ho == 2 ? -0.007843177461025892f : -0.003913899321136329f;
  const int t00 = b * S;
  const int srow = tid >> 3, spc = tid & 7, sOff = srow * RS + spc * 16;
  const bf16_t* gk = PROJ + (size_t)(t00 + srow) * NP + P_RK + h * 64 + spc * 8;
  const float kwj = __expf(lg * (float)(63 - srow));
  const bool outw = wid < 4; const int rb = wid & 3;
  bf16_t* gm = MIX + (size_t)(t00 + 16 * rb + (lane >> 2)) * 1024 + h * 64 + 16 * (lane & 3);
  LDS3 float* os = (LDS3 float*)(L + O_OS + rb * OSZ);
  const int zoff = (16 * rb + (lane >> 2)) * RS + 32 * (lane & 3);
  f32x4 gw4[4] = {};
  float decay[4][4], qw[4];
#pragma unroll
  for (int jt = 0; jt < 4; ++jt)
#pragma unroll
    for (int r = 0; r < 4; ++r) { const int d = (16 * rb + fr) - (16 * jt + 4 * g + r); decay[jt][r] = __expf(lg * (float)(d < 0 ? -d : d)); }
#pragma unroll
  for (int r = 0; r < 4; ++r) qw[r] = __expf(lg * (float)(16 * rb + 4 * g + r + 1));
  const float a64 = __expf(lg * 64.f);
  f32x4 Sacc[4];
#pragma unroll
  for (int e = 0; e < 4; ++e) Sacc[e] = (f32x4){0.f, 0.f, 0.f, 0.f};
  __syncthreads();
  for (int i = tid; i < TSZ / 4; i += 512) ((LDS3 unsigned*)(L + O_ST))[i] = 0u;
  RetStage R[4];
#define NTL(p) __builtin_nontemporal_load((const u32x4*)(p))
#define RLOAD(s, nn) do { const bf16_t* gn = gk + (size_t)(nn) * 64 * NP; R[s].k = NTL(gn); R[s].v = NTL(gn + 256); R[s].q = NTL(gn - 256); R[s].z = NTL(gn + 512); } while (0)
#pragma unroll
  for (int s = 0; s < 4; ++s) RLOAD(s, s);
  for (int n0 = 0; n0 < NCH; n0 += 4) {
#pragma unroll
    for (int s = 0; s < 4; ++s) {
      const int n = n0 + s, buf = s & 1;
      *(LDS3 u32x4*)(L + O_K + buf * TSZ + sOff) = R[s].k; *(LDS3 u32x4*)(L + O_V + buf * TSZ + sOff) = R[s].v;
      *(LDS3 u32x4*)(L + O_Q + buf * TSZ + sOff) = R[s].q; *(LDS3 u32x4*)(L + O_Z + buf * TSZ + sOff) = R[s].z;
      { const u32x4 vw = R[s].v;
        f32x4 lo = {bflo(vw.x), bfhi(vw.x), bflo(vw.y), bfhi(vw.y)}, hi2 = {bflo(vw.z), bfhi(vw.z), bflo(vw.w), bfhi(vw.w)};
        *(LDS3 u32x4*)(L + O_VS + buf * TSZ + sOff) = pack8bf(lo * kwj, hi2 * kwj); }
      { const int nn = (n + 4 < NCH) ? n + 4 : NCH - 1; RLOAD(s, nn); }
      CHAIN_BAR();
      const LDS3 char* KT = L + O_K + buf * TSZ; const LDS3 char* VT = L + O_V + buf * TSZ; const LDS3 char* VS = L + O_VS + buf * TSZ; const LDS3 char* QT = L + O_Q + buf * TSZ;
      if (outw) {
        const LDS3 char* STc = L + O_ST + buf * TSZ;
        const bf16x8 q0 = ld16(QT + (16 * rb + fr) * RS + 16 * g), q1 = ld16(QT + (16 * rb + fr) * RS + 64 + 16 * g);
        bf16x8 kf[4][2];
#pragma unroll
        for (int jt = 0; jt < 4; ++jt) { kf[jt][0] = ld16(KT + (16 * jt + fr) * RS + 16 * g); kf[jt][1] = ld16(KT + (16 * jt + fr) * RS + 64 + 16 * g); }
        CSB();
        f32x4 sT[4], o[4];
#pragma unroll
        for (int jt = 0; jt < 4; ++jt) { f32x4 a = (f32x4){0.f, 0.f, 0.f, 0.f}; a = MFMA16(kf[jt][0], q0, a); a = MFMA16(kf[jt][1], q1, a); sT[jt] = a; }
        bf16x8 sf[4][2], vf[4][2];
#pragma unroll
        for (int et = 0; et < 4; ++et) { sf[et][0] = ld16(STc + (16 * et + fr) * RS + 16 * g); sf[et][1] = ld16(STc + (16 * et + fr) * RS + 64 + 16 * g); }
#pragma unroll
        for (int et = 0; et < 4; ++et) {
          vf[et][0] = tr2(VT + (4 * g + q4) * RS + (16 * et + 4 * p4) * 2, VT + (16 + 4 * g + q4) * RS + (16 * et + 4 * p4) * 2);
          vf[et][1] = tr2(VT + (32 + 4 * g + q4) * RS + (16 * et + 4 * p4) * 2, VT + (48 + 4 * g + q4) * RS + (16 * et + 4 * p4) * 2); }
        CSB();
#pragma unroll
        for (int et = 0; et < 4; ++et) { f32x4 a = (f32x4){0.f, 0.f, 0.f, 0.f}; a = MFMA16(q0, sf[et][0], a); a = MFMA16(q1, sf[et][1], a); o[et] = a; }
#pragma unroll
        for (int jt = 0; jt < 4; ++jt)
#pragma unroll
          for (int r = 0; r < 4; ++r) sT[jt][r] *= decay[jt][r];
        const bf16x8 af0 = pack8(sT[0], sT[1]), af1 = pack8(sT[2], sT[3]);
#pragma unroll
        for (int et = 0; et < 4; ++et) {
#pragma unroll
          for (int r = 0; r < 4; ++r) o[et][r] *= qw[r];
          o[et] = MFMA16(af0, vf[et][0], o[et]); o[et] = MFMA16(af1, vf[et][1], o[et]); }
        out_store<false>(o, os, L + O_Z + buf * TSZ + zoff, lane, fr, g, gw4, gm + (size_t)n * 64 * 1024);
      } else {
        const int s4 = wid - 4; LDS3 char* STn = L + O_ST + (buf ^ 1) * TSZ;
        const bf16x8 kt0 = tr2(KT + (8 * g + q4) * RS + (16 * s4 + 4 * p4) * 2, KT + (8 * g + 4 + q4) * RS + (16 * s4 + 4 * p4) * 2);
        const bf16x8 kt1 = tr2(KT + (32 + 8 * g + q4) * RS + (16 * s4 + 4 * p4) * 2, KT + (32 + 8 * g + 4 + q4) * RS + (16 * s4 + 4 * p4) * 2);
        bf16x8 vs[4][2];
#pragma unroll
        for (int et = 0; et < 4; ++et) {
          vs[et][0] = tr2(VS + (8 * g + q4) * RS + (16 * et + 4 * p4) * 2, VS + (8 * g + 4 + q4) * RS + (16 * et + 4 * p4) * 2);
          vs[et][1] = tr2(VS + (32 + 8 * g + q4) * RS + (16 * et + 4 * p4) * 2, VS + (32 + 8 * g + 4 + q4) * RS + (16 * et + 4 * p4) * 2); }
        CSB();
#pragma unroll
        for (int et = 0; et < 4; ++et) {
          f32x4 a = Sacc[et] * a64;
          a = MFMA16(kt0, vs[et][0], a); a = MFMA16(kt1, vs[et][1], a);
          Sacc[et] = a;
          u32x2 w; w.x = cvt_pk_bf16(a[0], a[1]); w.y = cvt_pk_bf16(a[2], a[3]);
          *(LDS3 u32x2*)(STn + (16 * et + fr) * RS + (16 * s4 + 4 * g) * 2) = w;
        }
      }
    }
  }
#undef RLOAD
  __syncthreads();
}

struct GlaStage { u32x4 g0, g1, g2, v, z; };
__device__ __forceinline__ void gla_chain(const bf16_t* __restrict__ PROJ, const bf16_t* __restrict__ GP, const float* __restrict__ gnw, bf16_t* __restrict__ MIX, int b, int h, LDS3 char* L) {
  int tid_ = threadIdx.x; asm volatile("" : "+v"(tid_));
  const int tid = tid_, wid = __builtin_amdgcn_readfirstlane(tid >> 6), lane = tid & 63, fr = lane & 15, g = lane >> 4, q4 = fr >> 2, p4 = fr & 3;
  constexpr int O_QP = 0, O_QN = 2 * TSZ2, O_KN = 4 * TSZ2, O_KP = 6 * TSZ2, O_KD = 8 * TSZ2, O_V = 10 * TSZ2, O_Z = O_V + 2 * TSZ, O_ST = O_Z + 2 * TSZ, O_AL = O_ST + 2 * TSZ2, O_OS = O_AL + 256;
  const int t00 = b * S;
  const int srow = tid >> 3, spc = tid & 7, sOff = srow * RS + spc * 16;
  const bf16_t* gv = PROJ + (size_t)(t00 + srow) * NP + P_GV + h * 64 + spc * 8;
  const size_t item0 = ((size_t)(t00 >> 6)) * 4 + h;
  const bf16_t* gp = GP + item0 * GP_ITEM + (size_t)tid * 8;
  const int lpo = (tid & 63) * RS2 + ((tid >> 6) & 3) * 16;
  const int l0 = (tid >> 8) * 2 * TSZ2 + lpo;
  const int l1 = (2 + (tid >> 8)) * 2 * TSZ2 + lpo;
  const int l2 = tid < 256 ? 4 * 2 * TSZ2 + lpo : O_AL + (tid - 256) * 16;
  const int l2s = tid < 256 ? TSZ2 : 128;
  const bool has2 = tid < 264;
  const bool outw = wid < 4; const int rb = wid & 3;
  bf16_t* gm = MIX + (size_t)(t00 + 16 * rb + (lane >> 2)) * 1024 + 768 + h * 64 + 16 * (lane & 3);
  LDS3 float* os = (LDS3 float*)(L + O_OS + rb * OSZ);
  const int zoff = (16 * rb + (lane >> 2)) * RS + 32 * (lane & 3);
  f32x4 gw4[4];
#pragma unroll
  for (int i = 0; i < 4; ++i) gw4[i] = *(const f32x4*)(gnw + 16 * (lane & 3) + 4 * i);
  const int sdt = wid & 1, set0 = ((wid >> 1) & 1) * 2;
  f32x4 Sacc[2];
  Sacc[0] = (f32x4){0.f, 0.f, 0.f, 0.f}; Sacc[1] = (f32x4){0.f, 0.f, 0.f, 0.f};
  __syncthreads();
  for (int i = tid; i < TSZ2 / 4; i += 512) ((LDS3 unsigned*)(L + O_ST))[i] = 0u;
  GlaStage R[4];
#define GLOAD(s, nn) do { const bf16_t* gpn = gp + (size_t)(nn) * (4 * GP_ITEM); R[s].g0 = NTL(gpn); R[s].g1 = NTL(gpn + 512 * 8); if (has2) R[s].g2 = NTL(gpn + 1024 * 8); \
    R[s].v = NTL(gv + (size_t)(nn) * 64 * NP); R[s].z = NTL(gv + (size_t)(nn) * 64 * NP + 256); } while (0)
#pragma unroll
  for (int s = 0; s < 4; ++s) GLOAD(s, s);
  for (int n0 = 0; n0 < NCH; n0 += 4) {
#pragma unroll
    for (int s = 0; s < 4; ++s) {
      const int n = n0 + s, buf = s & 1;
      *(LDS3 u32x4*)(L + O_V + buf * TSZ + sOff) = R[s].v; *(LDS3 u32x4*)(L + O_Z + buf * TSZ + sOff) = R[s].z;
      *(LDS3 u32x4*)(L + buf * TSZ2 + l0) = R[s].g0; *(LDS3 u32x4*)(L + buf * TSZ2 + l1) = R[s].g1; if (has2) *(LDS3 u32x4*)(L + buf * l2s + l2) = R[s].g2;
      { const int nn = (n + 4 < NCH) ? n + 4 : NCH - 1; GLOAD(s, nn); }
      CHAIN_BAR();
      const LDS3 char* VT = L + O_V + buf * TSZ;
      if (outw) {
        const LDS3 char* QP = L + O_QP + buf * TSZ2; const LDS3 char* QN = L + O_QN + buf * TSZ2; const LDS3 char* KN = L + O_KN + buf * TSZ2; const LDS3 char* KP = L + O_KP + buf * TSZ2;
        const LDS3 char* STc = L + O_ST + buf * TSZ2;
        const bf16x8 qpf = ld16(QP + (16 * rb + fr) * RS2 + 16 * g), qnf = ld16(QN + (16 * rb + fr) * RS2 + 16 * g);
        bf16x8 knf[4], kpf[4];
#pragma unroll
        for (int jt = 0; jt < 4; ++jt) { knf[jt] = ld16(KN + (16 * jt + fr) * RS2 + 16 * g); kpf[jt] = ld16(KP + (16 * jt + fr) * RS2 + 16 * g); }
        CSB();
        f32x4 past[4], fut[4], o[4];
        const f32x4 z4 = (f32x4){0.f, 0.f, 0.f, 0.f};
#pragma unroll
        for (int jt = 0; jt < 4; ++jt) { past[jt] = MFMA16(knf[jt], qpf, z4); fut[jt] = MFMA16(kpf[jt], qnf, z4); }
        bf16x8 sf[4], vf[4][2];
#pragma unroll
        for (int et = 0; et < 4; ++et) sf[et] = ld16(STc + (16 * et + fr) * RS2 + 16 * g);
#pragma unroll
        for (int et = 0; et < 4; ++et) {
          vf[et][0] = tr2(VT + (4 * g + q4) * RS + (16 * et + 4 * p4) * 2, VT + (16 + 4 * g + q4) * RS + (16 * et + 4 * p4) * 2);
          vf[et][1] = tr2(VT + (32 + 4 * g + q4) * RS + (16 * et + 4 * p4) * 2, VT + (48 + 4 * g + q4) * RS + (16 * et + 4 * p4) * 2); }
        CSB();
#pragma unroll
        for (int et = 0; et < 4; ++et) o[et] = MFMA16(qpf, sf[et], z4);
        f32x4 sT[4];
#pragma unroll
        for (int jt = 0; jt < 4; ++jt)
#pragma unroll
          for (int r = 0; r < 4; ++r) sT[jt][r] = ((16 * rb + fr) >= (16 * jt + 4 * g + r)) ? past[jt][r] : fut[jt][r];
        const bf16x8 af0 = pack8(sT[0], sT[1]), af1 = pack8(sT[2], sT[3]);
#pragma unroll
        for (int et = 0; et < 4; ++et) { o[et] = MFMA16(af0, vf[et][0], o[et]); o[et] = MFMA16(af1, vf[et][1], o[et]); }
        out_store<true>(o, os, L + O_Z + buf * TSZ + zoff, lane, fr, g, gw4, gm + (size_t)n * 64 * 1024);
      } else {
        const LDS3 char* KD = L + O_KD + buf * TSZ2; LDS3 char* STn = L + O_ST + (buf ^ 1) * TSZ2;
        const f32x4 al = *(const LDS3 f32x4*)(L + O_AL + buf * 128 + (16 * sdt + 4 * g) * 4);
        const bf16x8 kt0 = tr2(KD + (8 * g + q4) * RS2 + (16 * sdt + 4 * p4) * 2, KD + (8 * g + 4 + q4) * RS2 + (16 * sdt + 4 * p4) * 2);
        const bf16x8 kt1 = tr2(KD + (32 + 8 * g + q4) * RS2 + (16 * sdt + 4 * p4) * 2, KD + (32 + 8 * g + 4 + q4) * RS2 + (16 * sdt + 4 * p4) * 2);
        bf16x8 vv[2][2];
#pragma unroll
        for (int e2 = 0; e2 < 2; ++e2) { const int et = set0 + e2;
          vv[e2][0] = tr2(VT + (8 * g + q4) * RS + (16 * et + 4 * p4) * 2, VT + (8 * g + 4 + q4) * RS + (16 * et + 4 * p4) * 2);
          vv[e2][1] = tr2(VT + (32 + 8 * g + q4) * RS + (16 * et + 4 * p4) * 2, VT + (32 + 8 * g + 4 + q4) * RS + (16 * et + 4 * p4) * 2); }
        CSB();
#pragma unroll
        for (int e2 = 0; e2 < 2; ++e2) { const int et = set0 + e2;
          f32x4 a = Sacc[e2] * al;
          a = MFMA16(kt0, vv[e2][0], a); a = MFMA16(kt1, vv[e2][1], a);
          Sacc[e2] = a;
          u32x2 w; w.x = cvt_pk_bf16(a[0], a[1]); w.y = cvt_pk_bf16(a[2], a[3]);
          *(LDS3 u32x2*)(STn + (16 * et + fr) * RS2 + (16 * sdt + 4 * g) * 2) = w;
        }
      }
    }
  }
#undef GLOAD
  __syncthreads();
}
__device__ __forceinline__ void chain_phase(const bf16_t* PROJ, const bf16_t* GP, const float* gnw, bf16_t* MIX, LDS3 char* L) {
  const int G = gridDim.x, bx = blockIdx.x; const int v = (G % 8 == 0) ? (bx % 8) * (G / 8) + bx / 8 : bx;
  for (int c = v; c < NB * 8; c += G) {
    const int b = c >> 3, h = c & 3;
    if ((c >> 2) & 1) gla_chain(PROJ, GP, gnw, MIX, b, h, L); else ret_chain(PROJ, MIX, b, h, L);
  }
}
#undef MFMA16
}

namespace atths {
using bf16=unsigned short;
using s16x4=__attribute__((ext_vector_type(4)))short;
using f32x16=__attribute__((ext_vector_type(16)))float;
constexpr int QP=768,KVP=1024;
constexpr int NW=8,QBLK=32,QB=QBLK*NW,KVBLK=64;
__device__ __forceinline__ int crow(int r,int hi){return (r&3)+8*(r>>2)+4*hi;}
#define SBAR() __builtin_amdgcn_sched_barrier(0)
__device__ __forceinline__ void cmask(f32x16&p0,f32x16&p1,int jb,int wq){
  const float NEG=-INFINITY;
  if(jb>wq){
  #pragma unroll
  for(int r=0;r<16;++r){p0[r]=NEG;p1[r]=NEG;}}
}

constexpr int NSK=4, SLOTK=12288, NSV=3, SLOTV=8192;
constexpr int LDS_K=0, LDS_V=NSK*SLOTK, LDS_WS=LDS_V+NSV*SLOTV, LDS_W=LDS_WS+NW*64*4, LDS_WKV=LDS_W+49152, LDS_OST=0, LDS_BYTES=LDS_WKV+32768;
__device__ __forceinline__ void glds16(const void*gbase,unsigned voff,unsigned lds_dst){unsigned keep;
  asm volatile("s_mov_b32 %0, m0\n\ts_mov_b32 m0, %3\n\ts_nop 0\n\tglobal_load_lds_dwordx4 %1, %2\n\ts_mov_b32 m0, %0":"=&s"(keep):"v"(voff),"s"(gbase),"s"(lds_dst):"memory");}
__device__ __forceinline__ float max3f(float a,float b,float c){float r;asm("v_max3_f32 %0, %1, %2, %3":"=v"(r):"v"(a),"v"(b),"v"(c));return r;}
__device__ __forceinline__ float max2f(float a,float b){float r;asm("v_max_f32_e32 %0, %1, %2":"=v"(r):"v"(a),"v"(b));return r;}
__device__ __forceinline__ float fadd_s(float a,float b){float r;asm("v_add_f32_e32 %0, %1, %2":"=v"(r):"v"(a),"v"(b));return r;}
__device__ __forceinline__ float fsub_s(float a,float b){float r;asm("v_sub_f32_e32 %0, %1, %2":"=v"(r):"v"(a),"v"(b));return r;}
typedef float f32x2_t __attribute__((ext_vector_type(2))); typedef __bf16 bf16x2_t __attribute__((ext_vector_type(2)));
__device__ __forceinline__ unsigned cvtpk_s(float lo,float hi){f32x2_t v={lo,hi};bf16x2_t b=__builtin_convertvector(v,bf16x2_t);return __builtin_bit_cast(unsigned,b);}
#define WAIT_BAR(N) asm volatile("s_waitcnt vmcnt(" #N ") lgkmcnt(0)\n\ts_barrier":::"memory")

__device__ __forceinline__ void qkt(f32x16&p0,f32x16&p1,const char*Kslot,const bf16x8*qr,const f32x16&negm,int r32,int hi){
  const char*kb=Kslot+hi*1024+r32*16;
  #pragma unroll
  for(int d0=0;d0<6;++d0){
    const bf16x8 b0=*reinterpret_cast<const bf16x8*>(kb+d0*2048);
    const bf16x8 b1=*reinterpret_cast<const bf16x8*>(kb+d0*2048+512);
    if(d0==0){p0=__builtin_amdgcn_mfma_f32_32x32x16_bf16(b0,qr[0],negm,0,0,0);p1=__builtin_amdgcn_mfma_f32_32x32x16_bf16(b1,qr[0],negm,0,0,0);}
    else{p0=__builtin_amdgcn_mfma_f32_32x32x16_bf16(b0,qr[d0],p0,0,0,0);p1=__builtin_amdgcn_mfma_f32_32x32x16_bf16(b1,qr[d0],p1,0,0,0);}}
}
typedef __attribute__((address_space(3))) const char* lds_cptr;
typedef short v4i16_t __attribute__((ext_vector_type(4)));
__device__ __forceinline__ void kload8(bf16x8*kf,lds_cptr kp){
  kf[0]=*(const __attribute__((address_space(3))) bf16x8*)(kp);      kf[1]=*(const __attribute__((address_space(3))) bf16x8*)(kp+512);
  kf[2]=*(const __attribute__((address_space(3))) bf16x8*)(kp+2048); kf[3]=*(const __attribute__((address_space(3))) bf16x8*)(kp+2560);
  kf[4]=*(const __attribute__((address_space(3))) bf16x8*)(kp+4096); kf[5]=*(const __attribute__((address_space(3))) bf16x8*)(kp+4608);
  kf[6]=*(const __attribute__((address_space(3))) bf16x8*)(kp+6144); kf[7]=*(const __attribute__((address_space(3))) bf16x8*)(kp+6656);
}
__device__ __forceinline__ void kload2(bf16x8*kf,lds_cptr kp,int j){ kf[2*j]=*(const __attribute__((address_space(3))) bf16x8*)(kp+j*2048); kf[2*j+1]=*(const __attribute__((address_space(3))) bf16x8*)(kp+j*2048+512); }
__device__ __forceinline__ s16x4 vtr(lds_cptr p){ return __builtin_bit_cast(s16x4,__builtin_amdgcn_ds_read_tr16_b64_v4i16((__attribute__((address_space(3))) v4i16_t*)p)); }
__device__ __forceinline__ float rowmax(const f32x16&p0,const f32x16&p1){
  float a=max3f(p0[0],p0[1],p1[0]),b=max3f(p0[2],p0[3],p1[1]);a=max3f(a,p1[2],p1[3]);
  #pragma unroll
  for(int r=4;r<16;r+=4){a=max3f(a,p0[r],p0[r+1]);b=max3f(b,p0[r+2],p0[r+3]);a=max3f(a,p1[r],p1[r+1]);b=max3f(b,p1[r+2],p1[r+3]);}
  const float m=max2f(a,b);
  auto rr=__builtin_amdgcn_permlane32_swap(__float_as_uint(m),__float_as_uint(m),false,false);
  return max2f(__uint_as_float(rr[0]),__uint_as_float(rr[1]));
}
__device__ __forceinline__ void pv(f32x16*o,int vb,bf16x8 pa0,bf16x8 pa1,bf16x8 pa2,bf16x8 pa3){
  #pragma unroll
  for(int d0=0;d0<2;++d0){s16x4 lo[4],hi[4];
    #pragma unroll
    for(int ks=0;ks<4;++ks){
      asm volatile("ds_read_b64_tr_b16 %0,%1 offset:%c2":"=&v"(lo[ks]):"v"(vb),"i"(d0*4096+ks*1024):"memory");
      asm volatile("ds_read_b64_tr_b16 %0,%1 offset:%c2":"=&v"(hi[ks]):"v"(vb),"i"(d0*4096+ks*1024+512):"memory");}
    asm volatile("s_waitcnt lgkmcnt(0)":::"memory");SBAR();
    #define PK(k) (bf16x8){lo[k][0],lo[k][1],lo[k][2],lo[k][3],hi[k][0],hi[k][1],hi[k][2],hi[k][3]}
    o[d0]=__builtin_amdgcn_mfma_f32_32x32x16_bf16(pa0,PK(0),o[d0],0,0,0);
    o[d0]=__builtin_amdgcn_mfma_f32_32x32x16_bf16(pa1,PK(1),o[d0],0,0,0);
    o[d0]=__builtin_amdgcn_mfma_f32_32x32x16_bf16(pa2,PK(2),o[d0],0,0,0);
    o[d0]=__builtin_amdgcn_mfma_f32_32x32x16_bf16(pa3,PK(3),o[d0],0,0,0);
    #undef PK
  }
}

#ifndef ATTN_STORE16
#define ATTN_STORE16(p,v) (*(u32x4*)(p)=(v))
#endif
template<int THRL> __device__ __forceinline__ void attn_unit(int b,int h,int qb,const bf16*__restrict__ Wq,const bf16*__restrict__ Wkv,const bf16*__restrict__ MQF,const bf16*__restrict__ MKVF,const float*__restrict__ SSP,const float2*__restrict__ CS16,bf16*KT,const bf16*__restrict__ KPE,const bf16*__restrict__ PROJ,bf16*MIX,char*shm,bool first){
  int tid_=threadIdx.x; asm volatile("":"+v"(tid_));
  const int tid=tid_,lane=tid&63,r32=lane&31,hi=lane>>5; const int wid=__builtin_amdgcn_readfirstlane(tid>>6);
  const long rowbase=(long)b*S; const int q0=qb*QB;
  bf16*KTh=KT+(size_t)((b*8+h)*(S/KVBLK))*8192; const bf16*Ph=KPE+(size_t)(b*(S/KVBLK))*2048;
  const unsigned lds0=(unsigned)(uintptr_t)shm;
  float*wsf=(float*)(shm+LDS_WS)+wid*64;
  const unsigned ksrc=(unsigned)(wid*512+lane*8)*2u;
  const unsigned ksrc2=(unsigned)((wid&3)*512+lane*8)*2u;
  const unsigned vsrc=(unsigned)(4096+wid*512+lane*8)*2u;
  const unsigned kdst=lds0+LDS_K+wid*1024, kdst2=lds0+LDS_K+(8+(wid&3))*1024, vdst=lds0+LDS_V+wid*1024;
  #define DMA_K(t,slot) do{ glds16(KTh,ksrc+(unsigned)(t)*16384u,(unsigned)__builtin_amdgcn_readfirstlane(kdst+(slot))); glds16(Ph,ksrc2+(unsigned)(t)*4096u,(unsigned)__builtin_amdgcn_readfirstlane(kdst2+(slot))); }while(0)
  #define DMA_V(t,slot) glds16(KTh,vsrc+(unsigned)(t)*16384u,(unsigned)__builtin_amdgcn_readfirstlane(vdst+(slot)))
  const int vb0=(int)(lds0+LDS_V)+((lane>>4)&1)*32+(lane&3)*8+(4*hi+((lane&15)>>2))*64;
  const char*Kbase=shm+LDS_K; bf16x8 kf[8];
  const lds_cptr shm3=(lds_cptr)shm; const lds_cptr kp0=shm3+LDS_K+hi*1024+r32*16; const lds_cptr vp0=shm3+LDS_V+((lane>>4)&1)*32+(lane&3)*8+(4*hi+((lane&15)>>2))*64;
  const int NT=(q0+QB)/KVBLK;
  if(first){
    const int m_=lane&31; const int pc_=16*(m_>>4)+8*((m_>>2)&1)+4*((m_>>3)&1)+(m_&3);
    const unsigned wv=(unsigned)(pc_*256+8*hi)*2u, wv2=(unsigned)(pc_*128+8*hi)*2u;
    #pragma unroll
    for(int i=0;i<6;++i){ const int blk=wid*6+i; const int nb=blk>>4,ks=blk&15;
      glds16((const char*)Wq+(size_t)(((h*96+32*nb)*256+16*ks)*2),wv,(unsigned)__builtin_amdgcn_readfirstlane(lds0+LDS_W+blk*1024)); }
    #pragma unroll
    for(int i=0;i<4;++i){ const int blk=wid*4+i; const int nb=blk>>3,ks=blk&7;
      glds16((const char*)Wkv+(size_t)(((h*128+32*nb)*128+16*ks)*2),wv2,(unsigned)__builtin_amdgcn_readfirstlane(lds0+LDS_WKV+blk*1024)); } }
  if(qb>0){DMA_K(0,0);DMA_V(0,0);DMA_K(1,SLOTK);DMA_K(2,2*SLOTK);}
  bf16x8 qr[6];
  { const unsigned trq=(unsigned)(rowbase+q0+wid*QBLK+r32);
    bf16x8 bkv[8],bq[16];
    #pragma unroll
    for(int ks=0;ks<8;++ks)bkv[ks]=*reinterpret_cast<const bf16x8*>(MKVF+((((trq>>5)*8+ks)*2+hi)*32+r32)*8);
    const f32x4*sp=(const f32x4*)(SSP+trq*12); const f32x4 s2=sp[2];
    if(first){WAIT_BAR(0);}
    {
      f32x16 ka[4];ka[0]=f32x16{};ka[1]=f32x16{};ka[2]=f32x16{};ka[3]=f32x16{};
      const unsigned wka=lds0+LDS_WKV+lane*16; bf16x8 fa[4],fb[4];
      #define LDSR(dst,addr,off) asm volatile("ds_read_b128 %0, %1 offset:%2":"=v"(dst):"v"(addr),"i"(off):"memory")
      #define LWAIT4(n,x) asm volatile("s_waitcnt lgkmcnt(" #n ")":"+v"(x[0]),"+v"(x[1]),"+v"(x[2]),"+v"(x[3])::"memory")
      #define LWAIT3(n,x) asm volatile("s_waitcnt lgkmcnt(" #n ")":"+v"(x[0]),"+v"(x[1]),"+v"(x[2])::"memory")
      #pragma unroll
      for(int nb=0;nb<4;++nb)LDSR(fa[nb],wka,(nb*8)*1024);
      #pragma unroll
      for(int ks=0;ks<8;ks+=2){
        #pragma unroll
        for(int nb=0;nb<4;++nb)LDSR(fb[nb],wka,(nb*8+ks+1)*1024);
        LWAIT4(4,fa);
        #pragma unroll
        for(int nb=0;nb<4;++nb)ka[nb]=__builtin_amdgcn_mfma_f32_32x32x16_bf16(fa[nb],bkv[ks],ka[nb],0,0,0);
        SBAR();
        if(ks+2<8){
          #pragma unroll
          for(int nb=0;nb<4;++nb)LDSR(fa[nb],wka,(nb*8+ks+2)*1024);
          LWAIT4(4,fb); }
        else { LWAIT4(0,fb); }
        #pragma unroll
        for(int nb=0;nb<4;++nb)ka[nb]=__builtin_amdgcn_mfma_f32_32x32x16_bf16(fb[nb],bkv[ks+1],ka[nb],0,0,0);
        SBAR(); }
      asm volatile("":::"memory");
      #pragma unroll
      for(int ks=0;ks<16;++ks)bq[ks]=*reinterpret_cast<const bf16x8*>(MQF+((((trq>>5)*16+ks)*2+hi)*32+r32)*8);
      const float rk=rsqrtf(((s2.x+s2.y)+(s2.z+s2.w))*(1.f/128.f)+EPS);
      bf16*tb=KTh+(size_t)(4*qb+(wid>>1))*8192; const int rt=32*(wid&1)+r32;
      #pragma unroll
      for(int nb=0;nb<4;++nb){
        #pragma unroll
        for(int hf=0;hf<2;++hf){ u32x4 w;
          w.x=cvtpk_s(ka[nb][8*hf+0]*rk,ka[nb][8*hf+1]*rk); w.y=cvtpk_s(ka[nb][8*hf+2]*rk,ka[nb][8*hf+3]*rk); w.z=cvtpk_s(ka[nb][8*hf+4]*rk,ka[nb][8*hf+5]*rk); w.w=cvtpk_s(ka[nb][8*hf+6]*rk,ka[nb][8*hf+7]*rk);
          if(nb<2) *(u32x4*)(tb+((4*nb+2*hf+hi)*512+rt*8))=w;
          else     *(u32x4*)(tb+(4096+(nb-2)*2048+rt*32+(2*hf+hi)*8))=w; } } }
    const f32x4 s0=sp[0],s1=sp[1];
    const f32x4*cp=(const f32x4*)(CS16+trq*16+4*hi); const f32x4 c0=cp[0],c1=cp[1],c2=cp[4],c3=cp[5];
    f32x16 qa[3];qa[0]=f32x16{};qa[1]=f32x16{};qa[2]=f32x16{};
    { const unsigned wpa=lds0+LDS_W+lane*16; bf16x8 fa[3],fb[3];
      #pragma unroll
      for(int nb=0;nb<3;++nb)LDSR(fa[nb],wpa,(nb*16)*1024);
      #pragma unroll
      for(int ks=0;ks<16;ks+=2){
        #pragma unroll
        for(int nb=0;nb<3;++nb)LDSR(fb[nb],wpa,(nb*16+ks+1)*1024);
        LWAIT3(3,fa);
        #pragma unroll
        for(int nb=0;nb<3;++nb)qa[nb]=__builtin_amdgcn_mfma_f32_32x32x16_bf16(fa[nb],bq[ks],qa[nb],0,0,0);
        SBAR();
        if(ks+2<16){
          #pragma unroll
          for(int nb=0;nb<3;++nb)LDSR(fa[nb],wpa,(nb*16+ks+2)*1024);
          LWAIT3(3,fb); }
        else { LWAIT3(0,fb); }
        #pragma unroll
        for(int nb=0;nb<3;++nb)qa[nb]=__builtin_amdgcn_mfma_f32_32x32x16_bf16(fb[nb],bq[ks+1],qa[nb],0,0,0);
        SBAR(); } }
    #undef LDSR
    #undef LWAIT4
    #undef LWAIT3
    const float rs=rsqrtf(((s0.x+s0.y)+(s0.z+s0.w)+(s1.x+s1.y)+(s1.z+s1.w))*(1.f/256.f)+EPS)*QSCALE;
    { const f32x4 a={qa[2][0],qa[2][1],qa[2][2],qa[2][3]},b4={qa[2][4],qa[2][5],qa[2][6],qa[2][7]},c4={qa[2][8],qa[2][9],qa[2][10],qa[2][11]},d4={qa[2][12],qa[2][13],qa[2][14],qa[2][15]};
      const f32x4 ra=rope4(a,c0),rb=rope4(b4,c1),rc=rope4(c4,c2),rd=rope4(d4,c3);
      #pragma unroll
      for(int i=0;i<4;++i){qa[2][i]=ra[i];qa[2][4+i]=rb[i];qa[2][8+i]=rc[i];qa[2][12+i]=rd[i];} }
    #pragma unroll
    for(int nb=0;nb<3;++nb){
      #pragma unroll
      for(int hf=0;hf<2;++hf){ u32x4 w;
        w.x=cvtpk_s(qa[nb][8*hf+0]*rs,qa[nb][8*hf+1]*rs); w.y=cvtpk_s(qa[nb][8*hf+2]*rs,qa[nb][8*hf+3]*rs); w.z=cvtpk_s(qa[nb][8*hf+4]*rs,qa[nb][8*hf+5]*rs); w.w=cvtpk_s(qa[nb][8*hf+6]*rs,qa[nb][8*hf+7]*rs);
        qr[2*nb+hf]=__builtin_bit_cast(bf16x8,w); } } }
  if(qb>0){WAIT_BAR(8);} else {WAIT_BAR(0);}
  float mhat=0.f,l_reg=0.f;f32x16 o[2];o[0]=f32x16{};o[1]=f32x16{};f32x16 negm=f32x16{};asm volatile("":"+v"(negm));
  const int wq=wid>>1;
  #define CMASK(P0,P1,t) do{int jb_=(t)-(NT-4); if(jb_>=0)cmask(P0,P1,jb_,wq);}while(0)
  bool resc=false;
  #define START(P0,P1) do{ const float rm=rowmax(P0,P1); resc=false; \
    { const float dl=rm; mhat=fadd_s(mhat,dl); \
      _Pragma("unroll") for(int r=0;r<16;++r){P0[r]=fsub_s(P0[r],dl);P1[r]=fsub_s(P1[r],dl);} \
      _Pragma("unroll") for(int r=0;r<16;++r)negm[r]=-mhat; asm volatile("":"+v"(negm)); } \
    _Pragma("unroll") for(int r=0;r<16;++r)P0[r]=__builtin_amdgcn_exp2f(P0[r]); }while(0)
  #define RESC() do{ if(resc){ asm volatile("s_waitcnt lgkmcnt(0)":::"memory"); \
      _Pragma("unroll") for(int d_=0;d_<2;++d_) _Pragma("unroll") for(int r=0;r<16;++r)o[d_][r]*=wsf[crow(r,hi)]; } }while(0)
  f32x16 pA0,pA1,pB0,pB1;
  int sl_prev=0,sl_cur=0,sl_next=SLOTV;
  int kc=0,kn=SLOTK,kw=3*SLOTK;
  #define ROT() do{sl_prev=sl_cur;sl_cur=sl_next;sl_next=(sl_next==(NSV-1)*SLOTV)?0:sl_next+SLOTV; kc=kn;kn=(kn==(NSK-1)*SLOTK)?0:kn+SLOTK;kw=(kw==(NSK-1)*SLOTK)?0:kw+SLOTK;}while(0)
  if(qb==0){ DMA_K(0,0);DMA_V(0,0);DMA_K(1,SLOTK);DMA_K(2,2*SLOTK); WAIT_BAR(5); }
  qkt(pA0,pA1,Kbase,qr,negm,r32,hi);asm volatile("s_nop 15\n\ts_nop 7":"+v"(pA0),"+v"(pA1));CMASK(pA0,pA1,0);
  START(pA0,pA1);
  _Pragma("unroll") for(int r=0;r<16;++r)pA1[r]=__builtin_amdgcn_exp2f(pA1[r]);
  WAIT_BAR(0);
  DMA_K(3,3*SLOTK);DMA_V(1,SLOTV);
  ROT();
  kload8(kf,kp0+kc);
  WAIT_BAR(3);
  s16x4 vlo[8],vhi[8]; u32x4 pw0,pw1,pw2,pw3;
  #define PKW(P,B) cvtpk_s(P[B],P[B+1])
  #define PAF(k) __builtin_bit_cast(bf16x8,pw##k)
  #define VFR(i) (bf16x8){vlo[i][0],vlo[i][1],vlo[i][2],vlo[i][3],vhi[i][0],vhi[i][1],vhi[i][2],vhi[i][3]}
  #define PIN(x) asm volatile("":"+v"(x))
  #define MX3(a,b,c) __builtin_fmaxf(__builtin_fmaxf((a),(b)),(c))
  #define GAPA(MF,A0,A1,A2,A3,W0,W1,PW) do{ MF; sacc+=A0; sacc+=A1; sacc+=A2; sacc+=A3; PIN(sacc); W0; W1; PIN(PW); SBAR(); }while(0)
  #define EX(v) __builtin_amdgcn_exp2f(v)
  #define GAPB(MF,X,B) do{ MF; X[B]=EX(X[B]); X[B+1]=EX(X[B+1]); X[B+2]=EX(X[B+2]); X[B+3]=EX(X[B+3]); PIN(X); SBAR(); }while(0)
  #define VRD(i) do{ vlo[i]=vtr(vp_+(((i)>>2)*4096+((i)&3)*1024)); vhi[i]=vtr(vp_+(((i)>>2)*4096+((i)&3)*1024+512)); }while(0)
  #define KRD(G,j) do{ if(G){ kload2(kf,kp0+kn,j); SBAR(); } }while(0)
  #define STEP(C0,C1,P0,P1,t,GK,GV,GL) do{ SBAR(); \
    const lds_cptr vp_=vp0+sl_prev; const lds_cptr ke_=kp0+kc+8192; bf16x8 e0_,e1_,e2_,e3_; \
    VRD(0); SBAR(); float sacc=(P0[0]+P0[1]); \
    GAPA(C0=__builtin_amdgcn_mfma_f32_32x32x16_bf16(kf[0],qr[0],negm,0,0,0), P0[2],P0[3],P0[4],P0[5],     pw0[0]=PKW(P0,0), pw0[1]=PKW(P0,2), pw0); \
    VRD(4); SBAR(); GAPA(C1=__builtin_amdgcn_mfma_f32_32x32x16_bf16(kf[1],qr[0],negm,0,0,0), P0[6],P0[7],P0[8],P0[9],     pw0[2]=PKW(P0,4), pw0[3]=PKW(P0,6), pw0); \
    VRD(1); SBAR(); GAPA(C0=__builtin_amdgcn_mfma_f32_32x32x16_bf16(kf[2],qr[1],C0,0,0,0),   P0[10],P0[11],P0[12],P0[13], pw1[0]=PKW(P0,8), pw1[1]=PKW(P0,10), pw1); \
    VRD(5); SBAR(); GAPA(C1=__builtin_amdgcn_mfma_f32_32x32x16_bf16(kf[3],qr[1],C1,0,0,0),   P0[14],P0[15],P1[0],P1[1],   pw1[2]=PKW(P0,12),pw1[3]=PKW(P0,14), pw1); \
    e0_=*(const __attribute__((address_space(3))) bf16x8*)(ke_); e1_=*(const __attribute__((address_space(3))) bf16x8*)(ke_+512); \
    VRD(2); SBAR(); GAPA(C0=__builtin_amdgcn_mfma_f32_32x32x16_bf16(kf[4],qr[2],C0,0,0,0),   P1[2],P1[3],P1[4],P1[5],     pw2[0]=PKW(P1,0), pw2[1]=PKW(P1,2), pw2); \
    VRD(6); SBAR(); GAPA(C1=__builtin_amdgcn_mfma_f32_32x32x16_bf16(kf[5],qr[2],C1,0,0,0),   P1[6],P1[7],P1[8],P1[9],     pw2[2]=PKW(P1,4), pw2[3]=PKW(P1,6), pw2); \
    e2_=*(const __attribute__((address_space(3))) bf16x8*)(ke_+2048); e3_=*(const __attribute__((address_space(3))) bf16x8*)(ke_+2560); \
    VRD(3); SBAR(); GAPA(C0=__builtin_amdgcn_mfma_f32_32x32x16_bf16(kf[6],qr[3],C0,0,0,0),   P1[10],P1[11],P1[12],P1[13], pw3[0]=PKW(P1,8), pw3[1]=PKW(P1,10), pw3); \
    VRD(7); SBAR(); GAPA(C1=__builtin_amdgcn_mfma_f32_32x32x16_bf16(kf[7],qr[3],C1,0,0,0),   P1[14],P1[15],0.f,0.f,       pw3[2]=PKW(P1,12),pw3[3]=PKW(P1,14), pw3); \
    C0=__builtin_amdgcn_mfma_f32_32x32x16_bf16(e0_,qr[4],C0,0,0,0); C1=__builtin_amdgcn_mfma_f32_32x32x16_bf16(e1_,qr[4],C1,0,0,0); \
    C0=__builtin_amdgcn_mfma_f32_32x32x16_bf16(e2_,qr[5],C0,0,0,0); C1=__builtin_amdgcn_mfma_f32_32x32x16_bf16(e3_,qr[5],C1,0,0,0); SBAR(); \
    l_reg+=sacc; \
    if(GK){DMA_K((t)+3,kw);} if(GV){DMA_V((t)+1,sl_next);} \
    CMASK(C0,C1,t); \
    { float a=MX3(C0[0],C0[1],C1[0]),b=MX3(C0[2],C0[3],C1[1]); a=MX3(a,C1[2],C1[3]); \
      _Pragma("unroll") for(int r=4;r<16;r+=4){a=MX3(a,C0[r],C0[r+1]);b=MX3(b,C0[r+2],C0[r+3]);a=MX3(a,C1[r],C1[r+1]);b=MX3(b,C1[r+2],C1[r+3]);} \
      float rm=__builtin_fmaxf(a,b); { auto rr=__builtin_amdgcn_permlane32_swap(__float_as_uint(rm),__float_as_uint(rm),false,false); rm=__builtin_fmaxf(__uint_as_float(rr[0]),__uint_as_float(rr[1])); } \
      resc=false; \
      if(__builtin_expect(__any(rm>(float)THRL),0)){ const float dl=__builtin_fmaxf(rm,0.f); mhat+=dl; \
        _Pragma("unroll") for(int r=0;r<16;++r){C0[r]-=dl;C1[r]-=dl;} \
        _Pragma("unroll") for(int r=0;r<16;++r)negm[r]=-mhat; asm volatile("":"+v"(negm)); \
        const float f=__builtin_amdgcn_exp2f(-dl); l_reg*=f; if(hi==0)wsf[r32]=f; resc=true; } } \
    SBAR(); \
    GAPB(o[0]=__builtin_amdgcn_mfma_f32_32x32x16_bf16(PAF(0),VFR(0),o[0],0,0,0), C0,0); \
    GAPB(o[1]=__builtin_amdgcn_mfma_f32_32x32x16_bf16(PAF(0),VFR(4),o[1],0,0,0), C0,4); \
    KRD(GL,0); GAPB(o[0]=__builtin_amdgcn_mfma_f32_32x32x16_bf16(PAF(1),VFR(1),o[0],0,0,0), C0,8); \
    KRD(GL,1); GAPB(o[1]=__builtin_amdgcn_mfma_f32_32x32x16_bf16(PAF(1),VFR(5),o[1],0,0,0), C0,12); \
    KRD(GL,2); GAPB(o[0]=__builtin_amdgcn_mfma_f32_32x32x16_bf16(PAF(2),VFR(2),o[0],0,0,0), C1,0); \
    KRD(GL,3); GAPB(o[1]=__builtin_amdgcn_mfma_f32_32x32x16_bf16(PAF(2),VFR(6),o[1],0,0,0), C1,4); \
    GAPB(o[0]=__builtin_amdgcn_mfma_f32_32x32x16_bf16(PAF(3),VFR(3),o[0],0,0,0), C1,8); \
    GAPB(o[1]=__builtin_amdgcn_mfma_f32_32x32x16_bf16(PAF(3),VFR(7),o[1],0,0,0), C1,12); \
    }while(0)
  int t=1;
  #undef CMASK
  #define CMASK(P0,P1,t) do{}while(0)
  for(;t+5<NT;t+=2){
    STEP(pB0,pB1,pA0,pA1,t,true,true,true);     WAIT_BAR(3); RESC(); ROT();
    STEP(pA0,pA1,pB0,pB1,t+1,true,true,true);   WAIT_BAR(3); RESC(); ROT();
  }
  #undef CMASK
  #define CMASK(P0,P1,t) do{int jb_=(t)-(NT-4); if(jb_>=0)cmask(P0,P1,jb_,wq);}while(0)
  #define ENDW(tt) do{ if((tt)+3<NT){WAIT_BAR(3);} else if((tt)+2<NT){WAIT_BAR(1);} else {WAIT_BAR(0);} }while(0)
  for(;t+1<NT;t+=2){
    STEP(pB0,pB1,pA0,pA1,t,(t+3<NT),(t+1<NT),(t+1<NT));       ENDW(t);   RESC(); ROT();
    STEP(pA0,pA1,pB0,pB1,t+1,(t+4<NT),(t+2<NT),(t+2<NT));     ENDW(t+1); RESC(); ROT();
  }
  STEP(pB0,pB1,pA0,pA1,NT-1,false,false,false); RESC();
  { float sacc=pB0[0]+pB0[1]; _Pragma("unroll") for(int r=2;r<16;++r)sacc+=pB0[r]; _Pragma("unroll") for(int r=0;r<16;++r)sacc+=pB1[r]; l_reg+=sacc;
    pw0=(u32x4){PKW(pB0,0),PKW(pB0,2),PKW(pB0,4),PKW(pB0,6)};pw1=(u32x4){PKW(pB0,8),PKW(pB0,10),PKW(pB0,12),PKW(pB0,14)};pw2=(u32x4){PKW(pB1,0),PKW(pB1,2),PKW(pB1,4),PKW(pB1,6)};pw3=(u32x4){PKW(pB1,8),PKW(pB1,10),PKW(pB1,12),PKW(pB1,14)};
    SBAR(); pv(o,vb0+sl_cur,PAF(0),PAF(1),PAF(2),PAF(3)); }
  asm volatile("s_waitcnt lgkmcnt(0)\n\ts_barrier":::"memory");
  #undef PKW
  #undef PAF
  #undef VFR
  #undef PIN
  #undef MX3
  #undef GAPA
  #undef GAPB
  #undef EX
  #undef VRD
  #undef KRD
  #undef STEP
  #undef ENDW
  {auto rr=__builtin_amdgcn_permlane32_swap(__float_as_uint(l_reg),__float_as_uint(l_reg),false,false);l_reg=__uint_as_float(rr[0])+__uint_as_float(rr[1]);}
  if(hi==0)wsf[32+r32]=l_reg;asm volatile("s_waitcnt lgkmcnt(0)":::"memory");
  { float*stg=(float*)(shm+LDS_OST)+wid*(32*68);
    const unsigned trow=(unsigned)(rowbase+q0+wid*QBLK+(lane>>3)); const int ch=(lane&7)*8;
    u32x4 zz[4];
    #pragma unroll
    for(int i=0;i<4;++i)zz[i]=*(const u32x4*)(PROJ+(unsigned)((trow+8*i)*NP+P_MZ+h*64+ch));
    #pragma unroll
    for(int r=0;r<16;++r){const float rl=__builtin_amdgcn_rcpf(wsf[32+crow(r,hi)]);const int orow=crow(r,hi);
      #pragma unroll
      for(int d0=0;d0<2;++d0)stg[orow*68+d0*32+r32]=o[d0][r]*rl;}
    asm volatile("s_waitcnt lgkmcnt(0)":::"memory");
    #pragma unroll
    for(int i=0;i<4;++i){const float*sp=stg+((lane>>3)+8*i)*68+ch; const f32x4 a=*(const f32x4*)sp,bq=*(const f32x4*)(sp+4);
      const f32x4 za={__builtin_bit_cast(float,zz[i].x<<16),__builtin_bit_cast(float,zz[i].x&0xffff0000u),__builtin_bit_cast(float,zz[i].y<<16),__builtin_bit_cast(float,zz[i].y&0xffff0000u)};
      const f32x4 zb={__builtin_bit_cast(float,zz[i].z<<16),__builtin_bit_cast(float,zz[i].z&0xffff0000u),__builtin_bit_cast(float,zz[i].w<<16),__builtin_bit_cast(float,zz[i].w&0xffff0000u)};
      *(u32x4*)(MIX+(unsigned)((trow+8*i)*1024+256+h*64+ch))=pack8bf(a*za,bq*zb);} }
  asm volatile("s_waitcnt lgkmcnt(0)\n\ts_barrier":::"memory");
  #undef DMA_K
  #undef DMA_V
  #undef CMASK
  #undef START
  #undef RESC
  #undef ROT
}
#undef SBAR
#undef WAIT_BAR
}

__device__ __forceinline__ void mix_phase(const bf16_t* Wq, const bf16_t* Wkv, const bf16_t* MQF, const bf16_t* MKVF, const float* SSP, const float2* CS16, bf16_t* KV, const bf16_t* KPE, const bf16_t* PROJ, const bf16_t* GP, const float* gnw, bf16_t* MIX, unsigned char* lds, int vb) {
  const int G = gridDim.x, bx = vb; const int v = (G % 8 == 0) ? (bx % 8) * (G / 8) + bx / 8 : bx;
  for (int bh = v; bh < NB * 8; bh += G) {
    const int b = bh >> 3, h = bh & 7;
    const int grp = bh & 3; const int cpos = grp == 0 ? 0 : grp == 1 ? 2 : grp == 2 ? 3 : 4;
    int qb = 0;
#pragma unroll 1
    for (int part = 0; part < 2; ++part) {
      const int qend = part == 0 ? cpos : S / 256; const int qbeg = qb;
#pragma unroll 1
      for (; qb < qend; ++qb) atths::attn_unit<8>(b, h, qb, Wq, Wkv, MQF, MKVF, SSP, CS16, KV, KPE, PROJ, MIX, (char*)lds, qb == qbeg);
      if (part == 0) { const int cb = bh >> 3, ch = bh & 3;
        if ((bh >> 2) & 1) chain::gla_chain(PROJ, GP, gnw, MIX, cb, ch, (LDS3 char*)lds); else chain::ret_chain(PROJ, MIX, cb, ch, (LDS3 char*)lds); }
    }
  }
}

#define GAS __attribute__((address_space(1)))
#define LAS __attribute__((address_space(3)))
typedef GAS unsigned gu32;
#define RLX_AGENT __ATOMIC_RELAXED, __HIP_MEMORY_SCOPE_AGENT
#define XB_TMO      128
#define XB_XCNT(j)  (256  + 64 * (j))
#define XB_XSUB(j)  (1280 + 64 * (j))
#define XB_XGEN(j)  (2304 + 64 * (j))
#define XB_TOP      3328
#define XB_TOPGEN   3392
#define XCD_BAR_WORDS 3456
#define XB_SPIN_CAP (1u << 18)

__device__ __forceinline__ unsigned xb_ld(unsigned* p)              { return __hip_atomic_load(p, __ATOMIC_RELAXED, __HIP_MEMORY_SCOPE_AGENT); }
__device__ __forceinline__ unsigned xb_add(unsigned* p, unsigned v) { return __hip_atomic_fetch_add(p, v, __ATOMIC_RELAXED, __HIP_MEMORY_SCOPE_AGENT); }
__device__ __forceinline__ unsigned xb_xcc_id() { return (unsigned)__builtin_amdgcn_s_getreg((3 << 11) | 20) & 0xFu; }
#define XB_SPIN(cond, bar) do { unsigned _sp = 0; while (cond) { __builtin_amdgcn_s_sleep(1); \
    if ((++_sp & 255u) == 0u) { if (xb_ld(&(bar)[XB_TMO])) break; if (_sp > XB_SPIN_CAP) { atomicAdd(&(bar)[XB_TMO], 1u); break; } } } } while (0)

struct XcdBarrier {
    unsigned* bar; unsigned x;
    volatile LAS unsigned* st;
};

__device__ __forceinline__ XcdBarrier xcd_barrier_post(unsigned* bar, volatile LAS unsigned* st) {
    XcdBarrier b; b.bar = bar; b.x = xb_xcc_id(); b.st = st;
    if (threadIdx.x == 0) (void)xb_add(&bar[XB_XCNT(b.x)], 1u);
    return b;
}
__device__ __forceinline__ void xcd_barrier_complete(unsigned* bar, unsigned x, unsigned& nloc, unsigned& nx) {
    const unsigned G = gridDim.x * gridDim.y * gridDim.z;
    unsigned sum, cnt, mine, sp = 0u;
    for (;;) {
        sum = 0u; cnt = 0u; mine = 0u;
#pragma unroll
        for (unsigned j = 0; j < 16; ++j) { const unsigned c = xb_ld(&bar[XB_XCNT(j)]); sum += c; cnt += (c > 0u) ? 1u : 0u; mine = (j == x) ? c : mine; }
        if (sum == G) break;
        __builtin_amdgcn_s_sleep(1);
        if ((++sp & 255u) == 0u) { if (xb_ld(&bar[XB_TMO])) break; if (sp > XB_SPIN_CAP) { atomicAdd(&bar[XB_TMO], 1u); break; } }
    }
    nloc = mine > 0u ? mine : 1u; nx = cnt > 0u ? cnt : 1u;
}

__device__ __forceinline__ void xcd_barrier(const XcdBarrier& b_) {
    XcdBarrier b = b_; asm volatile("" : "+s"(b.x));
    asm volatile("s_waitcnt vmcnt(0)" ::: "memory");
    __syncthreads();
    if (threadIdx.x == 0) {
        unsigned* bar = b.bar;
        __builtin_amdgcn_s_waitcnt(0);
        unsigned nloc = b.st[0], nx = b.st[1];
        if (nloc == 0u) { xcd_barrier_complete(bar, b.x, nloc, nx); b.st[0] = nloc; b.st[1] = nx; }
        const unsigned old = xb_add(&bar[XB_XSUB(b.x)], 1u);
        const unsigned gen = old / nloc;
        if (old + 1u == (gen + 1u) * nloc) {
            __builtin_amdgcn_fence(__ATOMIC_RELEASE, "agent");
            asm volatile("s_waitcnt vmcnt(0)" ::: "memory");
            const unsigned og = xb_add(&bar[XB_TOP], 1u);
            const unsigned tg = og / nx;
            if (og + 1u == (tg + 1u) * nx) xb_add(&bar[XB_TOPGEN], 1u);
            else XB_SPIN(xb_ld(&bar[XB_TOPGEN]) == tg, bar);
            __builtin_amdgcn_fence(__ATOMIC_ACQUIRE, "agent");
            xb_add(&bar[XB_XGEN(b.x)], 1u);
            asm volatile("s_waitcnt vmcnt(0)" ::: "memory");
        } else {
            XB_SPIN(xb_ld(&bar[XB_XGEN(b.x)]) == gen, bar);
            __builtin_amdgcn_fence(__ATOMIC_ACQUIRE, "agent");
            asm volatile("s_waitcnt vmcnt(0)" ::: "memory");
        }
    }
    __syncthreads();
}

#define XL_RANK(j)  (4096 + 64 * (j))
#define XL_SUB(j)   (5120 + 64 * (j))
#define XL_GEN(j)   (6144 + 64 * (j))
__device__ __forceinline__ void xcd_local_barrier(unsigned* bar, unsigned x_, unsigned nloc, volatile LAS unsigned* genw) {
    unsigned x = x_; asm volatile("" : "+s"(x));
    asm volatile("s_waitcnt vmcnt(0)" ::: "memory");
    __syncthreads();
    if (threadIdx.x == 0) {
        __builtin_amdgcn_s_waitcnt(0);
        const unsigned old = xb_add(&bar[XL_SUB(x)], 1u);
        const unsigned gen = genw[0]; genw[0] = gen + 1u;
        if (old + 1u == (gen + 1u) * nloc) { xb_add(&bar[XL_GEN(x)], 1u); }
        else { XB_SPIN(xb_ld(&bar[XL_GEN(x)]) == gen, bar); }
        __builtin_amdgcn_fence(__ATOMIC_ACQUIRE, "agent");
        asm volatile("s_waitcnt vmcnt(0)" ::: "memory");
    }
    __syncthreads();
}

#ifndef PROBE_STAMP
#define PROBE_STAMP 0
#endif
#ifndef PROBE_DUP
#define PROBE_DUP 0
#endif
constexpr int NTHREADS = 512;
constexpr int LDS_BYTES = 163840;
__global__ void __launch_bounds__(NTHREADS, 2) mk_fwd(Params p) {
    extern __shared__ __attribute__((aligned(16))) unsigned char lds[];
    cg::grid_group grid = cg::this_grid();
    unsigned char* ws = p.ws;
    float* ADA = (float*)(ws + WS_ADA); const float2* CS32 = (const float2*)(ws + WS_CS32); const float2* CS16 = (const float2*)(ws + WS_CS16);
    bf16_t* WinT = (bf16_t*)(ws + WS_WIN); bf16_t* WuqT = (bf16_t*)(ws + WS_WUQ); bf16_t* WukvT = (bf16_t*)(ws + WS_WUKV); bf16_t* WoutT = (bf16_t*)(ws + WS_WOUT);
    float* RSQ = (float*)(ws + WS_RSQ); float* RSKV = (float*)(ws + WS_RSKV); float* GG = (float*)(ws + WS_GG);
    bf16_t* H = (bf16_t*)(ws + WS_H); bf16_t* PROJ = (bf16_t*)(ws + WS_PROJ); bf16_t* Q = (bf16_t*)(ws + WS_Q); bf16_t* KV = (bf16_t*)(ws + WS_KV); bf16_t* MIX = (bf16_t*)(ws + WS_MIX);
    bf16_t* GP = (bf16_t*)(ws + WS_GP); float* SSP = (float*)(ws + WS_SSP);
    PG8_LAS unsigned char* ldsp = (PG8_LAS unsigned char*)lds;
    volatile LAS unsigned* MISC = (volatile LAS unsigned*)(ldsp + 163584);
    if (threadIdx.x < 32) MISC[threadIdx.x] = 0u;
    __syncthreads();
    XcdBarrier xbar = xcd_barrier_post((unsigned*)(ws + WS_CTL), MISC + 8);
#define GRID_BAR() xcd_barrier(xbar)
    if (threadIdx.x == 0) { MISC[16] = xb_add(&xbar.bar[XL_RANK(xbar.x)], 1u); MISC[17] = 0u; }
#define VB() ((int)__builtin_amdgcn_readfirstlane((int)MISC[16]))
#define UNI() ((unsigned)__builtin_amdgcn_readfirstlane((int)MISC[17]))
#define LAYER_BAR() do { if (UNI()) xcd_local_barrier(xbar.bar, xbar.x, gridDim.x >> 3, MISC + 18); else xcd_barrier(xbar); } while (0)
    unsigned long long* ts = (unsigned long long*)(ws + WS_CTL + 32768);
#if PROBE_STAMP
#define STAMP(i) do { if (blockIdx.x == 0 && threadIdx.x == 0) ts[i] = __builtin_amdgcn_s_memrealtime(); } while (0)
#else
#define STAMP(i) do { } while (0)
#endif
    STAMP(0);

    ph_prep<1>(p, mkctx(), ldsp);
#if PROBE_DUP & 64
    __syncthreads(); ph_prep<(PROBE_DUP >> 8) & 7>(p, mkctx(), ldsp);
#endif
    if (p.never) grid.sync();
    GRID_BAR();
    STAMP(1);
    if (threadIdx.x == 0) {
        const unsigned G_ = gridDim.x; unsigned ok = (G_ % 8u == 0u) ? 1u : 0u;
        for (unsigned j = 0; j < 8; ++j) ok &= (xb_ld(&xbar.bar[XB_XCNT(j)]) == G_ / 8u) ? 1u : 0u;
        const unsigned rk = MISC[16];
        MISC[16] = ok ? (xbar.x + 8u * rk) : blockIdx.x; MISC[17] = ok; }
    __syncthreads();
    ph_prep<6>(p, mkctx(), ldsp);
    { const Ctx c0 = mkctx(); ph_norm<false, 8>(c0, mkdom(c0, VB(), UNI()), p.x, p.norm_w, ADA, H); }
#pragma unroll 1
    for (int l = 0; l < DEPTH; ++l) {
        bf16_t* X1 = (bf16_t*)p.out; bf16_t* X2 = H;
        const float* ADA_l = ADA + (size_t)l * NB * 3072;
        if (l > 0) { const Ctx c1 = mkctx(); ph_norm<true, 8>(c1, mkdom(c1, VB(), UNI()), X1, p.norm_w + l * D, ADA_l, H); LAYER_BAR(); }
        else GRID_BAR();
        STAMP(2 + 6 * l + 0);
        run_gemm(ldsp, VB(), H, D, WinT + (size_t)l * NP * 1024, T, NP, 1024, EpiIn{PROJ, GG, CS32, CS16, SSP, Q, Q + (size_t)T * 256, Q + (size_t)T * 384});
#if PROBE_DUP & 1
        run_gemm(ldsp, VB(), H, D, WinT + (size_t)l * NP * 1024, T, NP, 1024, EpiIn{PROJ, GG, CS32, CS16, SSP, Q, Q + (size_t)T * 256, Q + (size_t)T * 384});
#endif
        LAYER_BAR();
        STAMP(2 + 6 * l + 1);
        { const Ctx cg = mkctx(); ph_gla_prep(cg, mkdom(cg, VB(), UNI()), PROJ, GG, p.w_g2 + (size_t)l * 16 * 128, p.b_g2 + l * 128, GP, (__attribute__((address_space(3))) float*)ldsp); }
#if PROBE_DUP & 2
        run_gemm(ldsp, VB(), PROJ + P_MQ, NP, WuqT + (size_t)l * 768 * 256, T, 768, 256, EpiQ{Q, SSP, CS16});
        run_gemm(ldsp, VB(), PROJ + P_MKV, NP, WukvT + (size_t)l * 1024 * 128, T, 1024, 128, EpiKV{KV, SSP});
#endif
        LAYER_BAR();
        STAMP(2 + 6 * l + 3);
        mix_phase(WuqT + (size_t)l * 768 * 256, WukvT + (size_t)l * 1024 * 128, Q, Q + (size_t)T * 256, SSP, CS16, KV, Q + (size_t)T * 384, PROJ, GP, p.gnw + l * 64, MIX, lds, VB());
        STAMP(16 + l);
#if PROBE_DUP & 4
        att::attn_phase(Q, KV, PROJ, MIX, (char*)lds);
#endif
#if PROBE_DUP & 8
        chain::chain_phase(PROJ, GP, p.gnw + l * 64, MIX, (LDS3 char*)lds);
#endif
        LAYER_BAR();
        STAMP(2 + 6 * l + 4);
        if (l == 0) run_gemm(ldsp, VB(), MIX, 1024, WoutT + (size_t)l * 1024 * 1024, T, 1024, 1024, EpiOut<false>{p.x, X1, ADA_l});
        else run_gemm(ldsp, VB(), MIX, 1024, WoutT + (size_t)l * 1024 * 1024, T, 1024, 1024, EpiOut<true>{X1, X2, ADA_l});
        LAYER_BAR();
        STAMP(2 + 6 * l + 5);
    }
    { const Ctx cf = mkctx(); ph_final<8>(cf, mkdom(cf, VB(), UNI()), H, p.fnw, p.out); }
#if PROBE_STAMP
    GRID_BAR(); STAMP(14); __syncthreads();
    {
      constexpr int PT[6][4] = {{0,0,0,0}, {0,1,1,2}, {2,3,3,4}, {4,5,5,16}, {16,6,6,7}, {13,14,8,9}};
      volatile unsigned long long* tv = ts;
      const float dA = (float)(tv[PT[PROBE_STAMP][1]] - tv[PT[PROBE_STAMP][0]]) * 0.01f, dB = (float)(tv[PT[PROBE_STAMP][3]] - tv[PT[PROBE_STAMP][2]]) * 0.01f;
      const float e = dB * (1.f / 2000.f);
      for (long i = c.gt; i < (1l << 20); i += c.GT) p.out[1024 + i] += e;
      if (blockIdx.x == 0 && c.tid == 0) p.out[0] += dA * (1.f / 2000.f); }
#endif
}

extern "C" void kernel_launch(void* const* d_in, const int* in_sizes, int n_in, void* d_out, int out_size, void* d_ws, size_t ws_size, hipStream_t stream) {
    static int grid_blocks = 0;
    if (grid_blocks == 0) {
        if (n_in != 16 || in_sizes[0] != T * D || out_size != T * D || ws_size < WS_END) {
            fprintf(stderr, "kernel_launch: shape/ws mismatch n_in %d in0 %d out %d ws %zu (need %zu)\n", n_in, n_in > 0 ? in_sizes[0] : -1, out_size, ws_size, (size_t)WS_END);
            grid_blocks = -1; return;
        }
        int dev = 0, cus = 0, per_cu = 0;
        hipGetDevice(&dev); hipDeviceGetAttribute(&cus, hipDeviceAttributeMultiprocessorCount, dev);
        if (hipFuncSetAttribute((const void*)mk_fwd, hipFuncAttributeMaxDynamicSharedMemorySize, LDS_BYTES) != hipSuccess) { fprintf(stderr, "kernel_launch: hipFuncSetAttribute failed\n"); grid_blocks = -1; return; }
        if (hipOccupancyMaxActiveBlocksPerMultiprocessor(&per_cu, (const void*)mk_fwd, NTHREADS, LDS_BYTES) != hipSuccess || per_cu < 1) { fprintf(stderr, "kernel_launch: occupancy query says %d blocks/CU\n", per_cu); grid_blocks = -1; return; }
        grid_blocks = cus;
        fprintf(stderr, "kernel_launch: cus %d per_cu %d grid %d\n", cus, per_cu, grid_blocks);
    }
    if (grid_blocks < 0) return;
    Params p{};
    p.x = (const float*)d_in[0]; p.c = (const float*)d_in[1]; p.pos = (const int*)d_in[2]; p.norm_w = (const float*)d_in[3]; p.ada_w = (const float*)d_in[4];
    p.ada_b = (const float*)d_in[5]; p.w_in = (const float*)d_in[6]; p.qnw = (const float*)d_in[7]; p.w_uq = (const float*)d_in[8]; p.kvnw = (const float*)d_in[9];
    p.w_ukv = (const float*)d_in[10]; p.w_g2 = (const float*)d_in[11]; p.b_g2 = (const float*)d_in[12]; p.gnw = (const float*)d_in[13]; p.w_out = (const float*)d_in[14];
    p.fnw = (const float*)d_in[15]; p.out = (float*)d_out; p.ws = (unsigned char*)d_ws;
    if (hipMemsetAsync((char*)d_ws + WS_CTL, 0, 65536, stream) != hipSuccess) { fprintf(stderr, "kernel_launch: memset failed\n"); return; }
    void* args[] = {&p};
    hipError_t e = hipLaunchCooperativeKernel((void*)mk_fwd, dim3(grid_blocks), dim3(NTHREADS), args, LDS_BYTES, stream);
    if (e != hipSuccess) fprintf(stderr, "cooperative launch failed: %s (grid %d)\n", hipGetErrorString(e), grid_blocks);
}
```
